# Optimizing an MI355X kernel written in HIP

```python
import math
import jax
import jax.numpy as jnp
from jax import lax
import numpy as np

D_MODEL = 1024
BATCH = 8
SEQ = 4096
DEPTH = 1

D_MIX = 2 * D_MODEL
ML_HEADS = 4
ML_DV = D_MODEL // ML_HEADS
ML_DQK = ML_DV // 2
ML_QK = ML_HEADS * ML_DQK
ML_WIDTH = ML_HEADS * ML_DV
SSM_WIDTH = D_MIX - ML_WIDTH
SSM_HEADDIM = 64
SSM_HEADS = SSM_WIDTH // SSM_HEADDIM
SSM_GROUPS = 4
SSM_STATE = 128
SSM_CONV_DIM = SSM_WIDTH + 2 * SSM_GROUPS * SSM_STATE
CONV_K = 5
CHUNK = 128
N_EXPERTS = 64
TOP_K = 8
N_EXPERT_GROUPS = 8
TOPK_GROUPS = 4
D_EXPERT = D_MODEL // 4
ROUTED_SCALE = 2.5
MOE_BLOCK = 512
LN_EPS = 1e-5
RMS_EPS = 1e-5
ALPHA = (2 * DEPTH) ** 0.25
BETA = (8 * DEPTH) ** -0.25
IN_SIZES = (ML_QK, ML_QK, ML_WIDTH, ML_WIDTH, 2 * ML_HEADS, 2 * ML_HEADS, SSM_WIDTH, SSM_CONV_DIM, 2 * SSM_HEADS)
IN_SCALES = (D_MODEL ** -0.5,) * 8 + (0.1 * D_MODEL ** -0.5,)
IN_SPLITS = tuple(int(s) for s in np.cumsum(IN_SIZES)[:-1])
D_IN_PROJ = sum(IN_SIZES)

kernel_name = 'hymba_mlstm_mamba2_moe_encoder_block'


def _layer_norm(x, g, b):
    xf = x.astype(jnp.float32)
    mu = xf.mean(-1, keepdims=True)
    var = jnp.square(xf - mu).mean(-1, keepdims=True)
    return ((xf - mu) * lax.rsqrt(var + LN_EPS) * g + b).astype(x.dtype)


def _mlstm_chunkwise(q, k, v, i_pre, f_pre):
    Bb, H, S, Dk = q.shape
    Dv = v.shape[-1]
    nc = S // CHUNK
    q = q.reshape(Bb, H, nc, CHUNK, Dk)
    k = k.reshape(Bb, H, nc, CHUNK, Dk)
    v = v.reshape(Bb, H, nc, CHUNK, Dv)
    ig = i_pre.reshape(Bb, H, nc, CHUNK)
    b = jnp.cumsum(jax.nn.log_sigmoid(f_pre).reshape(Bb, H, nc, CHUNK), axis=-1)
    g = b[..., -1]
    a = g[..., None] - b + ig
    m_loc = a.max(-1)
    kw = k * jnp.exp(a - m_loc[..., None])[..., None]
    U = jnp.einsum('bhcsk,bhcsv->bhckv', kw, v)
    u = kw.sum(3)

    def step(carry, inp):
        C, n, m = carry
        U_c, u_c, g_c, ml_c = inp
        m_new = jnp.maximum(g_c + m, ml_c)
        decay = jnp.exp(g_c + m - m_new)
        scale = jnp.exp(ml_c - m_new)
        C_new = decay[..., None, None] * C + scale[..., None, None] * U_c
        n_new = decay[..., None] * n + scale[..., None] * u_c
        return (C_new, n_new, m_new), (C, n, m)

    init = (jnp.zeros((Bb, H, Dk, Dv), jnp.float32), jnp.zeros((Bb, H, Dk), jnp.float32),
            jnp.full((Bb, H), -jnp.inf, jnp.float32))
    mv = lambda t: jnp.moveaxis(t, 2, 0)
    _, (Cp, n_p, m_p) = lax.scan(step, init, (mv(U), mv(u), mv(g), mv(m_loc)))
    Cp = jnp.moveaxis(Cp, 0, 2)
    n_p = jnp.moveaxis(n_p, 0, 2)
    m_p = jnp.moveaxis(m_p, 0, 2)

    tril = jnp.tril(jnp.ones((CHUNK, CHUNK), bool))
    dmat = jnp.where(tril, b[..., :, None] - b[..., None, :] + ig[..., None, :], -jnp.inf)
    m_inter = b + m_p[..., None]
    m_t = jnp.maximum(m_inter, dmat.max(-1))
    s_mat = jnp.einsum('bhctk,bhcsk->bhcts', q, k) * jnp.exp(dmat - m_t[..., None])
    inter_w = jnp.exp(m_inter - m_t)
    num = jnp.einsum('bhcts,bhcsv->bhctv', s_mat, v) + inter_w[..., None] * jnp.einsum('bhctk,bhckv->bhctv', q, Cp)
    den = s_mat.sum(-1) + inter_w * jnp.einsum('bhctk,bhck->bhct', q, n_p)
    h = num / jnp.maximum(jnp.abs(den), jnp.exp(-m_t))[..., None]
    return h.reshape(Bb, H, S, Dv)


def _mlstm_group(q, k, v, o, i_pre, f_pre, i_bias, f_bias, norm_w):
    Bb, S, _ = q.shape
    H = ML_HEADS
    heads = lambda t, d: t.reshape(Bb, S, H, d).transpose(0, 2, 1, 3).astype(jnp.float32)
    qh = heads(q, ML_DQK)
    kh = heads(k, ML_DQK) * (ML_DQK ** -0.5)
    vh = heads(v, ML_DV)
    ig = (i_pre.astype(jnp.float32) + i_bias.astype(jnp.float32)).transpose(0, 2, 1)
    fg = (f_pre.astype(jnp.float32) + f_bias.astype(jnp.float32)).transpose(0, 2, 1)
    flip = lambda t: jnp.flip(t, axis=2)
    h_fwd = _mlstm_chunkwise(qh, kh, vh, ig[:, :H], fg[:, :H])
    h_bwd = flip(_mlstm_chunkwise(flip(qh), flip(kh), flip(vh), flip(ig[:, H:]), flip(fg[:, H:])))
    h = h_fwd + h_bwd
    mu = h.mean(-1, keepdims=True)
    var = jnp.square(h - mu).mean(-1, keepdims=True)
    h = (h - mu) * lax.rsqrt(var + LN_EPS) * norm_w.astype(jnp.float32).reshape(H, 1, ML_DV)
    h = h.transpose(0, 2, 1, 3).reshape(Bb, S, ML_WIDTH)
    return (jax.nn.sigmoid(o.astype(jnp.float32)) * h).astype(q.dtype)


def _ssd_chunked(x, dt, A, Bm, Cm):
    Bb, S, H, P = x.shape
    G, N = Bm.shape[2], Bm.shape[3]
    hg = H // G
    nc = S // CHUNK
    x = x.reshape(Bb, nc, CHUNK, G, hg, P)
    dt = dt.reshape(Bb, nc, CHUNK, G, hg)
    Bm = Bm.reshape(Bb, nc, CHUNK, G, N)
    Cm = Cm.reshape(Bb, nc, CHUNK, G, N)
    acum = jnp.cumsum(dt * A.reshape(G, hg), axis=2)
    xdt = x * dt[..., None]
    tril = jnp.tril(jnp.ones((CHUNK, CHUNK), bool))
    seg = acum[:, :, :, None] - acum[:, :, None, :]
    decay_ts = jnp.exp(jnp.where(tril[:, :, None, None], seg, -jnp.inf))
    cb = jnp.einsum('bctgn,bcsgn->bctsg', Cm, Bm)
    y_diag = jnp.einsum('bctsgh,bcsghp->bctghp', cb[..., None] * decay_ts, xdt)
    decay_s = jnp.exp(acum[:, :, -1:] - acum)
    states = jnp.einsum('bcsgn,bcsghp->bcghpn', Bm, xdt * decay_s[..., None])
    chunk_decay = jnp.exp(acum[:, :, -1])

    def step(h, inp):
        st, dc = inp
        return dc[..., None, None] * h + st, h

    _, h_prev = lax.scan(step, jnp.zeros((Bb, G, hg, P, N), jnp.float32),
                         (jnp.moveaxis(states, 1, 0), jnp.moveaxis(chunk_decay, 1, 0)))
    h_prev = jnp.moveaxis(h_prev, 0, 1)
    y_off = jnp.einsum('bctgn,bcghpn->bctghp', Cm, h_prev) * jnp.exp(acum)[..., None]
    return (y_diag + y_off).reshape(Bb, S, H, P)


def _mamba2_group(z, xbc, dt_pre, conv_w, conv_b, dt_bias, a_log, d_skip, norm_w):
    Bb, S, _ = z.shape
    H = SSM_HEADS
    xbc = lax.conv_general_dilated(xbc, conv_w[:, None, :], window_strides=(1,),
                                   padding=[(CONV_K // 2, CONV_K // 2)],
                                   dimension_numbers=('NWC', 'WIO', 'NWC'),
                                   feature_group_count=SSM_CONV_DIM) + conv_b
    xbc = jax.nn.silu(xbc)
    xs, Bm, Cm = jnp.split(xbc, [SSM_WIDTH, SSM_WIDTH + SSM_GROUPS * SSM_STATE], axis=-1)
    xs = xs.reshape(Bb, S, H, SSM_HEADDIM).astype(jnp.float32)
    Bm = Bm.reshape(Bb, S, SSM_GROUPS, SSM_STATE).astype(jnp.float32)
    Cm = Cm.reshape(Bb, S, SSM_GROUPS, SSM_STATE).astype(jnp.float32)
    dt = jax.nn.softplus(dt_pre.astype(jnp.float32) + dt_bias.astype(jnp.float32))
    A = -jnp.exp(a_log.astype(jnp.float32))
    fl = lambda t: jnp.flip(t, axis=1)
    y_f = _ssd_chunked(xs, dt[..., :H], A[:H], Bm, Cm)
    y_b = fl(_ssd_chunked(fl(xs), fl(dt[..., H:]), A[H:], fl(Bm), fl(Cm)))
    y = y_f + y_b + d_skip.astype(jnp.float32)[:, None] * xs
    y = y.reshape(Bb, S, SSM_WIDTH) * jax.nn.silu(z.astype(jnp.float32))
    yg = y.reshape(Bb, S, SSM_GROUPS, SSM_WIDTH // SSM_GROUPS)
    yg = yg * lax.rsqrt(jnp.mean(yg * yg, -1, keepdims=True) + RMS_EPS)
    return (yg.reshape(Bb, S, SSM_WIDTH) * norm_w.astype(jnp.float32)).astype(z.dtype)


def _moe(x2d, w_router, router_bias, w_gate, w_up, w_down, ws_gate, ws_up, ws_down):
    T, D = x2d.shape
    E = N_EXPERTS
    scores = jax.nn.sigmoid((x2d @ w_router).astype(jnp.float32))
    choice = scores + router_bias.astype(jnp.float32)
    grp_score = lax.top_k(choice.reshape(T, N_EXPERT_GROUPS, E // N_EXPERT_GROUPS), 2)[0].sum(-1)
    _, top_groups = lax.top_k(grp_score, TOPK_GROUPS)
    gmask = jnp.any(top_groups[..., None] == jnp.arange(N_EXPERT_GROUPS), axis=1)
    emask = jnp.repeat(gmask, E // N_EXPERT_GROUPS, axis=1)
    _, idx = lax.top_k(jnp.where(emask, choice, -jnp.inf), TOP_K)
    wsel = jnp.take_along_axis(scores, idx, axis=1)
    wsel = wsel / wsel.sum(-1, keepdims=True) * ROUTED_SCALE

    M = T * TOP_K
    e_flat = idx.reshape(M)
    tok_flat = jnp.arange(M, dtype=jnp.int32) // TOP_K
    g_flat = wsel.reshape(M)
    order = jnp.argsort(e_flat)
    e_sorted = e_flat[order]
    counts = jnp.bincount(e_flat, length=E)
    starts = jnp.cumsum(counts) - counts
    pcounts = (counts + MOE_BLOCK - 1) // MOE_BLOCK * MOE_BLOCK
    pends = jnp.cumsum(pcounts)
    pstarts = pends - pcounts
    dest = pstarts[e_sorted] + (jnp.arange(M, dtype=jnp.int32) - starts[e_sorted])
    nb = (M + E * (MOE_BLOCK - 1)) // MOE_BLOCK
    slot_tok = jnp.zeros((nb * MOE_BLOCK,), jnp.int32).at[dest].set(tok_flat[order])
    slot_gate = jnp.zeros((nb * MOE_BLOCK,), jnp.float32).at[dest].set(g_flat[order])
    block_expert = jnp.minimum(jnp.searchsorted(pends, jnp.arange(nb) * MOE_BLOCK, side='right'), E - 1)

    def body(y, blk):
        tok, gate, e = blk
        xb = x2d[tok]
        h = jax.nn.silu(xb @ w_gate[e]) * (xb @ w_up[e])
        out = (h @ w_down[e]) * gate[:, None].astype(x2d.dtype)
        return y.at[tok].add(out), None

    routed, _ = lax.scan(body, jnp.zeros_like(x2d),
                         (slot_tok.reshape(nb, MOE_BLOCK), slot_gate.reshape(nb, MOE_BLOCK), block_expert))
    shared = (jax.nn.silu(x2d @ ws_gate) * (x2d @ ws_up)) @ ws_down
    return routed + shared


def _layer(x, w_in, ml_i_bias, ml_f_bias, ml_norm_w, conv_w, conv_b, dt_bias, a_log, d_skip, ssm_norm_w,
           w_out, ln1_g, ln1_b, w_router, router_bias, w_exp_gate, w_exp_up, w_exp_down,
           w_sh_gate, w_sh_up, w_sh_down, ln2_g, ln2_b):
    Bb, S, D = x.shape
    proj = jnp.einsum('bsd,de->bse', x, w_in)
    q, k, v, o, ig, fg, z, xbc, dt = jnp.split(proj, IN_SPLITS, axis=-1)
    y_ml = _mlstm_group(q, k, v, o, ig, fg, ml_i_bias, ml_f_bias, ml_norm_w)
    y_ssm = _mamba2_group(z, xbc, dt, conv_w, conv_b, dt_bias, a_log, d_skip, ssm_norm_w)
    mix = jnp.einsum('bse,ed->bsd', jnp.concatenate([y_ml, y_ssm], axis=-1), w_out)
    h = _layer_norm(ALPHA * x + mix, ln1_g, ln1_b)
    ffn = _moe(h.reshape(Bb * S, D), w_router, router_bias, w_exp_gate, w_exp_up, w_exp_down,
               w_sh_gate, w_sh_up, w_sh_down).reshape(Bb, S, D)
    return _layer_norm(ALPHA * h + ffn, ln2_g, ln2_b)


def setup_inputs(seed: int = 0) -> dict:
    key = jax.random.key(seed)
    ks = jax.random.split(key, 32)
    f32 = jnp.float32
    L = DEPTH
    nrm = lambda kk, shape, scale: jax.random.normal(kk, shape, f32) * scale
    x = nrm(ks[0], (BATCH, SEQ, D_MODEL), 1.0)
    wk = jax.random.split(ks[1], len(IN_SIZES))
    w_in = jnp.concatenate([nrm(wk[j], (L, D_MODEL, IN_SIZES[j]), IN_SCALES[j]) for j in range(len(IN_SIZES))], axis=-1)
    ml_i_bias = nrm(ks[2], (L, 2 * ML_HEADS), 0.1)
    ml_f_bias = 3.0 + 3.0 * jax.random.uniform(ks[3], (L, 2 * ML_HEADS), f32)
    ml_norm_w = 1.0 + nrm(ks[4], (L, ML_WIDTH), 0.02)
    conv_w = nrm(ks[5], (L, CONV_K, SSM_CONV_DIM), CONV_K ** -0.5)
    conv_b = nrm(ks[6], (L, SSM_CONV_DIM), 0.02)
    dt0 = jnp.exp(jax.random.uniform(ks[7], (L, 2 * SSM_HEADS), f32, math.log(1e-3), math.log(1e-1)))
    dt_bias = dt0 + jnp.log(-jnp.expm1(-dt0))
    a_log = jnp.log(jax.random.uniform(ks[8], (L, 2 * SSM_HEADS), f32, 1.0, 16.0))
    d_skip = 1.0 + nrm(ks[9], (L, SSM_HEADS), 0.02)
    ssm_norm_w = 1.0 + nrm(ks[10], (L, SSM_WIDTH), 0.02)
    w_out = nrm(ks[11], (L, D_MIX, D_MODEL), D_MIX ** -0.5 * BETA)
    ln1_g = 1.0 + nrm(ks[12], (L, D_MODEL), 0.02)
    ln1_b = nrm(ks[13], (L, D_MODEL), 0.02)
    w_router = nrm(ks[14], (L, D_MODEL, N_EXPERTS), D_MODEL ** -0.5)
    router_bias = nrm(ks[15], (L, N_EXPERTS), 0.01)
    w_exp_gate = nrm(ks[16], (L, N_EXPERTS, D_MODEL, D_EXPERT), D_MODEL ** -0.5)
    w_exp_up = nrm(ks[17], (L, N_EXPERTS, D_MODEL, D_EXPERT), D_MODEL ** -0.5)
    w_exp_down = nrm(ks[18], (L, N_EXPERTS, D_EXPERT, D_MODEL), D_EXPERT ** -0.5 * BETA)
    w_sh_gate = nrm(ks[19], (L, D_MODEL, D_EXPERT), D_MODEL ** -0.5)
    w_sh_up = nrm(ks[20], (L, D_MODEL, D_EXPERT), D_MODEL ** -0.5)
    w_sh_down = nrm(ks[21], (L, D_EXPERT, D_MODEL), D_EXPERT ** -0.5 * BETA)
    ln2_g = 1.0 + nrm(ks[22], (L, D_MODEL), 0.02)
    ln2_b = nrm(ks[23], (L, D_MODEL), 0.02)
    return {'x': x, 'w_in': w_in, 'ml_i_bias': ml_i_bias, 'ml_f_bias': ml_f_bias, 'ml_norm_w': ml_norm_w,
            'conv_w': conv_w, 'conv_b': conv_b, 'dt_bias': dt_bias, 'a_log': a_log, 'd_skip': d_skip,
            'ssm_norm_w': ssm_norm_w, 'w_out': w_out, 'ln1_g': ln1_g, 'ln1_b': ln1_b,
            'w_router': w_router, 'router_bias': router_bias, 'w_exp_gate': w_exp_gate,
            'w_exp_up': w_exp_up, 'w_exp_down': w_exp_down, 'w_sh_gate': w_sh_gate,
            'w_sh_up': w_sh_up, 'w_sh_down': w_sh_down, 'ln2_g': ln2_g, 'ln2_b': ln2_b}


def reference(x, w_in, ml_i_bias, ml_f_bias, ml_norm_w, conv_w, conv_b, dt_bias, a_log, d_skip,
              ssm_norm_w, w_out, ln1_g, ln1_b, w_router, router_bias, w_exp_gate, w_exp_up, w_exp_down,
              w_sh_gate, w_sh_up, w_sh_down, ln2_g, ln2_b):
    for l in range(DEPTH):
        x = _layer(x, w_in[l], ml_i_bias[l], ml_f_bias[l], ml_norm_w[l], conv_w[l], conv_b[l], dt_bias[l],
                   a_log[l], d_skip[l], ssm_norm_w[l], w_out[l], ln1_g[l], ln1_b[l], w_router[l],
                   router_bias[l], w_exp_gate[l], w_exp_up[l], w_exp_down[l], w_sh_gate[l], w_sh_up[l],
                   w_sh_down[l], ln2_g[l], ln2_b[l])
    return x
```

```cpp
#include <hip/hip_runtime.h>
#include <hip/hip_cooperative_groups.h>
#include <cstdio>
#include <cstdint>
namespace cg = cooperative_groups;

#define LAS __attribute__((address_space(3)))
typedef unsigned short bf16_t;
typedef short bf16x8 __attribute__((ext_vector_type(8)));
typedef short s16x4 __attribute__((ext_vector_type(4)));
typedef short v4i16_t __attribute__((ext_vector_type(4)));
typedef float f32x4 __attribute__((ext_vector_type(4)));
typedef float f32x2 __attribute__((ext_vector_type(2)));
typedef unsigned u32x4 __attribute__((ext_vector_type(4)));
typedef unsigned u32x2 __attribute__((ext_vector_type(2)));
typedef LAS unsigned char* ldsp;
typedef LAS const unsigned char* ldscp;

constexpr int BATCH = 8, SEQ = 4096, DM = 1024, T = BATCH * SEQ;
constexpr int NC = 32, CH = 128;
constexpr int NIN = 6192, NINP = 6144;
constexpr int NE = 64, TOPK = 8, DE = 256;
constexpr float LN_EPS = 1e-5f, RMS_EPS = 1e-5f;
constexpr float ALPHA = 1.189207115002721f;
constexpr float NEG_BIG = -1e30f;
constexpr int NPASS = 3;
constexpr int PASS_VB0[NPASS + 1] = {0, 88, 176, 256};
constexpr int PASS_MAXROWS = 106496 + 32768;
constexpr int PASS_MAXTILES = PASS_MAXROWS / 256;
constexpr int YS_ROW0 = 90624;

constexpr size_t MiB = 1u << 20;
constexpr size_t WS_CTL = 0;
constexpr size_t WS_WIN = 1 * MiB;
constexpr size_t WS_WOUT = 14 * MiB;
constexpr size_t WS_GATES = 18 * MiB;
constexpr size_t WS_MSTAT = 24 * MiB;
constexpr size_t WS_Q = 26 * MiB;
constexpr size_t WS_K = 58 * MiB;
constexpr size_t WS_V = 90 * MiB;
constexpr size_t WS_OZ = 154 * MiB;
constexpr size_t WS_XBC = 282 * MiB;
constexpr size_t WS_XB = 410 * MiB;
constexpr size_t WS_H = 26 * MiB;
constexpr size_t WS_W1T = 90 * MiB;
constexpr size_t WS_W2T = 155 * MiB;
constexpr size_t WS_Y = 188 * MiB;
constexpr size_t WS_ACT = 429 * MiB;
constexpr size_t WS_SELE = 497 * MiB;
constexpr size_t WS_SELW = 498 * MiB;
constexpr size_t WS_TOKPOS = 499 * MiB;
constexpr size_t WS_ROWTOK = 500 * MiB;
constexpr size_t WS_ROWGATE = 502 * MiB;
constexpr size_t WS_ROWY = 504 * MiB;
constexpr size_t WS_TILEE = 506 * MiB;
constexpr size_t WS_END = 507 * MiB;
static_assert((size_t)(YS_ROW0 + T) * DM * 2 <= (WS_ACT - WS_Y) && (size_t)PASS_MAXROWS * DE * 2 <= (WS_SELE - WS_ACT) && (size_t)NPASS * PASS_MAXROWS * 4 <= 2 * MiB, "MoE workspace map");
constexpr int MS_GM = 0;
constexpr int MS_MP = 4096;
constexpr int MS_U = 8192;
constexpr int MS_SD = 8192 + 262144;
constexpr int CW_BLOCKCNT = 1024;
constexpr int CW_NTILES = 512;
constexpr int CW_BAR = 32768;
constexpr int MISC_OFF = 159744 - 64;

constexpr int LDS_BYTES = 159744;

typedef __bf16 bf16x2_t __attribute__((ext_vector_type(2)));
__device__ __forceinline__ unsigned pk2(float lo, float hi) { const f32x2 v = {lo, hi}; const bf16x2_t b = __builtin_convertvector(v, bf16x2_t); return __builtin_bit_cast(unsigned, b); }
__device__ __forceinline__ unsigned f2bf(float f) { return pk2(f, 0.f) & 0xffffu; }
__device__ __forceinline__ float bflo(unsigned u) { return __builtin_bit_cast(float, u << 16); }
__device__ __forceinline__ float bfhi(unsigned u) { return __builtin_bit_cast(float, u & 0xffff0000u); }
__device__ __forceinline__ float bf2f(short s) { return __builtin_bit_cast(float, ((unsigned)(unsigned short)s) << 16); }
__device__ __forceinline__ float wave_sum(float v) {
#pragma unroll
    for (int o = 1; o < 64; o <<= 1) v += __shfl_xor(v, o);
    return v;
}
__device__ __forceinline__ float wave_max(float v) {
#pragma unroll
    for (int o = 1; o < 64; o <<= 1) v = fmaxf(v, __shfl_xor(v, o));
    return v;
}
__device__ __forceinline__ float wave_scan_add(float v, int lane) {
#pragma unroll
    for (int o = 1; o < 64; o <<= 1) { const float t = __shfl_up(v, o); if (lane >= o) v += t; }
    return v;
}
__device__ __forceinline__ float wave_scan_max(float v, int lane) {
#pragma unroll
    for (int o = 1; o < 64; o <<= 1) { const float t = __shfl_up(v, o); if (lane >= o) v = fmaxf(v, t); }
    return v;
}
__device__ __forceinline__ float sigmoidf_(float x) { return __builtin_amdgcn_rcpf(1.f + __expf(-x)); }
__device__ __forceinline__ float siluf_(float x) { return x * __builtin_amdgcn_rcpf(1.f + __expf(-x)); }
__device__ __forceinline__ float logsigmoidf_(float x) { return fminf(x, 0.f) - log1pf(__expf(-fabsf(x))); }
__device__ __forceinline__ float softplusf_(float x) { return fmaxf(x, 0.f) + log1pf(__expf(-fabsf(x))); }
__device__ __forceinline__ s16x4 vtr(ldscp p) { return __builtin_bit_cast(s16x4, __builtin_amdgcn_ds_read_tr16_b64_v4i16((LAS v4i16_t*)p)); }
__device__ __forceinline__ bf16x8 cat8(s16x4 lo, s16x4 hi) { return (bf16x8){lo[0], lo[1], lo[2], lo[3], hi[0], hi[1], hi[2], hi[3]}; }
#define BLOCK_SYNC() __syncthreads()
#define LDS_BARRIER() do { asm volatile("s_waitcnt lgkmcnt(0)" ::: "memory"); __builtin_amdgcn_s_barrier(); asm volatile("" ::: "memory"); } while (0)
__device__ __forceinline__ int launder(int v) { asm volatile("" : "+v"(v)); return v; }

namespace pg8 {
constexpr int BM = 256, BK = 64, HALF = 128, HTB = HALF * BK * 2, STAGE_BYTES = 8 * HTB, NXCD = 8, WGM = 8;
__host__ __device__ __forceinline__ int lds_byte(int r, int c) { const int st = (r >> 4) * 2 + (c >> 5), rr = r & 15, cc = c & 31, ob = rr * 64 + cc * 2; return st * 1024 + (ob ^ (((ob >> 9) & 1) << 5)); }
__host__ __device__ __forceinline__ void stage_rc(int b, int& R, int& C) { const int st = b / 1024, sb = b % 1024, swz = sb ^ (((sb >> 9) & 1) << 5); R = (st >> 1) * 16 + swz / 64; C = (st & 1) * 32 + (swz % 64) / 2; }
__host__ __device__ __forceinline__ int perm32(int rho) { const int n = rho >> 4, i = rho & 15; return 8 * (i >> 2) + 4 * n + (i & 3); }

struct Unit { int pm, pn, e; };
struct Gemm { const bf16_t* A; const bf16_t* Bt; int M, N, K; size_t bstride; const int* rowidx; };

struct StaticOrder {
    int nM, nN, nwg, G, c;
    __device__ void init(int M, int N, int G_, int c_) { nM = M / BM; nN = N / BM; nwg = nM * nN; G = G_; c = c_; }
    __device__ bool next(int i, Unit& u) const {
        const long L = (long)i * G + c; if (L >= nwg) return false;
        int wgid = (int)L; { const int q = nwg / NXCD, r = nwg % NXCD, xcd = wgid % NXCD, off = wgid / NXCD; wgid = (xcd < r ? xcd * (q + 1) : r * (q + 1) + (xcd - r) * q) + off; }
        const int nig = WGM * nN, gid = wgid / nig, fm = gid * WGM, gsz = (nM - fm) < WGM ? (nM - fm) : WGM;
        u.pm = fm + ((wgid % nig) % gsz); u.pn = (wgid % nig) / gsz; u.e = 0; return true;
    }
};
template <int NN, bool DYN> struct MoeOrder {
    int ntile, G, c, efix; const int* tile_e;
    __device__ __forceinline__ bool next(int i, Unit& u) const {
        const int L = i * G + c; if (L >= ntile * NN) return false;
        u.pm = L / NN; u.pn = L % NN; u.e = DYN ? tile_e[u.pm] : efix; return true;
    }
};

__device__ __forceinline__ unsigned cvt_pk_bf16(float lo, float hi) { unsigned r; asm volatile("v_cvt_pk_bf16_f32 %0, %1, %2" : "=v"(r) : "v"(lo), "v"(hi)); return r; }

template <class Epi, class Sched, bool GATHER>
__device__ __forceinline__ void gemm_phase(ldsp lds, const Gemm g, const Sched& S, const Epi& E) {
    const int tid = launder((int)threadIdx.x), wid = __builtin_amdgcn_readfirstlane(tid >> 6), lane = tid & 63, wr = wid >> 2, wc = wid & 3, fr = lane & 15, fq = lane >> 4;
    const int K = g.K, nt = K / BK;
    unsigned voffA[2], voffB[2]; int stR[2], stC[2];
#pragma unroll
    for (int i = 0; i < 2; ++i) { int R, C; stage_rc(tid * 16 + i * 8192, R, C); const int Rb = Epi::PERM ? ((R & ~31) + perm32(R & 31)) : R;
        stR[i] = R; stC[i] = C; voffA[i] = (unsigned)(R * K + C) * 2u; voffB[i] = (unsigned)(Rb * K + C) * 2u; }
    const size_t kstep = (size_t)(BK * 2);
    const size_t hstep = (size_t)HALF * K * 2;
    const size_t tstep = 2 * hstep;
    const unsigned ldsw = (unsigned)wid * 1024u;
    const int aoff = lds_byte(wr * 64 + fr, fq * 8), boff = lds_byte(wc * 32 + fr, fq * 8);
#define PG8_SA(b, h) (((b) * 2 + (h)) * HTB)
#define PG8_SB(b, h) ((4 + (b) * 2 + (h)) * HTB)
#define PG8_STAGE(bufoff, gbase, voff) do { _Pragma("unroll") for (int _i = 0; _i < 2; ++_i) \
        __builtin_amdgcn_global_load_lds((const unsigned*)((const char*)(gbase) + (voff)[_i]), (LAS unsigned*)(lds + (bufoff) + ldsw + _i * 8192), 16, 0, 0); } while (0)
#define PG8_LDA(dst, b, h) do { _Pragma("unroll") for (int m = 0; m < 4; ++m) _Pragma("unroll") for (int k = 0; k < 2; ++k) dst[m][k] = *(const LAS bf16x8*)(lds + PG8_SA(b, h) + aoff + m * 2048 + k * 1024); } while (0)
#define PG8_LDB(dst, b, h) do { _Pragma("unroll") for (int n = 0; n < 2; ++n) _Pragma("unroll") for (int k = 0; k < 2; ++k) dst[n][k] = *(const LAS bf16x8*)(lds + PG8_SB(b, h) + boff + n * 2048 + k * 1024); } while (0)
#define PG8_MMA(ai, bj, At, Bt) do { __builtin_amdgcn_s_setprio(1); _Pragma("unroll") for (int m = 0; m < 4; ++m) _Pragma("unroll") for (int n = 0; n < 2; ++n) _Pragma("unroll") for (int k = 0; k < 2; ++k) \
        acc[ai][bj][m][n] = __builtin_amdgcn_mfma_f32_16x16x32_bf16(Bt[n][k], At[m][k], acc[ai][bj][m][n], 0, 0, 0); __builtin_amdgcn_s_setprio(0); } while (0)
#define PG8_WAIT_V(n) asm volatile("s_waitcnt vmcnt(" #n ")" ::: "memory")
#define PG8_WAIT_L(n) asm volatile("s_waitcnt lgkmcnt(" #n ")" ::: "memory")
#define PG8_BAR __builtin_amdgcn_s_barrier()
#define PG8_SCHED __builtin_amdgcn_sched_barrier(0)
    Unit cur, nxt; int ui = 0;
    if (!S.next(0, cur)) return;
    f32x4 acc[2][2][4][2];
#pragma unroll
    for (int a = 0; a < 2; ++a)
#pragma unroll
        for (int b = 0; b < 2; ++b)
#pragma unroll
            for (int m = 0; m < 4; ++m)
#pragma unroll
                for (int n = 0; n < 2; ++n) acc[a][b][m][n] = (f32x4){0.f, 0.f, 0.f, 0.f};
    bf16x8 At[4][2], B0[2][2], B1[2][2];
    unsigned gc[2][2], gn[2][2];
    auto load_g = [&](unsigned (&dst)[2][2], const Unit& u) {
#pragma unroll
        for (int h = 0; h < 2; ++h)
#pragma unroll
            for (int i = 0; i < 2; ++i) { const int src = g.rowidx[u.pm * BM + h * HALF + stR[i]]; dst[h][i] = (unsigned)(src * K + stC[i]) * 2u; }
    };
    const char* cA = GATHER ? (const char*)g.A : (const char*)g.A + (size_t)cur.pm * tstep;
    const char* cB = (const char*)g.Bt + (size_t)cur.e * g.bstride + (size_t)cur.pn * tstep;
#define PG8_STA(bufoff, h, ptr, garr) do { if constexpr (GATHER) { PG8_STAGE(bufoff, ptr, garr[h]); } else { PG8_STAGE(bufoff, (ptr) + (h) * hstep, voffA); } } while (0)
    if constexpr (GATHER) { load_g(gc, cur); }
    PG8_STAGE(PG8_SB(0, 0), cB, voffB); PG8_STAGE(PG8_SB(0, 1), cB + hstep, voffB); PG8_STA(PG8_SA(0, 0), 0, cA, gc); PG8_STA(PG8_SA(0, 1), 1, cA, gc);
    if (wr == 1) PG8_BAR;
    PG8_WAIT_V(2); PG8_BAR;
    PG8_STAGE(PG8_SB(1, 0), cB + kstep, voffB); PG8_STA(PG8_SA(1, 0), 0, cA + kstep, gc); PG8_STAGE(PG8_SB(1, 1), cB + hstep + kstep, voffB);
    PG8_WAIT_V(6); PG8_BAR;
    for (;;) {
        const bool has_next = S.next(ui + 1, nxt);
        const char* nA = GATHER ? (const char*)g.A : (has_next ? (const char*)g.A + (size_t)nxt.pm * tstep : cA);
        const char* nB = has_next ? (const char*)g.Bt + (size_t)nxt.e * g.bstride + (size_t)nxt.pn * tstep : cB;
        if constexpr (GATHER) { if (has_next) load_g(gn, nxt); else {
#pragma unroll
            for (int h = 0; h < 2; ++h)
#pragma unroll
                for (int i = 0; i < 2; ++i) gn[h][i] = gc[h][i]; } }
        for (int t = 0; t < nt; t += 2) {
            const bool last = (t == nt - 2);
            const char* a1 = cA + (size_t)(t + 1) * kstep;
            const char* a2 = last ? nA : cA + (size_t)(t + 2) * kstep; const char* b2 = last ? nB : cB + (size_t)(t + 2) * kstep;
            const char* a3 = a2 + kstep; const char* b3 = b2 + kstep;
#define PG8_STA2(bufoff, h, ptr) do { if constexpr (GATHER) { if (last) { PG8_STAGE(bufoff, ptr, gn[h]); } else { PG8_STAGE(bufoff, ptr, gc[h]); } } else { PG8_STAGE(bufoff, (ptr) + (h) * hstep, voffA); } } while (0)
            PG8_LDB(B0, 0, 0); PG8_LDB(B1, 0, 1); PG8_SCHED; PG8_LDA(At, 0, 0); PG8_STA(PG8_SA(1, 1), 1, a1, gc);
            PG8_WAIT_V(8); PG8_WAIT_L(0); PG8_BAR; PG8_MMA(0, 0, At, B0); PG8_MMA(0, 1, At, B1); PG8_BAR; PG8_SCHED;
            PG8_LDA(At, 0, 1); PG8_STAGE(PG8_SB(0, 0), b2, voffB); PG8_STAGE(PG8_SB(0, 1), b2 + hstep, voffB); PG8_STA2(PG8_SA(0, 0), 0, a2);
            PG8_WAIT_V(8); PG8_WAIT_L(0); PG8_BAR; PG8_MMA(1, 0, At, B0); PG8_MMA(1, 1, At, B1); PG8_BAR; PG8_SCHED;
            PG8_LDB(B0, 1, 0); PG8_LDB(B1, 1, 1); PG8_SCHED; PG8_LDA(At, 1, 0); PG8_STA2(PG8_SA(0, 1), 1, a2);
            PG8_WAIT_V(8); PG8_WAIT_L(0); PG8_BAR; PG8_MMA(0, 0, At, B0); PG8_MMA(0, 1, At, B1); PG8_BAR; PG8_SCHED;
            PG8_LDA(At, 1, 1); PG8_STAGE(PG8_SB(1, 0), b3, voffB); PG8_STAGE(PG8_SB(1, 1), b3 + hstep, voffB); PG8_STA2(PG8_SA(1, 0), 0, a3);
            PG8_WAIT_V(8); PG8_WAIT_L(0); PG8_BAR; PG8_MMA(1, 0, At, B0); PG8_MMA(1, 1, At, B1); PG8_BAR; PG8_SCHED;
        }
        if (wr == 0) PG8_BAR;
        E(acc, cur, wr, wc, fr, fq);
        if (!has_next) break;
#pragma unroll
        for (int a = 0; a < 2; ++a)
#pragma unroll
            for (int b = 0; b < 2; ++b)
#pragma unroll
                for (int m = 0; m < 4; ++m)
#pragma unroll
                    for (int n = 0; n < 2; ++n) acc[a][b][m][n] = (f32x4){0.f, 0.f, 0.f, 0.f};
        cur = nxt; cA = nA; cB = nB; ++ui;
        if constexpr (GATHER) {
#pragma unroll
            for (int h = 0; h < 2; ++h)
#pragma unroll
                for (int i = 0; i < 2; ++i) gc[h][i] = gn[h][i];
        }
        if (wr == 1) PG8_BAR;
    }
    PG8_WAIT_V(0);
    PG8_BAR;
#undef PG8_SA
#undef PG8_SB
#undef PG8_STAGE
#undef PG8_STA
#undef PG8_STA2
#undef PG8_LDA
#undef PG8_LDB
#undef PG8_MMA
#undef PG8_WAIT_V
#undef PG8_WAIT_L
#undef PG8_BAR
#undef PG8_SCHED
}

struct EpiInProj {
    static constexpr bool PERM = true;
    bf16_t *q, *k, *v, *oz, *xbc; float* gates;
    __device__ __forceinline__ void operator()(const f32x4 (&acc)[2][2][4][2], const Unit& u, int wr, int wc, int fr, int fq) const {
        const int row0 = u.pm * BM + wr * 64 + fr, pn = u.pn;
        bf16_t* base; int ld, colt;
        if (pn < 2) { base = q; ld = 512; colt = pn * 256; }
        else if (pn < 4) { base = k; ld = 512; colt = (pn - 2) * 256; }
        else if (pn < 8) { base = v; ld = 1024; colt = (pn - 4) * 256; }
        else if (pn < 16) { base = oz; ld = 2048; colt = (pn - 8) * 256; }
        else { base = xbc; ld = 2048; colt = (pn - 16) * 256; }
        const int col0 = colt + wc * 32 + 8 * fq;
#pragma unroll
        for (int ai = 0; ai < 2; ++ai)
#pragma unroll
            for (int m = 0; m < 4; ++m) { bf16_t* rowp = base + (size_t)(row0 + ai * HALF + m * 16) * ld + col0;
#pragma unroll
                for (int bj = 0; bj < 2; ++bj) { const f32x4 v0 = acc[ai][bj][m][0], v1 = acc[ai][bj][m][1];
                    u32x4 w; w.x = cvt_pk_bf16(v0[0], v0[1]); w.y = cvt_pk_bf16(v0[2], v0[3]); w.z = cvt_pk_bf16(v1[0], v1[1]); w.w = cvt_pk_bf16(v1[2], v1[3]);
                    *(u32x4*)(rowp + bj * HALF) = w; } }
    }
};
struct EpiResF32 {
    static constexpr bool PERM = false;
    const float* res; float* out; int ldc; float alpha;
    __device__ __forceinline__ void operator()(const f32x4 (&acc)[2][2][4][2], const Unit& u, int wr, int wc, int fr, int fq) const {
        const int col0 = u.pn * BM + wc * 32 + 4 * fq;
#pragma unroll
        for (int ai = 0; ai < 2; ++ai)
#pragma unroll
            for (int m = 0; m < 4; ++m) { const size_t off = (size_t)(u.pm * BM + ai * HALF + wr * 64 + m * 16 + fr) * ldc + col0;
                f32x4 r[2][2];
#pragma unroll
                for (int bj = 0; bj < 2; ++bj)
#pragma unroll
                    for (int n = 0; n < 2; ++n) r[bj][n] = *(const f32x4*)(res + off + bj * HALF + n * 16);
#pragma unroll
                for (int bj = 0; bj < 2; ++bj)
#pragma unroll
                    for (int n = 0; n < 2; ++n) *(f32x4*)(out + off + bj * HALF + n * 16) = acc[ai][bj][m][n] + r[bj][n] * alpha;
                asm volatile("" ::: "memory"); }
    }
};
struct EpiF32 {
    static constexpr bool PERM = false;
    float* out; int ldc;
    __device__ __forceinline__ void operator()(const f32x4 (&acc)[2][2][4][2], const Unit& u, int wr, int wc, int fr, int fq) const {
        const int col0 = u.pn * BM + wc * 32 + 4 * fq;
#pragma unroll
        for (int ai = 0; ai < 2; ++ai)
#pragma unroll
            for (int m = 0; m < 4; ++m) { float* rowp = out + (size_t)(u.pm * BM + ai * HALF + wr * 64 + m * 16 + fr) * ldc + col0;
#pragma unroll
                for (int bj = 0; bj < 2; ++bj)
#pragma unroll
                    for (int n = 0; n < 2; ++n) *(f32x4*)(rowp + bj * HALF + n * 16) = acc[ai][bj][m][n];
                asm volatile("" ::: "memory"); }
    }
};
struct EpiSwiGLU {
    static constexpr bool PERM = true;
    bf16_t* act;
    __device__ __forceinline__ void operator()(const f32x4 (&acc)[2][2][4][2], const Unit& u, int wr, int wc, int fr, int fq) const {
        const int row0 = u.pm * BM + wr * 64 + fr, col0 = u.pn * 128 + wc * 32 + 8 * fq;
#pragma unroll
        for (int ai = 0; ai < 2; ++ai)
#pragma unroll
            for (int m = 0; m < 4; ++m) { bf16_t* rowp = act + (size_t)(row0 + ai * HALF + m * 16) * DE + col0;
                float r[8];
#pragma unroll
                for (int n = 0; n < 2; ++n)
#pragma unroll
                    for (int j = 0; j < 4; ++j) { const float gt = acc[ai][0][m][n][j], up = acc[ai][1][m][n][j]; r[n * 4 + j] = gt * __builtin_amdgcn_rcpf(1.f + __expf(-gt)) * up; }
                u32x4 w; w.x = cvt_pk_bf16(r[0], r[1]); w.y = cvt_pk_bf16(r[2], r[3]); w.z = cvt_pk_bf16(r[4], r[5]); w.w = cvt_pk_bf16(r[6], r[7]);
                *(u32x4*)rowp = w; asm volatile("" ::: "memory"); }
    }
};
struct EpiDownY {
    static constexpr bool PERM = true;
    bf16_t* Y; const int* rowy; const float* rowgate;
    __device__ __forceinline__ void operator()(const f32x4 (&acc)[2][2][4][2], const Unit& u, int wr, int wc, int fr, int fq) const {
        const int row0 = u.pm * BM + wr * 64 + fr, col0 = u.pn * BM + wc * 32 + 8 * fq;
#pragma unroll
        for (int ai = 0; ai < 2; ++ai) {
            int yrv[4]; float gtv[4];
#pragma unroll
            for (int m = 0; m < 4; ++m) { const int row = row0 + ai * HALF + m * 16; yrv[m] = rowy[row]; gtv[m] = rowgate[row]; }
#pragma unroll
            for (int m = 0; m < 4; ++m) { const int yr = yrv[m]; const float gt = gtv[m];
                bf16_t* rowp = Y + (size_t)yr * DM + col0;
#pragma unroll
                for (int bj = 0; bj < 2; ++bj) { const f32x4 v0 = acc[ai][bj][m][0] * gt, v1 = acc[ai][bj][m][1] * gt;
                    u32x4 w; w.x = cvt_pk_bf16(v0[0], v0[1]); w.y = cvt_pk_bf16(v0[2], v0[3]); w.z = cvt_pk_bf16(v1[0], v1[1]); w.w = cvt_pk_bf16(v1[2], v1[3]);
                    *(u32x4*)(rowp + bj * HALF) = w; }
                asm volatile("" ::: "memory"); }
        }
    }
};
}

struct Args { const float* in[24]; float* out; unsigned char* ws; int ph_lo, ph_hi; };
typedef const __attribute__((address_space(4))) Args& ArgsRef;
enum { I_X = 0, I_WIN, I_MLIB, I_MLFB, I_MLNW, I_CONVW, I_CONVB, I_DTB, I_ALOG, I_DSKIP, I_SSMNW, I_WOUT, I_LN1G, I_LN1B, I_WR, I_RB, I_WEG, I_WEU, I_WED, I_WSG, I_WSU, I_WSD, I_LN2G, I_LN2B };

__device__ __forceinline__ void transpose_item(const float* W, int ldw, int k0, int c0, bf16_t* WT, int ldk, int r0, float scale, LAS float* scr, int lane) {
#pragma unroll 8
    for (int i = 0; i < 32; ++i) { const int kk = 2 * i + (lane >> 5); scr[kk * 33 + (lane & 31)] = W[(size_t)(k0 + kk) * ldw + c0 + (lane & 31)]; }
    asm volatile("s_waitcnt lgkmcnt(0)" ::: "memory");
    const int c = lane & 7;
#pragma unroll
    for (int j = 0; j < 4; ++j) { const int n = (lane >> 3) + 8 * j; const LAS float* s = scr + (8 * c) * 33 + n;
        u32x4 o; o.x = pk2(s[0 * 33] * scale, s[1 * 33] * scale); o.y = pk2(s[2 * 33] * scale, s[3 * 33] * scale); o.z = pk2(s[4 * 33] * scale, s[5 * 33] * scale); o.w = pk2(s[6 * 33] * scale, s[7 * 33] * scale);
        *(u32x4*)(WT + (size_t)(r0 + n) * ldk + k0 + 8 * c) = o; }
    asm volatile("s_waitcnt lgkmcnt(0)" ::: "memory");
}

__device__ __forceinline__ void phase_p0(ArgsRef a, ldsp lds) {
    const int tid = launder((int)threadIdx.x), lane = tid & 63, wave = tid >> 6, G = gridDim.x;
    const int gw = blockIdx.x * 8 + wave, NGW = G * 8;
    LAS float* scr = (LAS float*)(lds + wave * 8448);
    const float* x = a.in[I_X]; bf16_t* xb = (bf16_t*)(a.ws + WS_XB);
    bf16_t* wint = (bf16_t*)(a.ws + WS_WIN); bf16_t* woutt = (bf16_t*)(a.ws + WS_WOUT);
    constexpr int NI_WIN = 192 * 16, NI_WOUT = 32 * 32;
    for (int it = gw; it < NI_WIN + NI_WOUT; it += NGW) {
        if (it < NI_WIN) {
            const int cb = it % 192, kb = it / 192; const int dr = cb * 32;
            int sc; float scale = 1.f;
            if (dr < 512) sc = dr; else if (dr < 1024) { sc = dr; scale = 0.08838834764831845f; } else if (dr < 3072) sc = dr; else sc = dr + 16;
            transpose_item(a.in[I_WIN], NIN, kb * 64, sc, wint, DM, dr, scale, scr, lane);
        } else {
            const int r = it - NI_WIN; const int cb = r % 32, kb = r / 32;
            transpose_item(a.in[I_WOUT], DM, kb * 64, cb * 32, woutt, 2048, cb * 32, 1.f, scr, lane);
        }
    }
    LDS_BARRIER();
    constexpr int WP = 2064;
    for (int e = tid; e < 48 * DM; e += 512) { const int k = e / 48, n = e % 48; const int col = n < 16 ? 3072 + n : 6160 + (n - 16);
        *(LAS unsigned short*)(lds + n * WP + k * 2) = (unsigned short)f2bf(a.in[I_WIN][(size_t)k * NIN + col]); }
    LDS_BARRIER();
    float* gates = (float*)(a.ws + WS_GATES);
    const int fr = lane & 15, fq = lane >> 4;
    for (int grp = gw; grp < T / 16; grp += NGW) {
        const float* xr = x + (size_t)(grp * 16 + fr) * DM + 8 * fq; bf16_t* xo = xb + (size_t)(grp * 16 + fr) * DM + 8 * fq;
        f32x4 acc[3];
#pragma unroll
        for (int nt = 0; nt < 3; ++nt) acc[nt] = (f32x4){0.f, 0.f, 0.f, 0.f};
#pragma unroll 1
        for (int kc = 0; kc < 4; ++kc) {
            f32x4 v[8][2];
#pragma unroll
            for (int ks = 0; ks < 8; ++ks) { v[ks][0] = *(const f32x4*)(xr + 256 * kc + 32 * ks); v[ks][1] = *(const f32x4*)(xr + 256 * kc + 32 * ks + 4); }
#pragma unroll
            for (int ks = 0; ks < 8; ++ks) {
                u32x4 pk; pk.x = pk2(v[ks][0][0], v[ks][0][1]); pk.y = pk2(v[ks][0][2], v[ks][0][3]); pk.z = pk2(v[ks][1][0], v[ks][1][1]); pk.w = pk2(v[ks][1][2], v[ks][1][3]);
                *(u32x4*)(xo + 256 * kc + 32 * ks) = pk;
                const bf16x8 af = __builtin_bit_cast(bf16x8, pk);
#pragma unroll
                for (int nt = 0; nt < 3; ++nt) { const bf16x8 wf = *(const LAS bf16x8*)(lds + (16 * nt + fr) * WP + (256 * kc + 32 * ks + 8 * fq) * 2);
                    acc[nt] = __builtin_amdgcn_mfma_f32_16x16x32_bf16(wf, af, acc[nt], 0, 0, 0); }
            }
        }
#pragma unroll
        for (int nt = 0; nt < 3; ++nt) *(f32x4*)(gates + (size_t)(grp * 16 + fr) * 48 + 16 * nt + 4 * fq) = acc[nt];
    }
    LDS_BARRIER();
}

__device__ __forceinline__ void chunk_state_gemm(ldscp P, int pitchP, ldscp Q, int pitchQ, const LAS float* w, bf16_t* out, int lane) {
    const int g = lane >> 4, q = (lane & 15) >> 2, p = lane & 3, fr = lane & 15;
    f32x4 acc[8][4];
#pragma unroll
    for (int i = 0; i < 8; ++i)
#pragma unroll
        for (int j = 0; j < 4; ++j) acc[i][j] = (f32x4){0.f, 0.f, 0.f, 0.f};
#pragma unroll 1
    for (int ks = 0; ks < 4; ++ks) {
        const int srow = 32 * ks + 8 * g;
        const f32x4 w0 = *(const LAS f32x4*)(w + srow), w1 = *(const LAS f32x4*)(w + srow + 4);
        bf16x8 qf[4];
#pragma unroll
        for (int jt = 0; jt < 4; ++jt) {
            ldscp ad = Q + (srow + q) * pitchQ + (16 * jt + 4 * p) * 2;
            const s16x4 lo = vtr(ad), hi = vtr(ad + 4 * pitchQ);
            u32x4 pk; pk.x = pk2(bf2f(lo[0]) * w0[0], bf2f(lo[1]) * w0[1]); pk.y = pk2(bf2f(lo[2]) * w0[2], bf2f(lo[3]) * w0[3]);
            pk.z = pk2(bf2f(hi[0]) * w1[0], bf2f(hi[1]) * w1[1]); pk.w = pk2(bf2f(hi[2]) * w1[2], bf2f(hi[3]) * w1[3]);
            qf[jt] = __builtin_bit_cast(bf16x8, pk);
        }
#pragma unroll
        for (int it = 0; it < 8; ++it) {
            ldscp ad = P + (srow + q) * pitchP + (16 * it + 4 * p) * 2;
            const bf16x8 pf = cat8(vtr(ad), vtr(ad + 4 * pitchP));
#pragma unroll
            for (int jt = 0; jt < 4; ++jt) acc[it][jt] = __builtin_amdgcn_mfma_f32_16x16x32_bf16(pf, qf[jt], acc[it][jt], 0, 0, 0);
        }
    }
#pragma unroll
    for (int it = 0; it < 8; ++it)
#pragma unroll
        for (int jt = 0; jt < 4; ++jt) { u32x2 o; o.x = pk2(acc[it][jt][0], acc[it][jt][1]); o.y = pk2(acc[it][jt][2], acc[it][jt][3]);
            *(u32x2*)(out + (size_t)(16 * jt + fr) * 128 + 16 * it + 4 * g) = o; }
}

constexpr int P128 = 288, P256 = 544;
constexpr int P128R = 272;

struct MlVec { float ig[2], bb[2], colw[2]; float g; };
__device__ __forceinline__ MlVec ml_chunk_vec(const float* gates, int row0, int d, int h, float ib, float fb, int lane) {
    MlVec r; float lf[2];
#pragma unroll
    for (int j = 0; j < 2; ++j) { const int u = 2 * lane + j, t = d ? 127 - u : u; const float* gr = gates + (size_t)(row0 + t) * 48;
        r.ig[j] = gr[d * 4 + h] + ib; lf[j] = logsigmoidf_(gr[8 + d * 4 + h] + fb); }
    const float loc1 = lf[0] + lf[1]; const float s = wave_scan_add(loc1, lane); const float ex = s - loc1;
    r.bb[0] = ex + lf[0]; r.bb[1] = s; r.g = __shfl(s, 63);
    r.colw[0] = r.ig[0] - r.bb[0]; r.colw[1] = r.ig[1] - r.bb[1];
    return r;
}

__device__ __forceinline__ void phase_ml_states(ArgsRef a, ldsp lds) {
    const int tid = launder((int)threadIdx.x), lane = tid & 63, wave = __builtin_amdgcn_readfirstlane(tid >> 6), G = gridDim.x;
    const bf16_t* Kb = (const bf16_t*)(a.ws + WS_K); const bf16_t* Vb = (const bf16_t*)(a.ws + WS_V);
    const float* gates = (const float*)(a.ws + WS_GATES); float* ms = (float*)(a.ws + WS_MSTAT);
    bf16_t* ST = (bf16_t*)a.out;
    ldsp Kt = lds, Vt = lds + 36864; LAS float* wv = (LAS float*)(lds + 106496);
    for (int item = blockIdx.x; item < BATCH * 4 * NC; item += G) {
        const int c = item % NC, h = (item / NC) % 4, b = item / (NC * 4); const int row0 = b * SEQ + c * CH;
#pragma unroll
        for (int i = 0; i < 4; ++i) { const int id = tid + 512 * i, r = id >> 4, ch = id & 15;
            *(LAS u32x4*)(Kt + r * P128 + ch * 16) = *(const u32x4*)(Kb + (size_t)(row0 + r) * 512 + h * 128 + ch * 8); }
#pragma unroll
        for (int i = 0; i < 8; ++i) { const int id = tid + 512 * i, r = id >> 5, ch = id & 31;
            *(LAS u32x4*)(Vt + r * P256 + ch * 16) = *(const u32x4*)(Vb + (size_t)(row0 + r) * 1024 + h * 256 + ch * 8); }
        if (wave < 2) {
            const int d = wave; const MlVec v = ml_chunk_vec(gates, row0, d, h, a.in[I_MLIB][d * 4 + h], a.in[I_MLFB][d * 4 + h], lane);
            const float a0 = v.g + v.colw[0], a1 = v.g + v.colw[1]; const float ml = wave_max(fmaxf(a0, a1));
#pragma unroll
            for (int j = 0; j < 2; ++j) { const int u = 2 * lane + j, t = d ? 127 - u : u; wv[d * 128 + t] = __expf((j ? a1 : a0) - ml); }
            if (lane == 0) { const int chain = (b * 4 + h) * 2 + d; ms[MS_GM + (chain * 32 + c) * 2] = v.g; ms[MS_GM + (chain * 32 + c) * 2 + 1] = ml; }
        }
        LDS_BARRIER();
        if (tid < 256) { const int d = tid >> 7, dk = tid & 127; float s = 0.f;
            for (int r = 0; r < 128; ++r) s += wv[d * 128 + r] * bf2f(*(const LAS short*)(Kt + r * P128 + dk * 2));
            ms[MS_U + (size_t)(((b * 4 + h) * 2 + d) * 32 + c) * 128 + dk] = s; }
        { const int d = wave >> 2, qd = wave & 3;
          bf16_t* out = ST + ((size_t)(((b * 4 + h) * 2 + d) * 32 + c) * 256 + 64 * qd) * 128;
          chunk_state_gemm(Kt, P128, Vt + 64 * qd * 2, P256, wv + d * 128, out, lane); }
        LDS_BARRIER();
    }
}

template <bool ML, bool REV>
__device__ __forceinline__ void scan_chain(const float* ms, const bf16_t* base, bf16_t* wbase, int chain, float (&st)[8], float& m) {
    constexpr int E = ML ? 32768 : 8192;
#pragma unroll 1
    for (int half = 0; half < 2; ++half) {
        const int cb0 = (REV ? 1 - half : half) * 16;
        u32x4 buf[16]; float dcy[16], scl[16];
#pragma unroll
        for (int j = 0; j < 16; ++j) buf[j] = *(const u32x4*)(base + (size_t)(cb0 + j) * E);
#pragma unroll
        for (int j = 0; j < 16; ++j) { const int c = cb0 + j;
            if (ML) { dcy[j] = ms[MS_GM + (chain * 32 + c) * 2]; scl[j] = ms[MS_GM + (chain * 32 + c) * 2 + 1]; }
            else { dcy[j] = ms[MS_SD + chain * 32 + c]; scl[j] = 1.f; } }
#pragma unroll
        for (int step = 0; step < 16; ++step) {
            const int j = REV ? 15 - step : step; const int c = cb0 + j;
            const u32x4 cur = buf[j];
            float decay = dcy[j], scale = scl[j];
            if (ML) { const float g = decay, ml = scale; const float mn = fmaxf(g + m, ml); decay = __expf(g + m - mn); scale = __expf(ml - mn); m = mn; }
            u32x4 o; o.x = pk2(st[0], st[1]); o.y = pk2(st[2], st[3]); o.z = pk2(st[4], st[5]); o.w = pk2(st[6], st[7]);
            *(u32x4*)(wbase + (size_t)c * E) = o;
            st[0] = decay * st[0] + scale * bflo(cur.x); st[1] = decay * st[1] + scale * bfhi(cur.x);
            st[2] = decay * st[2] + scale * bflo(cur.y); st[3] = decay * st[3] + scale * bfhi(cur.y);
            st[4] = decay * st[4] + scale * bflo(cur.z); st[5] = decay * st[5] + scale * bfhi(cur.z);
            st[6] = decay * st[6] + scale * bflo(cur.w); st[7] = decay * st[7] + scale * bfhi(cur.w);
        }
    }
}

template <bool ML>
__device__ __forceinline__ void phase_scan(ArgsRef a, bool dry = false) {
    const int tid = launder((int)threadIdx.x), G = gridDim.x;
    float* ms = (float*)(a.ws + WS_MSTAT); bf16_t* ST = (bf16_t*)a.out;
    constexpr int E = ML ? 32768 : 8192, VPC = E / 8, NCHAIN = ML ? 64 : 256, NV = NCHAIN * VPC, NX = ML ? 64 * 128 : 0;
    for (int it = blockIdx.x * 512 + tid; it < (dry ? NV / 2 : NV + NX); it += G * 512) {
        if (it < NV) {
            const int chain = it / VPC, vi = it % VPC, d = chain & 1;
            float st[8];
#pragma unroll
            for (int j = 0; j < 8; ++j) st[j] = 0.f;
            float m = NEG_BIG;
            bf16_t* base = ST + (size_t)chain * 32 * E + vi * 8;
            bf16_t* wbase = dry ? (bf16_t*)(a.ws + WS_XB) + (base - ST) : base;
            if (d == 0) scan_chain<ML, false>(ms, base, wbase, chain, st, m);
            else scan_chain<ML, true>(ms, base, wbase, chain, st, m);
        } else if (ML) {
            const int idx = it - NV, chain = idx >> 7, dk = idx & 127, d = chain & 1;
            float n = 0.f, m = NEG_BIG;
            for (int step = 0; step < 32; ++step) {
                const int c = d ? 31 - step : step;
                const float g = ms[MS_GM + (chain * 32 + c) * 2], ml = ms[MS_GM + (chain * 32 + c) * 2 + 1]; const float mn = fmaxf(g + m, ml);
                const float decay = __expf(g + m - mn), scale = __expf(ml - mn);
                float* up = ms + MS_U + (size_t)(chain * 32 + c) * 128 + dk; const float u = *up; *up = n;
                if (dk == 0) ms[MS_MP + chain * 32 + c] = m;
                n = decay * n + scale * u; m = mn;
            }
        }
    }
}

__device__ __forceinline__ void phase_ml_out(ArgsRef a, ldsp lds, int dry = 0) {
    const int tid = launder((int)threadIdx.x), lane = tid & 63, wave = __builtin_amdgcn_readfirstlane(tid >> 6), G = gridDim.x;
    const int fr_ = lane & 15, fq_ = lane >> 4;
    const bf16_t* Qb = (const bf16_t*)(a.ws + WS_Q); const bf16_t* Kb = (const bf16_t*)(a.ws + WS_K); const bf16_t* Vb = (const bf16_t*)(a.ws + WS_V);
    bf16_t* OZ = (bf16_t*)(a.ws + WS_OZ);
    const float* gates = (const float*)(a.ws + WS_GATES); const float* ms = (const float*)(a.ws + WS_MSTAT);
    const bf16_t* ST = (const bf16_t*)a.out;
    ldsp Qt = lds, Kt = lds + 36864, Xt = lds + 73728;
    LAS float* vec = (LAS float*)(lds + 147456);
    LAS float* npv = vec + 1280;
    LAS float* nwl = npv + 256;
    for (int i = tid; i < 1024; i += 512) nwl[i] = a.in[I_MLNW][i];
    for (int item = blockIdx.x; item < BATCH * 4 * NC; item += G) {
        const int c = item % NC, h = (item / NC) % 4, b = item / (NC * 4); const int row0 = b * SEQ + c * CH;
        const int chain0 = (b * 4 + h) * 2;
        const int fr = launder(fr_), fq = launder(fq_), g4 = fq, q4 = fr >> 2, p4 = fr & 3;
#pragma unroll
        for (int i = 0; i < 4; ++i) { const int id = tid + 512 * i, r = id >> 4, ch = id & 15;
            *(LAS u32x4*)(Qt + r * P128R + ch * 16) = *(const u32x4*)(Qb + (size_t)(row0 + r) * 512 + h * 128 + ch * 8);
            *(LAS u32x4*)(Kt + r * P128R + ch * 16) = *(const u32x4*)(Kb + (size_t)(row0 + r) * 512 + h * 128 + ch * 8); }
        { const bf16_t* cp = ST + (size_t)((chain0 + 0) * 32 + c) * 32768;
#pragma unroll
          for (int i = 0; i < 8; ++i) { const int id = tid + 512 * i, r = id >> 4, ch = id & 15;
              *(LAS u32x4*)(Xt + r * P128R + ch * 16) = *(const u32x4*)(cp + (size_t)r * 128 + ch * 8); } }
        if (wave < 2) {
            const int d = wave; const MlVec v = ml_chunk_vec(gates, row0, d, h, a.in[I_MLIB][d * 4 + h], a.in[I_MLFB][d * 4 + h], lane);
            const float mp = ms[MS_MP + (chain0 + d) * 32 + c];
            const float cm1 = fmaxf(v.colw[0], v.colw[1]); const float sc = wave_scan_max(cm1, lane); float ex = __shfl_up(sc, 1); if (lane == 0) ex = NEG_BIG;
            const float cmax[2] = {fmaxf(ex, v.colw[0]), sc};
#pragma unroll
            for (int j = 0; j < 2; ++j) { const int u = 2 * lane + j, t = d ? 127 - u : u; const float ro = fmaxf(mp, cmax[j]);
                LAS float* vd = vec + d * 640;
                vd[t] = v.colw[j]; vd[128 + t] = ro; vd[256 + t] = __expf(mp - ro); vd[384 + t] = __expf(-(v.bb[j] + ro)); }
        } else if (wave < 6) {
            const int i2 = tid - 128; const int d = i2 >> 7, dk = i2 & 127; npv[d * 128 + dk] = ms[MS_U + (size_t)((chain0 + d) * 32 + c) * 128 + dk];
        }
        LDS_BARRIER();
        if (dry == 2) { LDS_BARRIER(); continue; }

        { const int pr = tid >> 1, part = tid & 1, d = pr >> 7, t = pr & 127; float s = 0.f;
          for (int k = 0; k < 64; ++k) { const int dk = part * 64 + k; s += bf2f(*(const LAS short*)(Qt + t * P128R + dk * 2)) * npv[d * 128 + dk]; }
          s += __shfl_xor(s, 1); if (part == 0) vec[d * 640 + 512 + t] = s; }
        f32x4 sacc[8];
#pragma unroll
        for (int i = 0; i < 8; ++i) sacc[i] = (f32x4){0.f, 0.f, 0.f, 0.f};
        bf16x8 qf[4];
#pragma unroll
        for (int ks = 0; ks < 4; ++ks) qf[ks] = *(const LAS bf16x8*)(Qt + (16 * wave + fr) * P128R + (32 * ks + 8 * fq) * 2);
#pragma unroll
        for (int ks = 0; ks < 4; ++ks)
#pragma unroll
            for (int i = 0; i < 8; ++i) { const bf16x8 kf = *(const LAS bf16x8*)(Kt + (16 * i + fr) * P128R + (32 * ks + 8 * fq) * 2);
                sacc[i] = __builtin_amdgcn_mfma_f32_16x16x32_bf16(kf, qf[ks], sacc[i], 0, 0, 0); }
        LDS_BARRIER();
        if (dry == 3) { asm volatile("" :: "v"(sacc[0]), "v"(sacc[1]), "v"(sacc[2]), "v"(sacc[3]), "v"(sacc[4]), "v"(sacc[5]), "v"(sacc[6]), "v"(sacc[7])); LDS_BARRIER(); continue; }
        const int t = 16 * wave + fr;
        const float rof = vec[128 + t], rob = vec[640 + 128 + t];
        float rsf = 0.f, rsb = 0.f;
#pragma unroll
        for (int i = 0; i < 8; ++i) {
            if (i < wave) { const f32x4 cwf = *(const LAS f32x4*)(vec + 16 * i + 4 * fq);
#pragma unroll
                for (int r = 0; r < 4; ++r) rsf += sacc[i][r] * __expf(cwf[r] - rof); }
            else if (i > wave) { const f32x4 cwb = *(const LAS f32x4*)(vec + 640 + 16 * i + 4 * fq);
#pragma unroll
                for (int r = 0; r < 4; ++r) rsb += sacc[i][r] * __expf(cwb[r] - rob); }
            else { const f32x4 cwf = *(const LAS f32x4*)(vec + 16 * i + 4 * fq), cwb = *(const LAS f32x4*)(vec + 640 + 16 * i + 4 * fq);
#pragma unroll
                for (int r = 0; r < 4; ++r) { const int s = 16 * i + 4 * fq + r; const float sv = sacc[i][r];
                    float ef = __expf(fminf(cwf[r] - rof, 0.f)), eb = __expf(fminf(cwb[r] - rob, 0.f));
                    ef = (s <= t) ? ef : 0.f; eb = (s >= t) ? eb : 0.f;
                    rsf += sv * ef; rsb += sv * eb; } }
        }
        rsf += __shfl_xor(rsf, 16); rsf += __shfl_xor(rsf, 32); rsb += __shfl_xor(rsb, 16); rsb += __shfl_xor(rsb, 32);
        const float iwf = vec[256 + t], iwb = vec[640 + 256 + t];
        const float denf = rsf + iwf * vec[512 + t], denb = rsb + iwb * vec[640 + 512 + t];
        const float rinvf = 1.f / fmaxf(fabsf(denf), vec[384 + t]), rinvb = 1.f / fmaxf(fabsf(denb), vec[640 + 384 + t]);
        const float cf = iwf * rinvf, cb = iwb * rinvb;
        asm volatile("" ::: "memory");
        { const int fq2 = launder(fq), t2 = launder(t);
#pragma unroll
        for (int i = 0; i < 8; ++i) { float pv[4];
            if (i < wave) { const f32x4 cwf = *(const LAS f32x4*)(vec + 16 * i + 4 * fq2);
#pragma unroll
                for (int r = 0; r < 4; ++r) pv[r] = sacc[i][r] * (__expf(cwf[r] - rof) * rinvf); }
            else if (i > wave) { const f32x4 cwb = *(const LAS f32x4*)(vec + 640 + 16 * i + 4 * fq2);
#pragma unroll
                for (int r = 0; r < 4; ++r) pv[r] = sacc[i][r] * (__expf(cwb[r] - rob) * rinvb); }
            else { const f32x4 cwf = *(const LAS f32x4*)(vec + 16 * i + 4 * fq2), cwb = *(const LAS f32x4*)(vec + 640 + 16 * i + 4 * fq2);
#pragma unroll
                for (int r = 0; r < 4; ++r) { const int s = 16 * i + 4 * fq2 + r;
                    float ef = __expf(fminf(cwf[r] - rof, 0.f)), eb = __expf(fminf(cwb[r] - rob, 0.f));
                    ef = (s <= t2) ? ef : 0.f; eb = (s >= t2) ? eb : 0.f;
                    pv[r] = sacc[i][r] * (ef * rinvf + eb * rinvb); } }
            u32x2 o; o.x = pk2(pv[0], pv[1]); o.y = pk2(pv[2], pv[3]);
            *(LAS u32x2*)(Kt + t2 * P128R + (16 * i + 4 * fq2) * 2) = o; } }
        asm volatile("" ::: "memory");
        f32x4 hacc[16];
#pragma unroll
        for (int n = 0; n < 16; ++n) hacc[n] = (f32x4){0.f, 0.f, 0.f, 0.f};
#pragma unroll
        for (int nh = 0; nh < 2; ++nh) {
#pragma unroll
            for (int ks = 0; ks < 4; ++ks)
#pragma unroll
                for (int n = 8 * nh; n < 8 * nh + 8; ++n) { const bf16x8 cfr = *(const LAS bf16x8*)(Xt + (16 * n + fr) * P128R + (32 * ks + 8 * fq) * 2);
                    hacc[n] = __builtin_amdgcn_mfma_f32_16x16x32_bf16(cfr, qf[ks], hacc[n], 0, 0, 0); }
            asm volatile("" ::: "memory");
        }
#pragma unroll
        for (int n = 0; n < 16; ++n) hacc[n] = hacc[n] * cf;
        LDS_BARRIER();
        if (dry == 4) {
#pragma unroll
            for (int n = 0; n < 16; ++n) asm volatile("" :: "v"(hacc[n]));
            continue; }
        { const bf16_t* cp = ST + (size_t)((chain0 + 1) * 32 + c) * 32768;
#pragma unroll
          for (int i = 0; i < 8; ++i) { const int id = tid + 512 * i, r = id >> 4, ch = id & 15;
              *(LAS u32x4*)(Xt + r * P128R + ch * 16) = *(const u32x4*)(cp + (size_t)r * 128 + ch * 8); } }
        LDS_BARRIER();
#pragma unroll
        for (int nh = 0; nh < 2; ++nh) {
            f32x4 tacc[8];
#pragma unroll
            for (int n = 0; n < 8; ++n) tacc[n] = (f32x4){0.f, 0.f, 0.f, 0.f};
#pragma unroll
            for (int ks = 0; ks < 4; ++ks)
#pragma unroll
                for (int n = 0; n < 8; ++n) { const bf16x8 cfr = *(const LAS bf16x8*)(Xt + (16 * (8 * nh + n) + fr) * P128R + (32 * ks + 8 * fq) * 2);
                    tacc[n] = __builtin_amdgcn_mfma_f32_16x16x32_bf16(cfr, qf[ks], tacc[n], 0, 0, 0); }
#pragma unroll
            for (int n = 0; n < 8; ++n) hacc[8 * nh + n] = hacc[8 * nh + n] + tacc[n] * cb;
            asm volatile("" ::: "memory");
        }
        LDS_BARRIER();
        if (dry == 5) {
#pragma unroll
            for (int n = 0; n < 16; ++n) asm volatile("" :: "v"(hacc[n]));
            continue; }
#pragma unroll
        for (int i = 0; i < 8; ++i) { const int id = tid + 512 * i, r = id >> 5, ch = id & 31;
            *(LAS u32x4*)(Xt + r * P256 + ch * 16) = *(const u32x4*)(Vb + (size_t)(row0 + r) * 1024 + h * 256 + ch * 8); }
        LDS_BARRIER();
#pragma unroll
        for (int ks = 0; ks < 4; ++ks) {
            const bf16x8 pf = *(const LAS bf16x8*)(Kt + t * P128R + (32 * ks + 8 * fq) * 2);
#pragma unroll
            for (int n = 0; n < 16; ++n) { ldscp ad = Xt + (32 * ks + 8 * g4 + q4) * P256 + (16 * n + 4 * p4) * 2;
                const bf16x8 vf = cat8(vtr(ad), vtr(ad + 4 * P256));
                hacc[n] = __builtin_amdgcn_mfma_f32_16x16x32_bf16(vf, pf, hacc[n], 0, 0, 0); }
        }
        if (dry == 6) {
#pragma unroll
            for (int n = 0; n < 16; ++n) asm volatile("" :: "v"(hacc[n]));
            LDS_BARRIER(); continue; }
        float s1 = 0.f;
#pragma unroll
        for (int n = 0; n < 16; ++n) s1 += (hacc[n][0] + hacc[n][1]) + (hacc[n][2] + hacc[n][3]);
        s1 += __shfl_xor(s1, 16); s1 += __shfl_xor(s1, 32);
        const float mu = s1 * (1.f / 256.f); float s2 = 0.f;
#pragma unroll
        for (int n = 0; n < 16; ++n) { const f32x4 dd = hacc[n] - mu; s2 += (dd[0] * dd[0] + dd[1] * dd[1]) + (dd[2] * dd[2] + dd[3] * dd[3]); }
        s2 += __shfl_xor(s2, 16); s2 += __shfl_xor(s2, 32);
        const float rstd = 1.f / sqrtf(s2 * (1.f / 256.f) + LN_EPS);
        bf16_t* orow = OZ + (size_t)(row0 + t) * 2048 + h * 256;
        u32x2 ovv[16];
#pragma unroll
        for (int n = 0; n < 16; ++n) ovv[n] = *(const u32x2*)(orow + 16 * n + 4 * fq);
        bf16_t* owr = dry ? (bf16_t*)(a.ws + WS_XB) + (size_t)(row0 + t) * 1024 + h * 256 : orow;
        const LAS float* nw = nwl + h * 256;
#pragma unroll
        for (int n = 0; n < 16; ++n) { const int dv = 16 * n + 4 * fq; const u32x2 ov = ovv[n]; const f32x4 w4 = *(const LAS f32x4*)(nw + dv);
            const float y0 = (hacc[n][0] - mu) * rstd * w4[0] * sigmoidf_(bflo(ov.x)), y1 = (hacc[n][1] - mu) * rstd * w4[1] * sigmoidf_(bfhi(ov.x));
            const float y2 = (hacc[n][2] - mu) * rstd * w4[2] * sigmoidf_(bflo(ov.y)), y3 = (hacc[n][3] - mu) * rstd * w4[3] * sigmoidf_(bfhi(ov.y));
            u32x2 o; o.x = pk2(y0, y1); o.y = pk2(y2, y3); if (dry == 7) asm volatile("" :: "v"(o)); else *(u32x2*)(owr + dv) = o; }
        LDS_BARRIER();
    }
}

__device__ __forceinline__ void ssd_conv_tiles(ArgsRef a, int b, int c, int g, ldsp Xt, ldsp Bt, ldsp Ct, int want, int pitchBC) {
    const int tid = launder((int)threadIdx.x), ch64 = tid & 63, strip = tid >> 6;
    int col, pitch; ldsp dst; bool on;
    if (ch64 < 32) { col = 256 * g + 8 * ch64; dst = Xt + ch64 * 16; pitch = P256; on = want & 1; }
    else if (ch64 < 48) { col = 1024 + 128 * g + 8 * (ch64 - 32); dst = Bt + (ch64 - 32) * 16; pitch = pitchBC; on = want & 2; }
    else { col = 1536 + 128 * g + 8 * (ch64 - 48); dst = Ct + (ch64 - 48) * 16; pitch = pitchBC; on = want & 4; }
    if (!on) return;
    const bf16_t* X = (const bf16_t*)(a.ws + WS_XBC) + (size_t)b * SEQ * 2048 + col;
    const float* cw = a.in[I_CONVW] + col; const float* cbp = a.in[I_CONVB] + col;
    f32x2 w2[5][4], bias2[4];
#pragma unroll
    for (int j = 0; j < 5; ++j) { const f32x4 w0 = *(const f32x4*)(cw + j * 2048), w1 = *(const f32x4*)(cw + j * 2048 + 4);
        w2[j][0] = (f32x2){w0[0], w0[1]}; w2[j][1] = (f32x2){w0[2], w0[3]}; w2[j][2] = (f32x2){w1[0], w1[1]}; w2[j][3] = (f32x2){w1[2], w1[3]}; }
    { const f32x4 b0 = *(const f32x4*)cbp, b1 = *(const f32x4*)(cbp + 4); bias2[0] = (f32x2){b0[0], b0[1]}; bias2[1] = (f32x2){b0[2], b0[3]}; bias2[2] = (f32x2){b1[0], b1[1]}; bias2[3] = (f32x2){b1[2], b1[3]}; }
    const int t0 = c * CH + strip * 16;
    u32x4 rows[20];
#pragma unroll
    for (int j = 0; j < 20; ++j) { const int tt = t0 - 2 + j; const int tc = tt < 0 ? 0 : (tt >= SEQ ? SEQ - 1 : tt);
        const u32x4 v = *(const u32x4*)(X + (size_t)tc * 2048); rows[j] = (tt >= 0 && tt < SEQ) ? v : (u32x4){0u, 0u, 0u, 0u}; }
#pragma unroll
    for (int r = 0; r < 16; ++r) {
        f32x2 o2[4];
#pragma unroll
        for (int e = 0; e < 4; ++e) o2[e] = bias2[e];
#pragma unroll
        for (int j = 0; j < 5; ++j) { const u32x4 v = rows[r + j];
            o2[0] += w2[j][0] * (f32x2){bflo(v.x), bfhi(v.x)}; o2[1] += w2[j][1] * (f32x2){bflo(v.y), bfhi(v.y)};
            o2[2] += w2[j][2] * (f32x2){bflo(v.z), bfhi(v.z)}; o2[3] += w2[j][3] * (f32x2){bflo(v.w), bfhi(v.w)}; }
        u32x4 pk;
#pragma unroll
        for (int e = 0; e < 4; ++e) { const f32x2 ng = o2[e] * -1.4426950408889634f; f32x2 ex; ex.x = __builtin_amdgcn_exp2f(ng.x); ex.y = __builtin_amdgcn_exp2f(ng.y);
            const f32x2 dn = ex + 1.0f; f32x2 rc; rc.x = __builtin_amdgcn_rcpf(dn.x); rc.y = __builtin_amdgcn_rcpf(dn.y); const f32x2 sv = o2[e] * rc;
            pk[e] = pk2(sv.x, sv.y); }
        *(LAS u32x4*)(dst + (strip * 16 + r) * pitch) = pk;
    }
}

struct SsVec { float dt[2], ac[2]; float tot; };
__device__ __forceinline__ SsVec ss_chunk_vec(const float* gates, int row0, int d, int h16, float dtb, float A, int lane) {
    SsVec r; float da[2];
#pragma unroll
    for (int j = 0; j < 2; ++j) { const int u = 2 * lane + j, t = d ? 127 - u : u;
        r.dt[j] = softplusf_(gates[(size_t)(row0 + t) * 48 + 16 + d * 16 + h16] + dtb); da[j] = r.dt[j] * A; }
    const float loc1 = da[0] + da[1]; const float s = wave_scan_add(loc1, lane); const float ex = s - loc1;
    r.ac[0] = ex + da[0]; r.ac[1] = s; r.tot = __shfl(s, 63);
    return r;
}

__device__ __forceinline__ void phase_ssd_states(ArgsRef a, ldsp lds) {
    const int tid = launder((int)threadIdx.x), lane = tid & 63, wave = __builtin_amdgcn_readfirstlane(tid >> 6), G = gridDim.x;
    const float* gates = (const float*)(a.ws + WS_GATES); float* ms = (float*)(a.ws + WS_MSTAT);
    bf16_t* ST = (bf16_t*)a.out;
    ldsp Bt = lds, Xt = lds + 36864; LAS float* wv = (LAS float*)(lds + 106496);
    for (int item = blockIdx.x; item < BATCH * NC * 4; item += G) {
        const int g = item % 4, c = (item / 4) % NC, b = item / (4 * NC); const int row0 = b * SEQ + c * CH;
        ssd_conv_tiles(a, b, c, g, Xt, Bt, Bt, 3, P128);
        const int hh = wave >> 1, d = wave & 1, h16 = 4 * g + hh;
        { const SsVec v = ss_chunk_vec(gates, row0, d, h16, a.in[I_DTB][d * 16 + h16], -__expf(a.in[I_ALOG][d * 16 + h16]), lane);
#pragma unroll
          for (int j = 0; j < 2; ++j) { const int u = 2 * lane + j, t = d ? 127 - u : u; wv[wave * 128 + t] = v.dt[j] * __expf(v.tot - v.ac[j]); }
          if (lane == 0) ms[MS_SD + ((b * 16 + h16) * 2 + d) * 32 + c] = __expf(v.tot); }
        LDS_BARRIER();
        { bf16_t* out = ST + (size_t)(((b * 16 + h16) * 2 + d) * 32 + c) * 8192;
          chunk_state_gemm(Bt, P128, Xt + 64 * hh * 2, P256, wv + wave * 128, out, lane); }
        LDS_BARRIER();
    }
}

__device__ __forceinline__ void phase_ssd_out(ArgsRef a, ldsp lds, int dry = 0) {
    const int tid = launder((int)threadIdx.x), lane = tid & 63, wave = __builtin_amdgcn_readfirstlane(tid >> 6), G = gridDim.x;
    const int fr_ = lane & 15, fq_ = lane >> 4;
    const float* gates = (const float*)(a.ws + WS_GATES);
    bf16_t* OZ = (bf16_t*)(a.ws + WS_OZ); const bf16_t* ST = (const bf16_t*)a.out;
    ldsp Ct = lds, Bt = lds + 36864, Xt = lds + 73728;
    LAS float* vec = (LAS float*)(lds + 73728 + 69632);
    static_assert(73728 + 69632 + 8192 + 4096 <= MISC_OFF, "layout");
    LAS float* nwl = vec + 2048;
    for (int i = tid; i < 1024; i += 512) nwl[i] = a.in[I_SSMNW][i];
    for (int item = blockIdx.x; item < BATCH * NC * 4; item += G) {
        const int g = item % 4, c = (item / 4) % NC, b = item / (4 * NC); const int row0 = b * SEQ + c * CH;
        const int fr = launder(fr_), fq = launder(fq_), g4 = fq, q4 = fr >> 2, p4 = fr & 3;
        ssd_conv_tiles(a, b, c, g, Xt, Bt, Ct, 7, P128R);
        { const int hh = wave >> 1, d = wave & 1, h16 = 4 * g + hh;
          const SsVec v = ss_chunk_vec(gates, row0, d, h16, a.in[I_DTB][d * 16 + h16], -__expf(a.in[I_ALOG][d * 16 + h16]), lane);
#pragma unroll
          for (int j = 0; j < 2; ++j) { const int u = 2 * lane + j, t = d ? 127 - u : u; vec[wave * 256 + t] = v.ac[j]; vec[wave * 256 + 128 + t] = v.dt[j]; } }
        LDS_BARRIER();
        if (dry == 2) { LDS_BARRIER(); continue; }
        f32x4 cbv[8];
#pragma unroll
        for (int i = 0; i < 8; ++i) cbv[i] = (f32x4){0.f, 0.f, 0.f, 0.f};
        bf16x8 cf[4];
#pragma unroll
        for (int ks = 0; ks < 4; ++ks) cf[ks] = *(const LAS bf16x8*)(Ct + (16 * wave + fr) * P128R + (32 * ks + 8 * fq) * 2);
#pragma unroll
        for (int ks = 0; ks < 4; ++ks)
#pragma unroll
            for (int i = 0; i < 8; ++i) { const bf16x8 bfr = *(const LAS bf16x8*)(Bt + (16 * i + fr) * P128R + (32 * ks + 8 * fq) * 2);
                cbv[i] = __builtin_amdgcn_mfma_f32_16x16x32_bf16(bfr, cf[ks], cbv[i], 0, 0, 0); }
        LDS_BARRIER();
        if (dry == 3) { asm volatile("" :: "v"(cbv[0]), "v"(cbv[1]), "v"(cbv[2]), "v"(cbv[3]), "v"(cbv[4]), "v"(cbv[5]), "v"(cbv[6]), "v"(cbv[7])); continue; }
        const int t = 16 * wave + fr;
        ldsp Ht = Ct;
        u32x4 pre[4];
#pragma unroll
        for (int i = 0; i < 4; ++i) { const int id = tid + 512 * i, d = id >> 10, r = (id >> 4) & 63, ch = id & 15;
            pre[i] = *(const u32x4*)(ST + (size_t)(((b * 16 + 4 * g) * 2 + d) * 32 + c) * 8192 + r * 128 + ch * 8); }
        float s2 = 0.f;
        bf16_t* yrow = dry ? (bf16_t*)(a.ws + WS_XB) + (size_t)(row0 + t) * 1024 + 256 * g : OZ + (size_t)(row0 + t) * 2048 + 1024 + 256 * g;
#pragma unroll 1
        for (int hh = 0; hh < 4; ++hh) {
            const int h16 = 4 * g + hh;
#pragma unroll
            for (int i = 0; i < 4; ++i) { const int id = tid + 512 * i, d = id >> 10, r = (id >> 4) & 63, ch = id & 15;
                *(LAS u32x4*)(Ht + d * 18432 + r * P128R + ch * 16) = pre[i]; }
            LDS_BARRIER();
            if (hh < 3) {
#pragma unroll
                for (int i = 0; i < 4; ++i) { const int id = tid + 512 * i, d = id >> 10, r = (id >> 4) & 63, ch = id & 15;
                    pre[i] = *(const u32x4*)(ST + (size_t)(((b * 16 + h16 + 1) * 2 + d) * 32 + c) * 8192 + r * 128 + ch * 8); }
            }
            const bf16_t* zrow = OZ + (size_t)(row0 + t) * 2048 + 1024 + 256 * g + 64 * hh;
            u32x2 zpre[4];
#pragma unroll
            for (int n = 0; n < 4; ++n) zpre[n] = *(const u32x2*)(zrow + 16 * n + 4 * fq);
            f32x4 y[4];
            if (dry == 5) {
#pragma unroll
                for (int n = 0; n < 4; ++n) y[n] = (f32x4){0.f, 0.f, 0.f, 0.f};
            } else {
                f32x4 yf[4], yb[4];
#pragma unroll
                for (int n = 0; n < 4; ++n) { yf[n] = (f32x4){0.f, 0.f, 0.f, 0.f}; yb[n] = (f32x4){0.f, 0.f, 0.f, 0.f}; }
#pragma unroll
                for (int ks = 0; ks < 4; ++ks)
#pragma unroll
                    for (int n = 0; n < 4; ++n) {
                        const bf16x8 h0 = *(const LAS bf16x8*)(Ht + (16 * n + fr) * P128R + (32 * ks + 8 * fq) * 2);
                        const bf16x8 h1 = *(const LAS bf16x8*)(Ht + 18432 + (16 * n + fr) * P128R + (32 * ks + 8 * fq) * 2);
                        yf[n] = __builtin_amdgcn_mfma_f32_16x16x32_bf16(h0, cf[ks], yf[n], 0, 0, 0);
                        yb[n] = __builtin_amdgcn_mfma_f32_16x16x32_bf16(h1, cf[ks], yb[n], 0, 0, 0); }
                const float ef = __expf(vec[(hh * 2 + 0) * 256 + t]), eb = __expf(vec[(hh * 2 + 1) * 256 + t]);
#pragma unroll
                for (int n = 0; n < 4; ++n) y[n] = yf[n] * ef + yb[n] * eb;
            }
            if (dry != 4) {
            { const int fq2 = launder(fq), t2 = launder(t);
              const float af = vec[(hh * 2 + 0) * 256 + t2], ab = vec[(hh * 2 + 1) * 256 + t2];
#pragma unroll
              for (int i = 0; i < 8; ++i) { float pv[4]; const LAS float* vb = vec + hh * 512 + 16 * i + 4 * fq2;
                  if (i < wave) { const f32x4 acf = *(const LAS f32x4*)(vb), dtf = *(const LAS f32x4*)(vb + 128);
#pragma unroll
                      for (int r = 0; r < 4; ++r) pv[r] = cbv[i][r] * (__expf(af - acf[r]) * dtf[r]); }
                  else if (i > wave) { const f32x4 acb = *(const LAS f32x4*)(vb + 256), dtb = *(const LAS f32x4*)(vb + 384);
#pragma unroll
                      for (int r = 0; r < 4; ++r) pv[r] = cbv[i][r] * (__expf(ab - acb[r]) * dtb[r]); }
                  else { const f32x4 acf = *(const LAS f32x4*)(vb), dtf = *(const LAS f32x4*)(vb + 128), acb = *(const LAS f32x4*)(vb + 256), dtb = *(const LAS f32x4*)(vb + 384);
#pragma unroll
                      for (int r = 0; r < 4; ++r) { const int s = 16 * i + 4 * fq2 + r;
                          float lf = __expf(fminf(af - acf[r], 0.f)) * dtf[r], lb = __expf(fminf(ab - acb[r], 0.f)) * dtb[r];
                          lf = (s <= t2) ? lf : 0.f; lb = (s >= t2) ? lb : 0.f;
                          pv[r] = cbv[i][r] * (lf + lb); } }
                  u32x2 o; o.x = pk2(pv[0], pv[1]); o.y = pk2(pv[2], pv[3]);
                  *(LAS u32x2*)(Bt + t2 * P128R + (16 * i + 4 * fq2) * 2) = o; } }
            asm volatile("s_waitcnt lgkmcnt(0)" ::: "memory");
#pragma unroll
            for (int ks = 0; ks < 4; ++ks) {
                const bf16x8 pf = *(const LAS bf16x8*)(Bt + t * P128R + (32 * ks + 8 * fq) * 2);
#pragma unroll
                for (int n = 0; n < 4; ++n) { ldscp ad = Xt + (32 * ks + 8 * g4 + q4) * P256 + (64 * hh + 16 * n + 4 * p4) * 2;
                    const bf16x8 xf = cat8(vtr(ad), vtr(ad + 4 * P256));
                    y[n] = __builtin_amdgcn_mfma_f32_16x16x32_bf16(xf, pf, y[n], 0, 0, 0); }
            }
            }
            { const float dsk = a.in[I_DSKIP][h16];
#pragma unroll
              for (int n = 0; n < 4; ++n) { const int p = 16 * n + 4 * fq;
                  const u32x2 xv = *(const LAS u32x2*)(Xt + t * P256 + (64 * hh + p) * 2); const u32x2 zv = zpre[n];
                  f32x4 o;
                  o[0] = (y[n][0] + dsk * bflo(xv.x)) * siluf_(bflo(zv.x)); o[1] = (y[n][1] + dsk * bfhi(xv.x)) * siluf_(bfhi(zv.x));
                  o[2] = (y[n][2] + dsk * bflo(xv.y)) * siluf_(bflo(zv.y)); o[3] = (y[n][3] + dsk * bfhi(xv.y)) * siluf_(bfhi(zv.y));
                  s2 += (o[0] * o[0] + o[1] * o[1]) + (o[2] * o[2] + o[3] * o[3]);
                  u32x2 ow; ow.x = pk2(o[0], o[1]); ow.y = pk2(o[2], o[3]); *(u32x2*)(yrow + 64 * hh + p) = ow; } }
            LDS_BARRIER();
        }
        s2 += __shfl_xor(s2, 16); s2 += __shfl_xor(s2, 32);
        const float rs = 1.f / sqrtf(s2 * (1.f / 256.f) + RMS_EPS);
        const LAS float* nw = nwl + 256 * g;
        u32x2 yvv[16];
#pragma unroll
        for (int hn = 0; hn < 16; ++hn) yvv[hn] = *(const u32x2*)(yrow + 16 * hn + 4 * fq);
#pragma unroll
        for (int hn = 0; hn < 16; ++hn) { const int ch = 16 * hn + 4 * fq; const f32x4 w4 = *(const LAS f32x4*)(nw + ch); const u32x2 yv = yvv[hn];
            u32x2 o; o.x = pk2(bflo(yv.x) * rs * w4[0], bfhi(yv.x) * rs * w4[1]); o.y = pk2(bflo(yv.y) * rs * w4[2], bfhi(yv.y) * rs * w4[3]); *(u32x2*)(yrow + ch) = o; }
        LDS_BARRIER();
    }
}

__device__ __forceinline__ void phase_ln1_router(ArgsRef a, ldsp lds) {
    const int tid = launder((int)threadIdx.x), lane = tid & 63, wave = __builtin_amdgcn_readfirstlane(tid >> 6), G = gridDim.x;
    const int gw = blockIdx.x * 8 + wave, NGW = G * 8;
    {
        LAS float* scr = (LAS float*)(lds + 81920 + wave * 8448);
        bf16_t* W1T = (bf16_t*)(a.ws + WS_W1T); bf16_t* W2T = (bf16_t*)(a.ws + WS_W2T);
        for (int it = gw; it < 65 * 384; it += NGW) {
            const int e = it / 384, r = it % 384;
            const float* wg = e < 64 ? a.in[I_WEG] + (size_t)e * DM * DE : a.in[I_WSG];
            const float* wu = e < 64 ? a.in[I_WEU] + (size_t)e * DM * DE : a.in[I_WSU];
            const float* wd = e < 64 ? a.in[I_WED] + (size_t)e * DE * DM : a.in[I_WSD];
            if (r < 256) { const int up = r >> 7, q = r & 127, cb = q & 7, kb = q >> 3;
                transpose_item(up ? wu : wg, DE, kb * 64, cb * 32, W1T + (size_t)e * 512 * DM, DM, 256 * (cb >> 2) + 32 * (cb & 3) + 128 * up, 1.f, scr, lane); }
            else { const int q = r - 256, cb = q & 31, kb = q >> 5;
                transpose_item(wd, DM, kb * 64, cb * 32, W2T + (size_t)e * DM * DE, DE, cb * 32, 1.f, scr, lane); }
        }
    }
    LDS_BARRIER();
    const float* r1 = a.out; bf16_t* H = (bf16_t*)(a.ws + WS_H);
    int* sele = (int*)(a.ws + WS_SELE); float* selw = (float*)(a.ws + WS_SELW);
    unsigned* ctl = (unsigned*)(a.ws + WS_CTL);
    constexpr int WPT = 160;
    ldsp Whi = lds, Wlo = lds + 40960;
    LAS float* lg = (LAS float*)(lds + 81920);
    LAS unsigned* cnt = (LAS unsigned*)(lds + 81920 + 33280);
    const float* g1 = a.in[I_LN1G]; const float* b1 = a.in[I_LN1B]; const float* wr = a.in[I_WR];
    const int fr = lane & 15, fq = lane >> 4, q4 = fr >> 2, p4 = fr & 3;
    for (int vb = blockIdx.x; vb < 256; vb += G) {
        const int tok0 = vb * 128;
        if (tid < 64) cnt[tid] = 0u;
        f32x4 ggv[4], bbv[4];
#pragma unroll
        for (int j = 0; j < 4; ++j) { ggv[j] = *((const f32x4*)g1 + lane + 64 * j); bbv[j] = *((const f32x4*)b1 + lane + 64 * j); }
        for (int rr = 0; rr < 16; rr += 4) {
            f32x4 v[4][4];
#pragma unroll
            for (int q = 0; q < 4; ++q) { const f32x4* xr = (const f32x4*)(r1 + (size_t)(tok0 + 16 * wave + rr + q) * DM) + lane;
#pragma unroll
                for (int j = 0; j < 4; ++j) v[q][j] = xr[64 * j]; }
#pragma unroll
            for (int q = 0; q < 4; ++q) {
                const int t = tok0 + 16 * wave + rr + q; float s = 0.f;
#pragma unroll
                for (int j = 0; j < 4; ++j) s += (v[q][j].x + v[q][j].y) + (v[q][j].z + v[q][j].w);
                const float mean = wave_sum(s) * (1.f / DM); float s2 = 0.f;
#pragma unroll
                for (int j = 0; j < 4; ++j) { v[q][j] = v[q][j] - mean; s2 += (v[q][j].x * v[q][j].x + v[q][j].y * v[q][j].y) + (v[q][j].z * v[q][j].z + v[q][j].w * v[q][j].w); }
                const float rstd = __builtin_amdgcn_rsqf(wave_sum(s2) * (1.f / DM) + LN_EPS);
                unsigned long long* o8 = (unsigned long long*)(H + (size_t)t * DM) + lane;
#pragma unroll
                for (int j = 0; j < 4; ++j) { const f32x4 hv = v[q][j] * rstd * ggv[j] + bbv[j];
                    o8[64 * j] = (unsigned long long)pk2(hv.x, hv.y) | ((unsigned long long)pk2(hv.z, hv.w) << 32); }
            }
        }
        asm volatile("s_waitcnt vmcnt(0)" ::: "memory");
        f32x4 lacc[4];
#pragma unroll
        for (int nt = 0; nt < 4; ++nt) lacc[nt] = (f32x4){0.f, 0.f, 0.f, 0.f};
        f32x4 pw[8];
#pragma unroll
        for (int i = 0; i < 8; ++i) pw[i] = *(const f32x4*)(wr + (size_t)(tid + 512 * i) * 4);
        const bf16_t* hrow = H + (size_t)(tok0 + 16 * wave + fr) * DM + 8 * fq;
#pragma unroll 1
        for (int kc = 0; kc < 4; ++kc) {
#pragma unroll
            for (int i = 0; i < 8; ++i) { const int id = tid + 512 * i, k = id >> 4, e4 = (id & 15) * 4; const f32x4 w = pw[i];
                u32x2 hi; hi.x = pk2(w[0], w[1]); hi.y = pk2(w[2], w[3]);
                u32x2 lo; lo.x = pk2(w[0] - bflo(hi.x), w[1] - bfhi(hi.x)); lo.y = pk2(w[2] - bflo(hi.y), w[3] - bfhi(hi.y));
                *(LAS u32x2*)(Whi + k * WPT + e4 * 2) = hi; *(LAS u32x2*)(Wlo + k * WPT + e4 * 2) = lo; }
            if (kc < 3) {
#pragma unroll
                for (int i = 0; i < 8; ++i) pw[i] = *(const f32x4*)(wr + (size_t)(kc + 1) * 256 * NE + (size_t)(tid + 512 * i) * 4);
            }
            bf16x8 af[8];
#pragma unroll
            for (int ks = 0; ks < 8; ++ks) af[ks] = *(const bf16x8*)(hrow + 256 * kc + 32 * ks);
            LDS_BARRIER();
#pragma unroll
            for (int ks = 0; ks < 8; ++ks)
#pragma unroll
                for (int nt = 0; nt < 4; ++nt) { const int off = (32 * ks + 8 * fq + q4) * WPT + (16 * nt + 4 * p4) * 2;
                    const bf16x8 wh = cat8(vtr(Whi + off), vtr(Whi + off + 4 * WPT)), wl = cat8(vtr(Wlo + off), vtr(Wlo + off + 4 * WPT));
                    lacc[nt] = __builtin_amdgcn_mfma_f32_16x16x32_bf16(af[ks], wh, lacc[nt], 0, 0, 0);
                    lacc[nt] = __builtin_amdgcn_mfma_f32_16x16x32_bf16(af[ks], wl, lacc[nt], 0, 0, 0); }
            LDS_BARRIER();
        }
#pragma unroll
        for (int nt = 0; nt < 4; ++nt)
#pragma unroll
            for (int r = 0; r < 4; ++r) lg[(16 * wave + 4 * fq + r) * 65 + 16 * nt + fr] = lacc[nt][r];
        asm volatile("s_waitcnt lgkmcnt(0)" ::: "memory");
        const float rb = a.in[I_RB][lane]; unsigned mycnt = 0u;
        for (int rr = 0; rr < 16; ++rr) {
            const int row = 16 * wave + rr; const int t = tok0 + row;
            const float score = sigmoidf_(lg[row * 65 + lane]); const float choice = score + rb;
            float m1 = choice; m1 = fmaxf(m1, __shfl_xor(m1, 1)); m1 = fmaxf(m1, __shfl_xor(m1, 2)); m1 = fmaxf(m1, __shfl_xor(m1, 4));
            const unsigned long long eq = __ballot(choice == m1); const int gbase = lane & ~7;
            const unsigned gm = (unsigned)(eq >> gbase) & 0xffu; const int first = gbase + __builtin_ctz(gm);
            float m2 = (lane == first) ? -INFINITY : choice; m2 = fmaxf(m2, __shfl_xor(m2, 1)); m2 = fmaxf(m2, __shfl_xor(m2, 2)); m2 = fmaxf(m2, __shfl_xor(m2, 4));
            const float gs = m1 + m2; const int grp = lane >> 3;
            int grank = 0;
#pragma unroll
            for (int g2 = 0; g2 < 8; ++g2) { const float og = __shfl(gs, 8 * g2); grank += (og > gs || (og == gs && g2 < grp)) ? 1 : 0; }
            float curv = (grank < 4) ? choice : -INFINITY; int rank = -1;
#pragma unroll
            for (int r = 0; r < TOPK; ++r) { const float mx = wave_max(curv); const unsigned long long bal = __ballot(curv == mx);
                const int win = __builtin_ctzll(bal); if (lane == win) { rank = r; curv = -INFINITY; } }
            const bool sel = rank >= 0;
            const float wsum = wave_sum(sel ? score : 0.f);
            if (sel) { sele[t * 8 + rank] = lane; selw[t * 8 + rank] = score / wsum * 2.5f; mycnt++; }
        }
        if (mycnt) atomicAdd((unsigned*)&cnt[lane], mycnt);
        LDS_BARRIER();
        if (tid < 64) ctl[CW_BLOCKCNT + vb * 64 + tid] = cnt[tid];
        LDS_BARRIER();
    }
}

__device__ __forceinline__ void phase_lists(ArgsRef a, ldsp lds) {
    const int tid = launder((int)threadIdx.x), lane = tid & 63, wave = __builtin_amdgcn_readfirstlane(tid >> 6), G = gridDim.x;
    const unsigned* ctl = (const unsigned*)(a.ws + WS_CTL); unsigned* ctlw = (unsigned*)(a.ws + WS_CTL);
    const int* sele = (const int*)(a.ws + WS_SELE); const float* selw = (const float*)(a.ws + WS_SELW);
    int* tokpos = (int*)(a.ws + WS_TOKPOS);
    LAS unsigned* part = (LAS unsigned*)lds;
    LAS unsigned* pre = part + 1024;
    LAS unsigned* cntp = pre + 64;
    LAS unsigned* pstart = cntp + 64;
    LAS unsigned* cstart = pstart + 64;
    LAS unsigned* lcnt = cstart + 64;
    for (int vb = blockIdx.x; vb < 256; vb += G) {
        const int p = vb < PASS_VB0[1] ? 0 : (vb < PASS_VB0[2] ? 1 : 2); const int vb0 = PASS_VB0[p], vb1 = PASS_VB0[p + 1];
        int* rowtok = (int*)(a.ws + WS_ROWTOK) + p * PASS_MAXROWS; float* rowgate = (float*)(a.ws + WS_ROWGATE) + p * PASS_MAXROWS;
        int* rowy = (int*)(a.ws + WS_ROWY) + p * PASS_MAXROWS; int* tilee = (int*)(a.ws + WS_TILEE) + p * PASS_MAXTILES;
        { const int e = tid & 63, pt = tid >> 6; unsigned tot = 0u, bel = 0u;
          for (int v2 = vb0 + pt; v2 < vb1; v2 += 8) { const unsigned cv = ctl[CW_BLOCKCNT + v2 * 64 + e]; tot += cv; if (v2 < vb) bel += cv; }
          part[(pt * 64 + e) * 2] = tot; part[(pt * 64 + e) * 2 + 1] = bel; }
        BLOCK_SYNC();
        if (tid < 64) { unsigned tot = 0u, bel = 0u;
#pragma unroll
            for (int pt = 0; pt < 8; ++pt) { tot += part[(pt * 64 + tid) * 2]; bel += part[(pt * 64 + tid) * 2 + 1]; }
            const unsigned pad = (tot + 255u) & ~255u;
            unsigned ps = pad, cs = tot;
#pragma unroll
            for (int o = 1; o < 64; o <<= 1) { const unsigned t1 = __shfl_up(ps, o), t2 = __shfl_up(cs, o); if (lane >= o) { ps += t1; cs += t2; } }
            pre[tid] = bel; cntp[tid] = tot; pstart[tid] = ps - pad; cstart[tid] = cs - tot; lcnt[tid] = 0u;
            if (tid == 63) lcnt[64] = ps;
            if (vb == vb0 && tid == 63) ctlw[CW_NTILES + p] = (ps >> 8) + (p == 0 ? T / 256 : 0); }
        BLOCK_SYNC();
#pragma unroll
        for (int i = 0; i < 2; ++i) { const int sidx = tid + 512 * i, tl = sidx >> 3, k = sidx & 7; const int t = vb * 128 + tl;
            const int e = sele[t * 8 + k]; const float w = selw[t * 8 + k];
            const unsigned rank = pre[e] + atomicAdd((unsigned*)&lcnt[e], 1u);
            const unsigned prow = pstart[e] + rank, yrow = cstart[e] + rank + 1u;
            rowtok[prow] = t; rowgate[prow] = w; rowy[prow] = (int)yrow; tokpos[t * 8 + k] = (int)yrow; }
        if (vb == vb0) {
            for (int e = wave; e < 64; e += 8) { const unsigned c0 = cntp[e], ps = pstart[e], pad = (c0 + 255u) & ~255u;
                for (unsigned r = c0 + lane; r < pad; r += 64) { rowtok[ps + r] = vb0 * 128; rowgate[ps + r] = 0.f; rowy[ps + r] = 0; }
                for (unsigned tl = lane; tl < (pad >> 8); tl += 64) tilee[(ps >> 8) + tl] = e; }
            if (p == 0) { const unsigned ps = lcnt[64];
                for (int r = tid; r < T; r += 512) { rowtok[ps + r] = r; rowgate[ps + r] = 1.f; rowy[ps + r] = YS_ROW0 + r; }
                for (int tl = tid; tl < T / 256; tl += 512) tilee[(ps >> 8) + tl] = 64; }
        }
        BLOCK_SYNC();
    }
}

__device__ __forceinline__ void moe_gemm1(ArgsRef a, ldsp lds, int p) {
    const unsigned* ctl = (const unsigned*)(a.ws + WS_CTL);
    const int ntile = (int)ctl[CW_NTILES + p];
    pg8::Gemm g{(const bf16_t*)(a.ws + WS_H), (const bf16_t*)(a.ws + WS_W1T), 0, 512, DM, (size_t)512 * DM * 2, (const int*)(a.ws + WS_ROWTOK) + p * PASS_MAXROWS};
    pg8::MoeOrder<2, true> S{ntile, (int)gridDim.x, (int)blockIdx.x, 0, (const int*)(a.ws + WS_TILEE) + p * PASS_MAXTILES};
    pg8::EpiSwiGLU E{(bf16_t*)(a.ws + WS_ACT)};
    pg8::gemm_phase<pg8::EpiSwiGLU, pg8::MoeOrder<2, true>, true>(lds, g, S, E);
}
__device__ __forceinline__ void moe_gemm2(ArgsRef a, ldsp lds, int p) {
    const unsigned* ctl = (const unsigned*)(a.ws + WS_CTL);
    const int ntile = (int)ctl[CW_NTILES + p];
    pg8::Gemm g{(const bf16_t*)(a.ws + WS_ACT), (const bf16_t*)(a.ws + WS_W2T), 0, DM, DE, (size_t)DM * DE * 2, nullptr};
    pg8::MoeOrder<4, true> S{ntile, (int)gridDim.x, (int)blockIdx.x, 0, (const int*)(a.ws + WS_TILEE) + p * PASS_MAXTILES};
    pg8::EpiDownY E{(bf16_t*)(a.ws + WS_Y), (const int*)(a.ws + WS_ROWY) + p * PASS_MAXROWS, (const float*)(a.ws + WS_ROWGATE) + p * PASS_MAXROWS};
    pg8::gemm_phase<pg8::EpiDownY, pg8::MoeOrder<4, true>, false>(lds, g, S, E);
}
__device__ __forceinline__ void moe_combine(ArgsRef a, int p) {
    const int tid = launder((int)threadIdx.x), lane = tid & 63, wave = tid >> 6, G = gridDim.x;
    const bf16_t* H = (const bf16_t*)(a.ws + WS_H); const bf16_t* Y = (const bf16_t*)(a.ws + WS_Y); const int* tokpos = (const int*)(a.ws + WS_TOKPOS);
    const float* g2 = a.in[I_LN2G]; const float* b2 = a.in[I_LN2B];
    const int t0 = PASS_VB0[p] * 128, t1 = PASS_VB0[p + 1] * 128;
    f32x4 gav[2], gbv[2], bav[2], bbv[2];
#pragma unroll
    for (int j = 0; j < 2; ++j) { const int c = 8 * lane + 512 * j; gav[j] = *(const f32x4*)(g2 + c); gbv[j] = *(const f32x4*)(g2 + c + 4); bav[j] = *(const f32x4*)(b2 + c); bbv[j] = *(const f32x4*)(b2 + c + 4); }
    for (int t = t0 + blockIdx.x * 8 + wave; t < t1; t += G * 8) {
        float v[2][8];
#pragma unroll
        for (int j = 0; j < 2; ++j) { const int c = 8 * lane + 512 * j;
            const u32x4 hv = *(const u32x4*)(H + (size_t)t * DM + c); const u32x4 sv = *(const u32x4*)(Y + (size_t)(YS_ROW0 + t) * DM + c);
            v[j][0] = bflo(sv.x) + ALPHA * bflo(hv.x); v[j][1] = bfhi(sv.x) + ALPHA * bfhi(hv.x); v[j][2] = bflo(sv.y) + ALPHA * bflo(hv.y); v[j][3] = bfhi(sv.y) + ALPHA * bfhi(hv.y);
            v[j][4] = bflo(sv.z) + ALPHA * bflo(hv.z); v[j][5] = bfhi(sv.z) + ALPHA * bfhi(hv.z); v[j][6] = bflo(sv.w) + ALPHA * bflo(hv.w); v[j][7] = bfhi(sv.w) + ALPHA * bfhi(hv.w); }
#pragma unroll
        for (int k = 0; k < 8; ++k) { const int yr = tokpos[t * 8 + k];
#pragma unroll
            for (int j = 0; j < 2; ++j) { const u32x4 yv = *(const u32x4*)(Y + (size_t)yr * DM + 8 * lane + 512 * j);
                v[j][0] += bflo(yv.x); v[j][1] += bfhi(yv.x); v[j][2] += bflo(yv.y); v[j][3] += bfhi(yv.y);
                v[j][4] += bflo(yv.z); v[j][5] += bfhi(yv.z); v[j][6] += bflo(yv.w); v[j][7] += bfhi(yv.w); } }
        float s = 0.f;
#pragma unroll
        for (int j = 0; j < 2; ++j)
#pragma unroll
            for (int e = 0; e < 8; ++e) s += v[j][e];
        const float mean = wave_sum(s) * (1.f / DM); float s2 = 0.f;
#pragma unroll
        for (int j = 0; j < 2; ++j)
#pragma unroll
            for (int e = 0; e < 8; ++e) { v[j][e] -= mean; s2 += v[j][e] * v[j][e]; }
        const float rstd = 1.f / sqrtf(wave_sum(s2) * (1.f / DM) + LN_EPS);
#pragma unroll
        for (int j = 0; j < 2; ++j) { const int c = 8 * lane + 512 * j;
            const f32x4 ga = gav[j], gb = gbv[j], ba = bav[j], bb = bbv[j];
            f32x4 o0, o1;
            o0[0] = v[j][0] * rstd * ga[0] + ba[0]; o0[1] = v[j][1] * rstd * ga[1] + ba[1]; o0[2] = v[j][2] * rstd * ga[2] + ba[2]; o0[3] = v[j][3] * rstd * ga[3] + ba[3];
            o1[0] = v[j][4] * rstd * gb[0] + bb[0]; o1[1] = v[j][5] * rstd * gb[1] + bb[1]; o1[2] = v[j][6] * rstd * gb[2] + bb[2]; o1[3] = v[j][7] * rstd * gb[3] + bb[3];
            *(f32x4*)(a.out + (size_t)t * DM + c) = o0; *(f32x4*)(a.out + (size_t)t * DM + c + 4) = o1; }
    }
}

#define XB_TMO      128
#define XB_XCNT(j)  (256  + 64 * (j))
#define XB_XSUB(j)  (1280 + 64 * (j))
#define XB_XGEN(j)  (2304 + 64 * (j))
#define XB_TOP      3328
#define XB_TOPGEN   3392
#define XCD_BAR_WORDS 3456
#define XB_SPIN_CAP (1u << 18)
__device__ __forceinline__ unsigned xb_ld(unsigned* p)              { return __hip_atomic_load(p, __ATOMIC_RELAXED, __HIP_MEMORY_SCOPE_AGENT); }
__device__ __forceinline__ unsigned xb_add(unsigned* p, unsigned v) { return __hip_atomic_fetch_add(p, v, __ATOMIC_RELAXED, __HIP_MEMORY_SCOPE_AGENT); }
__device__ __forceinline__ unsigned xb_xcc_id() { return (unsigned)__builtin_amdgcn_s_getreg((3 << 11) | 20) & 0xFu; }
#define XB_SPIN(cond, bar) do { unsigned _sp = 0; while (cond) { __builtin_amdgcn_s_sleep(1); \
    if ((++_sp & 255u) == 0u) { if (xb_ld(&(bar)[XB_TMO])) break; if (_sp > XB_SPIN_CAP) { atomicAdd(&(bar)[XB_TMO], 1u); break; } } } } while (0)
struct XcdBarrier { unsigned* bar; unsigned x; volatile LAS unsigned* st; };
__device__ __forceinline__ XcdBarrier xcd_barrier_post(unsigned* bar, volatile LAS unsigned* st) {
    XcdBarrier b; b.bar = bar; b.x = xb_xcc_id(); b.st = st;
    if (threadIdx.x == 0) (void)xb_add(&bar[XB_XCNT(b.x)], 1u);
    return b;
}
__device__ __forceinline__ void xcd_barrier_complete(unsigned* bar, unsigned x, unsigned& nloc, unsigned& nx) {
    const unsigned G = gridDim.x * gridDim.y * gridDim.z;
    unsigned sum, cnt, mine, sp = 0u;
    for (;;) {
        sum = 0u; cnt = 0u; mine = 0u;
#pragma unroll
        for (unsigned j = 0; j < 16; ++j) { const unsigned c = xb_ld(&bar[XB_XCNT(j)]); sum += c; cnt += (c > 0u) ? 1u : 0u; mine = (j == x) ? c : mine; }
        if (sum == G) break;
        __builtin_amdgcn_s_sleep(1);
        if ((++sp & 255u) == 0u) { if (xb_ld(&bar[XB_TMO])) break; if (sp > XB_SPIN_CAP) { atomicAdd(&bar[XB_TMO], 1u); break; } }
    }
    nloc = mine > 0u ? mine : 1u; nx = cnt > 0u ? cnt : 1u;
}
__device__ __forceinline__ void xcd_barrier(const XcdBarrier& b) {
    asm volatile("s_waitcnt vmcnt(0)" ::: "memory");
    __syncthreads();
    if (threadIdx.x == 0) {
        unsigned* bar = b.bar;
        __builtin_amdgcn_s_waitcnt(0);
        unsigned nloc = b.st[0], nx = b.st[1];
        if (nloc == 0u) { xcd_barrier_complete(bar, b.x, nloc, nx); b.st[0] = nloc; b.st[1] = nx; }
        const unsigned old = xb_add(&bar[XB_XSUB(b.x)], 1u);
        const unsigned gen = old / nloc;
        if (old + 1u == (gen + 1u) * nloc) {
            __builtin_amdgcn_fence(__ATOMIC_RELEASE, "agent");
            asm volatile("s_waitcnt vmcnt(0)" ::: "memory");
            const unsigned og = xb_add(&bar[XB_TOP], 1u);
            const unsigned tg = og / nx;
            if (og + 1u == (tg + 1u) * nx) xb_add(&bar[XB_TOPGEN], 1u);
            else XB_SPIN(xb_ld(&bar[XB_TOPGEN]) == tg, bar);
            __builtin_amdgcn_fence(__ATOMIC_ACQUIRE, "agent");
            xb_add(&bar[XB_XGEN(b.x)], 1u);
            asm volatile("s_waitcnt vmcnt(0)" ::: "memory");
        } else {
            XB_SPIN(xb_ld(&bar[XB_XGEN(b.x)]) == gen, bar);
            __builtin_amdgcn_fence(__ATOMIC_ACQUIRE, "agent");
            asm volatile("s_waitcnt vmcnt(0)" ::: "memory");
        }
    }
    __syncthreads();
}

constexpr int N_PHASES = 18;
#ifndef REP_MASK
#define REP_MASK 0
#endif
#define REP(k) (((REP_MASK) >> (k)) & 1)
#ifndef DRYLVL
#define DRYLVL 1
#endif
__device__ __forceinline__ const __attribute__((address_space(4))) Args* kargs() {
    const __attribute__((address_space(4))) Args* p = (const __attribute__((address_space(4))) Args*)__builtin_amdgcn_kernarg_segment_ptr();
    asm volatile("" : "+s"(p)); return p;
}
__global__ void __launch_bounds__(512, 2) fwd_megakernel(Args a_unused) {
    extern __shared__ __attribute__((aligned(16))) unsigned char lds_raw[];
    ldsp lds = (ldsp)lds_raw;
    cg::grid_group grid = cg::this_grid();
#define lo (kargs()->ph_lo)
#define hi (kargs()->ph_hi)
    if (threadIdx.x < 16) ((LAS unsigned*)(lds + MISC_OFF))[threadIdx.x] = 0u;
    __syncthreads();
    (void)xcd_barrier_post((unsigned*)(kargs()->ws + WS_CTL) + CW_BAR, (volatile LAS unsigned*)(lds + MISC_OFF));
#define a (*kargs())
#ifdef PHASE_ONLY
#define IN(k) ((k) == PHASE_ONLY && lo <= (k) && (k) < hi)
#elif defined(PHASE_MASK)
#define IN(k) ((((PHASE_MASK) >> (k)) & 1) && lo <= (k) && (k) < hi)
#else
#define IN(k) (lo <= (k) && (k) < hi)
#endif
#define SEAM(k) do { if (IN(k) && IN((k) + 1)) { XcdBarrier bar_; bar_.bar = (unsigned*)(kargs()->ws + WS_CTL) + CW_BAR; bar_.x = xb_xcc_id(); bar_.st = (volatile LAS unsigned*)(lds + MISC_OFF); xcd_barrier(bar_); } } while (0)
    if (lo < -12345) grid.sync();
    if (IN(0)) { if (REP(0)) phase_p0(a, lds); phase_p0(a, lds); }
    SEAM(0);
    if (IN(1)) for (int rep_ = 0; rep_ < 1 + REP(1); ++rep_) {
        pg8::Gemm g{(const bf16_t*)(a.ws + WS_XB), (const bf16_t*)(a.ws + WS_WIN), T, NINP, DM, 0, nullptr};
        pg8::StaticOrder S; S.init(T, NINP, (int)gridDim.x, (int)blockIdx.x);
        pg8::EpiInProj E{(bf16_t*)(a.ws + WS_Q), (bf16_t*)(a.ws + WS_K), (bf16_t*)(a.ws + WS_V), (bf16_t*)(a.ws + WS_OZ), (bf16_t*)(a.ws + WS_XBC), (float*)(a.ws + WS_GATES)};
        pg8::gemm_phase<pg8::EpiInProj, pg8::StaticOrder, false>(lds, g, S, E);
    }
    SEAM(1);
    if (IN(2)) { if (REP(2)) phase_ml_states(a, lds); phase_ml_states(a, lds); }
    SEAM(2);
    if (IN(3)) { if (REP(3)) phase_scan<true>(a, true); phase_scan<true>(a); }
    SEAM(3);
    if (IN(4)) { if (REP(4)) phase_ml_out(a, lds, DRYLVL); phase_ml_out(a, lds); }
    SEAM(4);
    if (IN(5)) { if (REP(5)) phase_ssd_states(a, lds); phase_ssd_states(a, lds); }
    SEAM(5);
    if (IN(6)) { if (REP(6)) phase_scan<false>(a, true); phase_scan<false>(a); }
    SEAM(6);
    if (IN(7)) { if (REP(7)) phase_ssd_out(a, lds, DRYLVL); phase_ssd_out(a, lds); }
    SEAM(7);
    if (IN(8)) for (int rep_ = 0; rep_ < 1 + REP(8); ++rep_) {
        pg8::Gemm g{(const bf16_t*)(a.ws + WS_OZ), (const bf16_t*)(a.ws + WS_WOUT), T, DM, 2048, 0, nullptr};
        pg8::StaticOrder S; S.init(T, DM, (int)gridDim.x, (int)blockIdx.x);
        pg8::EpiResF32 E{a.in[I_X], a.out, DM, ALPHA};
        pg8::gemm_phase<pg8::EpiResF32, pg8::StaticOrder, false>(lds, g, S, E);
    }
    SEAM(8);
    if (IN(9)) { if (REP(9)) phase_ln1_router(a, lds); phase_ln1_router(a, lds); }
    SEAM(9);
    if (IN(10)) { if (REP(10)) phase_lists(a, lds); phase_lists(a, lds); }
    SEAM(10);
    if (IN(11)) for (int rep_ = 0; rep_ < 1 + REP(11); ++rep_) moe_gemm1(a, lds, 0);
    SEAM(11);
    if (IN(12)) for (int rep_ = 0; rep_ < 1 + REP(12); ++rep_) moe_gemm2(a, lds, 0);
    SEAM(12);
    if (IN(13)) for (int rep_ = 0; rep_ < 1 + REP(13); ++rep_) { moe_combine(a, 0); moe_gemm1(a, lds, 1); }
    SEAM(13);
    if (IN(14)) for (int rep_ = 0; rep_ < 1 + REP(14); ++rep_) moe_gemm2(a, lds, 1);
    SEAM(14);
    if (IN(15)) for (int rep_ = 0; rep_ < 1 + REP(15); ++rep_) { moe_combine(a, 1); moe_gemm1(a, lds, 2); }
    SEAM(15);
    if (IN(16)) for (int rep_ = 0; rep_ < 1 + REP(16); ++rep_) moe_gemm2(a, lds, 2);
    SEAM(16);
    if (IN(17)) { if (REP(17)) moe_combine(a, 2); moe_combine(a, 2); }
#undef IN
#undef SEAM
#undef a
#undef lo
#undef hi
}

extern "C" void kernel_launch(void* const* d_in, const int* in_sizes, int n_in, void* d_out, int out_size, void* d_ws, size_t ws_size, hipStream_t stream) {
    static int grid = 0;
    if (grid == 0) {
        if (n_in != 24 || out_size != T * DM || ws_size < WS_END) { fprintf(stderr, "kernel_launch: unexpected problem (n_in %d, out %d, ws %zu); nothing launched\n", n_in, out_size, ws_size); grid = -1; return; }
        int dev = 0, cus = 0, per_cu = 0;
        hipGetDevice(&dev); hipDeviceGetAttribute(&cus, hipDeviceAttributeMultiprocessorCount, dev);
        hipFuncSetAttribute((const void*)fwd_megakernel, hipFuncAttributeMaxDynamicSharedMemorySize, LDS_BYTES);
        hipOccupancyMaxActiveBlocksPerMultiprocessor(&per_cu, (const void*)fwd_megakernel, 512, LDS_BYTES);
        if (per_cu < 1) { fprintf(stderr, "kernel_launch: occupancy query says %d blocks per CU\n", per_cu); per_cu = 1; }
        (void)hipGetLastError();
        grid = cus * per_cu; if (grid > 256) grid = 256;
    }
    if (grid < 0) return;
    hipMemsetAsync((char*)d_ws + WS_CTL, 0, 1 * MiB, stream);
    Args a{};
    for (int i = 0; i < 24; ++i) a.in[i] = (const float*)d_in[i];
    a.out = (float*)d_out; a.ws = (unsigned char*)d_ws; a.ph_lo = 0; a.ph_hi = N_PHASES;
    void* args[] = {&a};
    hipError_t e = hipLaunchCooperativeKernel((const void*)fwd_megakernel, dim3(grid), dim3(512), args, LDS_BYTES, stream);
    if (e != hipSuccess) fprintf(stderr, "cooperative launch failed: %s (grid %d)\n", hipGetErrorString(e), grid);
}
```

```cpp
#include <hip/hip_runtime.h>
#include <hip/hip_cooperative_groups.h>
#include <cstdio>
#include <cstdint>
namespace cg = cooperative_groups;

#define LAS __attribute__((address_space(3)))
typedef unsigned short bf16_t;
typedef short bf16x8 __attribute__((ext_vector_type(8)));
typedef short s16x4 __attribute__((ext_vector_type(4)));
typedef short v4i16_t __attribute__((ext_vector_type(4)));
typedef float f32x4 __attribute__((ext_vector_type(4)));
typedef float f32x2 __attribute__((ext_vector_type(2)));
typedef unsigned u32x4 __attribute__((ext_vector_type(4)));
typedef unsigned u32x2 __attribute__((ext_vector_type(2)));
typedef LAS unsigned char* ldsp;
typedef LAS const unsigned char* ldscp;

constexpr int BATCH = 8, SEQ = 4096, DM = 1024, T = BATCH * SEQ;
constexpr int NC = 32, CH = 128;
constexpr int NIN = 6192, NINP = 6144;
constexpr int NE = 64, TOPK = 8, DE = 256;
constexpr float LN_EPS = 1e-5f, RMS_EPS = 1e-5f;
constexpr float ALPHA = 1.189207115002721f;
constexpr float NEG_BIG = -1e30f;
constexpr int NPASS = 3;
constexpr int PASS_VB0[NPASS + 1] = {0, 88, 176, 256};
constexpr int PASS_MAXROWS = 106496 + 32768;
constexpr int PASS_MAXTILES = PASS_MAXROWS / 256;
constexpr int YS_ROW0 = 90624;

constexpr size_t MiB = 1u << 20;
constexpr size_t WS_CTL = 0;
constexpr size_t WS_WIN = 1 * MiB;
constexpr size_t WS_WOUT = 14 * MiB;
constexpr size_t WS_GATES = 18 * MiB;
constexpr size_t WS_MSTAT = 24 * MiB;
constexpr size_t WS_Q = 26 * MiB;
constexpr size_t WS_K = 58 * MiB;
constexpr size_t WS_V = 90 * MiB;
constexpr size_t WS_OZ = 154 * MiB;
constexpr size_t WS_XBC = 282 * MiB;
constexpr size_t WS_XB = 410 * MiB;
constexpr size_t WS_H = 26 * MiB;
constexpr size_t WS_W1T = 90 * MiB;
constexpr size_t WS_W2T = 155 * MiB;
constexpr size_t WS_Y = 188 * MiB;
constexpr size_t WS_ACT = 429 * MiB;
constexpr size_t WS_SELE = 497 * MiB;
constexpr size_t WS_SELW = 498 * MiB;
constexpr size_t WS_TOKPOS = 499 * MiB;
constexpr size_t WS_ROWTOK = 500 * MiB;
constexpr size_t WS_ROWGATE = 502 * MiB;
constexpr size_t WS_ROWY = 504 * MiB;
constexpr size_t WS_TILEE = 506 * MiB;
constexpr size_t WS_END = 507 * MiB;
static_assert((size_t)(YS_ROW0 + T) * DM * 2 <= (WS_ACT - WS_Y) && (size_t)PASS_MAXROWS * DE * 2 <= (WS_SELE - WS_ACT) && (size_t)NPASS * PASS_MAXROWS * 4 <= 2 * MiB, "MoE workspace map");
constexpr int MS_GM = 0;
constexpr int MS_MP = 4096;
constexpr int MS_U = 8192;
constexpr int MS_SD = 8192 + 262144;
constexpr int CW_BLOCKCNT = 1024;
constexpr int CW_NTILES = 512;
constexpr int CW_BAR = 32768;
constexpr int MISC_OFF = 159744 - 64;

constexpr int LDS_BYTES = 159744;

typedef __bf16 bf16x2_t __attribute__((ext_vector_type(2)));
__device__ __forceinline__ unsigned pk2(float lo, float hi) { const f32x2 v = {lo, hi}; const bf16x2_t b = __builtin_convertvector(v, bf16x2_t); return __builtin_bit_cast(unsigned, b); }
__device__ __forceinline__ unsigned f2bf(float f) { return pk2(f, 0.f) & 0xffffu; }
__device__ __forceinline__ float bflo(unsigned u) { return __builtin_bit_cast(float, u << 16); }
__device__ __forceinline__ float bfhi(unsigned u) { return __builtin_bit_cast(float, u & 0xffff0000u); }
__device__ __forceinline__ float bf2f(short s) { return __builtin_bit_cast(float, ((unsigned)(unsigned short)s) << 16); }
__device__ __forceinline__ float wave_sum(float v) {
#pragma unroll
    for (int o = 1; o < 64; o <<= 1) v += __shfl_xor(v, o);
    return v;
}
__device__ __forceinline__ float wave_max(float v) {
#pragma unroll
    for (int o = 1; o < 64; o <<= 1) v = fmaxf(v, __shfl_xor(v, o));
    return v;
}
__device__ __forceinline__ float wave_scan_add(float v, int lane) {
#pragma unroll
    for (int o = 1; o < 64; o <<= 1) { const float t = __shfl_up(v, o); if (lane >= o) v += t; }
    return v;
}
__device__ __forceinline__ float wave_scan_max(float v, int lane) {
#pragma unroll
    for (int o = 1; o < 64; o <<= 1) { const float t = __shfl_up(v, o); if (lane >= o) v = fmaxf(v, t); }
    return v;
}
__device__ __forceinline__ float sigmoidf_(float x) { return __builtin_amdgcn_rcpf(1.f + __expf(-x)); }
__device__ __forceinline__ float siluf_(float x) { return x * __builtin_amdgcn_rcpf(1.f + __expf(-x)); }
__device__ __forceinline__ float logsigmoidf_(float x) { return fminf(x, 0.f) - log1pf(__expf(-fabsf(x))); }
__device__ __forceinline__ float softplusf_(float x) { return fmaxf(x, 0.f) + log1pf(__expf(-fabsf(x))); }
__device__ __forceinline__ s16x4 vtr(ldscp p) { return __builtin_bit_cast(s16x4, __builtin_amdgcn_ds_read_tr16_b64_v4i16((LAS v4i16_t*)p)); }
__device__ __forceinline__ bf16x8 cat8(s16x4 lo, s16x4 hi) { return (bf16x8){lo[0], lo[1], lo[2], lo[3], hi[0], hi[1], hi[2], hi[3]}; }
#define BLOCK_SYNC() __syncthreads()
#define LDS_BARRIER() do { asm volatile("s_waitcnt lgkmcnt(0)" ::: "memory"); __builtin_amdgcn_s_barrier(); asm volatile("" ::: "memory"); } while (0)
__device__ __forceinline__ int launder(int v) { asm volatile("" : "+v"(v)); return v; }

namespace pg8 {
constexpr int BM = 256, BK = 64, HALF = 128, HTB = HALF * BK * 2, STAGE_BYTES = 8 * HTB, NXCD = 8, WGM = 8;
__host__ __device__ __forceinline__ int lds_byte(int r, int c) { const int st = (r >> 4) * 2 + (c >> 5), rr = r & 15, cc = c & 31, ob = rr * 64 + cc * 2; return st * 1024 + (ob ^ (((ob >> 9) & 1) << 5)); }
__host__ __device__ __forceinline__ void stage_rc(int b, int& R, int& C) { const int st = b / 1024, sb = b % 1024, swz = sb ^ (((sb >> 9) & 1) << 5); R = (st >> 1) * 16 + swz / 64; C = (st & 1) * 32 + (swz % 64) / 2; }
__host__ __device__ __forceinline__ int perm32(int rho) { const int n = rho >> 4, i = rho & 15; return 8 * (i >> 2) + 4 * n + (i & 3); }

struct Unit { int pm, pn, e; };
struct Gemm { const bf16_t* A; const bf16_t* Bt; int M, N, K; size_t bstride; const int* rowidx; };

struct StaticOrder {
    int nM, nN, nwg, G, c;
    __device__ void init(int M, int N, int G_, int c_) { nM = M / BM; nN = N / BM; nwg = nM * nN; G = G_; c = c_; }
    __device__ bool next(int i, Unit& u) const {
        const long L = (long)i * G + c; if (L >= nwg) return false;
        int wgid = (int)L; { const int q = nwg / NXCD, r = nwg % NXCD, xcd = wgid % NXCD, off = wgid / NXCD; wgid = (xcd < r ? xcd * (q + 1) : r * (q + 1) + (xcd - r) * q) + off; }
        const int nig = WGM * nN, gid = wgid / nig, fm = gid * WGM, gsz = (nM - fm) < WGM ? (nM - fm) : WGM;
        u.pm = fm + ((wgid % nig) % gsz); u.pn = (wgid % nig) / gsz; u.e = 0; return true;
    }
};
template <int NN, bool DYN> struct MoeOrder {
    int ntile, G, c, efix; const int* tile_e;
    __device__ __forceinline__ bool next(int i, Unit& u) const {
        const int L = i * G + c; if (L >= ntile * NN) return false;
        u.pm = L / NN; u.pn = L % NN; u.e = DYN ? tile_e[u.pm] : efix; return true;
    }
};

__device__ __forceinline__ unsigned cvt_pk_bf16(float lo, float hi) { unsigned r; asm volatile("v_cvt_pk_bf16_f32 %0, %1, %2" : "=v"(r) : "v"(lo), "v"(hi)); return r; }

template <class Epi, class Sched, bool GATHER>
__device__ __forceinline__ void gemm_phase(ldsp lds, const Gemm g, const Sched& S, const Epi& E) {
    const int tid = launder((int)threadIdx.x), wid = __builtin_amdgcn_readfirstlane(tid >> 6), lane = tid & 63, wr = wid >> 2, wc = wid & 3, fr = lane & 15, fq = lane >> 4;
    const int K = g.K, nt = K / BK;
    unsigned voffA[2], voffB[2]; int stR[2], stC[2];
#pragma unroll
    for (int i = 0; i < 2; ++i) { int R, C; stage_rc(tid * 16 + i * 8192, R, C); const int Rb = Epi::PERM ? ((R & ~31) + perm32(R & 31)) : R;
        stR[i] = R; stC[i] = C; voffA[i] = (unsigned)(R * K + C) * 2u; voffB[i] = (unsigned)(Rb * K + C) * 2u; }
    const size_t kstep = (size_t)(BK * 2);
    const size_t hstep = (size_t)HALF * K * 2;
    const size_t tstep = 2 * hstep;
    const unsigned ldsw = (unsigned)wid * 1024u;
    const int aoff = lds_byte(wr * 64 + fr, fq * 8), boff = lds_byte(wc * 32 + fr, fq * 8);
#define PG8_SA(b, h) (((b) * 2 + (h)) * HTB)
#define PG8_SB(b, h) ((4 + (b) * 2 + (h)) * HTB)
#define PG8_STAGE(bufoff, gbase, voff) do { _Pragma("unroll") for (int _i = 0; _i < 2; ++_i) \
        __builtin_amdgcn_global_load_lds((const unsigned*)((const char*)(gbase) + (voff)[_i]), (LAS unsigned*)(lds + (bufoff) + ldsw + _i * 8192), 16, 0, 0); } while (0)
#define PG8_LDA(dst, b, h) do { _Pragma("unroll") for (int m = 0; m < 4; ++m) _Pragma("unroll") for (int k = 0; k < 2; ++k) dst[m][k] = *(const LAS bf16x8*)(lds + PG8_SA(b, h) + aoff + m * 2048 + k * 1024); } while (0)
#define PG8_LDB(dst, b, h) do { _Pragma("unroll") for (int n = 0; n < 2; ++n) _Pragma("unroll") for (int k = 0; k < 2; ++k) dst[n][k] = *(const LAS bf16x8*)(lds + PG8_SB(b, h) + boff + n * 2048 + k * 1024); } while (0)
#define PG8_MMA(ai, bj, At, Bt) do { __builtin_amdgcn_s_setprio(1); _Pragma("unroll") for (int m = 0; m < 4; ++m) _Pragma("unroll") for (int n = 0; n < 2; ++n) _Pragma("unroll") for (int k = 0; k < 2; ++k) \
        acc[ai][bj][m][n] = __builtin_amdgcn_mfma_f32_16x16x32_bf16(Bt[n][k], At[m][k], acc[ai][bj][m][n], 0, 0, 0); __builtin_amdgcn_s_setprio(0); } while (0)
#define PG8_WAIT_V(n) asm volatile("s_waitcnt vmcnt(" #n ")" ::: "memory")
#define PG8_WAIT_L(n) asm volatile("s_waitcnt lgkmcnt(" #n ")" ::: "memory")
#define PG8_BAR __builtin_amdgcn_s_barrier()
#define PG8_SCHED __builtin_amdgcn_sched_barrier(0)
    Unit cur, nxt; int ui = 0;
    if (!S.next(0, cur)) return;
    f32x4 acc[2][2][4][2];
#pragma unroll
    for (int a = 0; a < 2; ++a)
#pragma unroll
        for (int b = 0; b < 2; ++b)
#pragma unroll
            for (int m = 0; m < 4; ++m)
#pragma unroll
                for (int n = 0; n < 2; ++n) acc[a][b][m][n] = (f32x4){0.f, 0.f, 0.f, 0.f};
    bf16x8 At[4][2], B0[2][2], B1[2][2];
    unsigned gc[2][2], gn[2][2];
    auto load_g = [&](unsigned (&dst)[2][2], const Unit& u) {
#pragma unroll
        for (int h = 0; h < 2; ++h)
#pragma unroll
            for (int i = 0; i < 2; ++i) { const int src = g.rowidx[u.pm * BM + h * HALF + stR[i]]; dst[h][i] = (unsigned)(src * K + stC[i]) * 2u; }
    };
    const char* cA = GATHER ? (const char*)g.A : (const char*)g.A + (size_t)cur.pm * tstep;
    const char* cB = (const char*)g.Bt + (size_t)cur.e * g.bstride + (size_t)cur.pn * tstep;
#define PG8_STA(bufoff, h, ptr, garr) do { if constexpr (GATHER) { PG8_STAGE(bufoff, ptr, garr[h]); } else { PG8_STAGE(bufoff, (ptr) + (h) * hstep, voffA); } } while (0)
    if constexpr (GATHER) { load_g(gc, cur); }
    PG8_STAGE(PG8_SB(0, 0), cB, voffB); PG8_STAGE(PG8_SB(0, 1), cB + hstep, voffB); PG8_STA(PG8_SA(0, 0), 0, cA, gc); PG8_STA(PG8_SA(0, 1), 1, cA, gc);
    if (wr == 1) PG8_BAR;
    PG8_WAIT_V(2); PG8_BAR;
    PG8_STAGE(PG8_SB(1, 0), cB + kstep, voffB); PG8_STA(PG8_SA(1, 0), 0, cA + kstep, gc); PG8_STAGE(PG8_SB(1, 1), cB + hstep + kstep, voffB);
    PG8_WAIT_V(6); PG8_BAR;
    for (;;) {
        const bool has_next = S.next(ui + 1, nxt);
        const char* nA = GATHER ? (const char*)g.A : (has_next ? (const char*)g.A + (size_t)nxt.pm * tstep : cA);
        const char* nB = has_next ? (const char*)g.Bt + (size_t)nxt.e * g.bstride + (size_t)nxt.pn * tstep : cB;
        if constexpr (GATHER) { if (has_next) load_g(gn, nxt); else {
#pragma unroll
            for (int h = 0; h < 2; ++h)
#pragma unroll
                for (int i = 0; i < 2; ++i) gn[h][i] = gc[h][i]; } }
        for (int t = 0; t < nt; t += 2) {
            const bool last = (t == nt - 2);
            const char* a1 = cA + (size_t)(t + 1) * kstep;
            const char* a2 = last ? nA : cA + (size_t)(t + 2) * kstep; const char* b2 = last ? nB : cB + (size_t)(t + 2) * kstep;
            const char* a3 = a2 + kstep; const char* b3 = b2 + kstep;
#define PG8_STA2(bufoff, h, ptr) do { if constexpr (GATHER) { if (last) { PG8_STAGE(bufoff, ptr, gn[h]); } else { PG8_STAGE(bufoff, ptr, gc[h]); } } else { PG8_STAGE(bufoff, (ptr) + (h) * hstep, voffA); } } while (0)
            PG8_LDB(B0, 0, 0); PG8_LDB(B1, 0, 1); PG8_SCHED; PG8_LDA(At, 0, 0); PG8_STA(PG8_SA(1, 1), 1, a1, gc);
            PG8_WAIT_V(8); PG8_WAIT_L(0); PG8_BAR; PG8_MMA(0, 0, At, B0); PG8_MMA(0, 1, At, B1); PG8_BAR; PG8_SCHED;
            PG8_LDA(At, 0, 1); PG8_STAGE(PG8_SB(0, 0), b2, voffB); PG8_STAGE(PG8_SB(0, 1), b2 + hstep, voffB); PG8_STA2(PG8_SA(0, 0), 0, a2);
            PG8_WAIT_V(8); PG8_WAIT_L(0); PG8_BAR; PG8_MMA(1, 0, At, B0); PG8_MMA(1, 1, At, B1); PG8_BAR; PG8_SCHED;
            PG8_LDB(B0, 1, 0); PG8_LDB(B1, 1, 1); PG8_SCHED; PG8_LDA(At, 1, 0); PG8_STA2(PG8_SA(0, 1), 1, a2);
            PG8_WAIT_V(8); PG8_WAIT_L(0); PG8_BAR; PG8_MMA(0, 0, At, B0); PG8_MMA(0, 1, At, B1); PG8_BAR; PG8_SCHED;
            PG8_LDA(At, 1, 1); PG8_STAGE(PG8_SB(1, 0), b3, voffB); PG8_STAGE(PG8_SB(1, 1), b3 + hstep, voffB); PG8_STA2(PG8_SA(1, 0), 0, a3);
            PG8_WAIT_V(8); PG8_WAIT_L(0); PG8_BAR; PG8_MMA(1, 0, At, B0); PG8_MMA(1, 1, At, B1); PG8_BAR; PG8_SCHED;
        }
        if (wr == 0) PG8_BAR;
        E(acc, cur, wr, wc, fr, fq);
        if (!has_next) break;
#pragma unroll
        for (int a = 0; a < 2; ++a)
#pragma unroll
            for (int b = 0; b < 2; ++b)
#pragma unroll
                for (int m = 0; m < 4; ++m)
#pragma unroll
                    for (int n = 0; n < 2; ++n) acc[a][b][m][n] = (f32x4){0.f, 0.f, 0.f, 0.f};
        cur = nxt; cA = nA; cB = nB; ++ui;
        if constexpr (GATHER) {
#pragma unroll
            for (int h = 0; h < 2; ++h)
#pragma unroll
                for (int i = 0; i < 2; ++i) gc[h][i] = gn[h][i];
        }
        if (wr == 1) PG8_BAR;
    }
    PG8_WAIT_V(0);
    PG8_BAR;
#undef PG8_SA
#undef PG8_SB
#undef PG8_STAGE
#undef PG8_STA
#undef PG8_STA2
#undef PG8_LDA
#undef PG8_LDB
#undef PG8_MMA
#undef PG8_WAIT_V
#undef PG8_WAIT_L
#undef PG8_BAR
#undef PG8_SCHED
}

struct EpiInProj {
    static constexpr bool PERM = true;
    bf16_t *q, *k, *v, *oz, *xbc; float* gates;
    __device__ __forceinline__ void operator()(const f32x4 (&acc)[2][2][4][2], const Unit& u, int wr, int wc, int fr, int fq) const {
        const int row0 = u.pm * BM + wr * 64 + fr, pn = u.pn;
        bf16_t* base; int ld, colt;
        if (pn < 2) { base = q; ld = 512; colt = pn * 256; }
        else if (pn < 4) { base = k; ld = 512; colt = (pn - 2) * 256; }
        else if (pn < 8) { base = v; ld = 1024; colt = (pn - 4) * 256; }
        else if (pn < 16) { base = oz; ld = 2048; colt = (pn - 8) * 256; }
        else { base = xbc; ld = 2048; colt = (pn - 16) * 256; }
        const int col0 = colt + wc * 32 + 8 * fq;
#pragma unroll
        for (int ai = 0; ai < 2; ++ai)
#pragma unroll
            for (int m = 0; m < 4; ++m) { bf16_t* rowp = base + (size_t)(row0 + ai * HALF + m * 16) * ld + col0;
#pragma unroll
                for (int bj = 0; bj < 2; ++bj) { const f32x4 v0 = acc[ai][bj][m][0], v1 = acc[ai][bj][m][1];
                    u32x4 w; w.x = cvt_pk_bf16(v0[0], v0[1]); w.y = cvt_pk_bf16(v0[2], v0[3]); w.z = cvt_pk_bf16(v1[0], v1[1]); w.w = cvt_pk_bf16(v1[2], v1[3]);
                    *(u32x4*)(rowp + bj * HALF) = w; } }
    }
};
struct EpiResF32 {
    static constexpr bool PERM = false;
    const float* res; float* out; int ldc; float alpha;
    __device__ __forceinline__ void operator()(const f32x4 (&acc)[2][2][4][2], const Unit& u, int wr, int wc, int fr, int fq) const {
        const int col0 = u.pn * BM + wc * 32 + 4 * fq;
#pragma unroll
        for (int ai = 0; ai < 2; ++ai)
#pragma unroll
            for (int m = 0; m < 4; ++m) { const size_t off = (size_t)(u.pm * BM + ai * HALF + wr * 64 + m * 16 + fr) * ldc + col0;
                f32x4 r[2][2];
#pragma unroll
                for (int bj = 0; bj < 2; ++bj)
#pragma unroll
                    for (int n = 0; n < 2; ++n) r[bj][n] = *(const f32x4*)(res + off + bj * HALF + n * 16);
#pragma unroll
                for (int bj = 0; bj < 2; ++bj)
#pragma unroll
                    for (int n = 0; n < 2; ++n) *(f32x4*)(out + off + bj * HALF + n * 16) = acc[ai][bj][m][n] + r[bj][n] * alpha;
                asm volatile("" ::: "memory"); }
    }
};
struct EpiF32 {
    static constexpr bool PERM = false;
    float* out; int ldc;
    __device__ __forceinline__ void operator()(const f32x4 (&acc)[2][2][4][2], const Unit& u, int wr, int wc, int fr, int fq) const {
        const int col0 = u.pn * BM + wc * 32 + 4 * fq;
#pragma unroll
        for (int ai = 0; ai < 2; ++ai)
#pragma unroll
            for (int m = 0; m < 4; ++m) { float* rowp = out + (size_t)(u.pm * BM + ai * HALF + wr * 64 + m * 16 + fr) * ldc + col0;
#pragma unroll
                for (int bj = 0; bj < 2; ++bj)
#pragma unroll
                    for (int n = 0; n < 2; ++n) *(f32x4*)(rowp + bj * HALF + n * 16) = acc[ai][bj][m][n];
                asm volatile("" ::: "memory"); }
    }
};
struct EpiSwiGLU {
    static constexpr bool PERM = true;
    bf16_t* act;
    __device__ __forceinline__ void operator()(const f32x4 (&acc)[2][2][4][2], const Unit& u, int wr, int wc, int fr, int fq) const {
        const int row0 = u.pm * BM + wr * 64 + fr, col0 = u.pn * 128 + wc * 32 + 8 * fq;
#pragma unroll
        for (int ai = 0; ai < 2; ++ai)
#pragma unroll
            for (int m = 0; m < 4; ++m) { bf16_t* rowp = act + (size_t)(row0 + ai * HALF + m * 16) * DE + col0;
                float r[8];
#pragma unroll
                for (int n = 0; n < 2; ++n)
#pragma unroll
                    for (int j = 0; j < 4; ++j) { const float gt = acc[ai][0][m][n][j], up = acc[ai][1][m][n][j]; r[n * 4 + j] = gt * __builtin_amdgcn_rcpf(1.f + __expf(-gt)) * up; }
                u32x4 w; w.x = cvt_pk_bf16(r[0], r[1]); w.y = cvt_pk_bf16(r[2], r[3]); w.z = cvt_pk_bf16(r[4], r[5]); w.w = cvt_pk_bf16(r[6], r[7]);
                *(u32x4*)rowp = w; asm volatile("" ::: "memory"); }
    }
};
struct EpiDownY {
    static constexpr bool PERM = true;
    bf16_t* Y; const int* rowy; const float* rowgate;
    __device__ __forceinline__ void operator()(const f32x4 (&acc)[2][2][4][2], const Unit& u, int wr, int wc, int fr, int fq) const {
        const int row0 = u.pm * BM + wr * 64 + fr, col0 = u.pn * BM + wc * 32 + 8 * fq;
#pragma unroll
        for (int ai = 0; ai < 2; ++ai) {
            int yrv[4]; float gtv[4];
#pragma unroll
            for (int m = 0; m < 4; ++m) { const int row = row0 + ai * HALF + m * 16; yrv[m] = rowy[row]; gtv[m] = rowgate[row]; }
#pragma unroll
            for (int m = 0; m < 4; ++m) { const int yr = yrv[m]; const float gt = gtv[m];
                bf16_t* rowp = Y + (size_t)yr * DM + col0;
#pragma unroll
                for (int bj = 0; bj < 2; ++bj) { const f32x4 v0 = acc[ai][bj][m][0] * gt, v1 = acc[ai][bj][m][1] * gt;
                    u32x4 w; w.x = cvt_pk_bf16(v0[0], v0[1]); w.y = cvt_pk_bf16(v0[2], v0[3]); w.z = cvt_pk_bf16(v1[0], v1[1]); w.w = cvt_pk_bf16(v1[2], v1[3]);
                    *(u32x4*)(rowp + bj * HALF) = w; }
                asm volatile("" ::: "memory"); }
        }
    }
};
}

struct Args { const float* in[24]; float* out; unsigned char* ws; int ph_lo, ph_hi; };
typedef const __attribute__((address_space(4))) Args& ArgsRef;
enum { I_X = 0, I_WIN, I_MLIB, I_MLFB, I_MLNW, I_CONVW, I_CONVB, I_DTB, I_ALOG, I_DSKIP, I_SSMNW, I_WOUT, I_LN1G, I_LN1B, I_WR, I_RB, I_WEG, I_WEU, I_WED, I_WSG, I_WSU, I_WSD, I_LN2G, I_LN2B };

__device__ __forceinline__ void transpose_item(const float* W, int ldw, int k0, int c0, bf16_t* WT, int ldk, int r0, float scale, LAS float* scr, int lane) {
#pragma unroll 8
    for (int i = 0; i < 32; ++i) { const int kk = 2 * i + (lane >> 5); scr[kk * 33 + (lane & 31)] = W[(size_t)(k0 + kk) * ldw + c0 + (lane & 31)]; }
    asm volatile("s_waitcnt lgkmcnt(0)" ::: "memory");
    const int c = lane & 7;
#pragma unroll
    for (int j = 0; j < 4; ++j) { const int n = (lane >> 3) + 8 * j; const LAS float* s = scr + (8 * c) * 33 + n;
        u32x4 o; o.x = pk2(s[0 * 33] * scale, s[1 * 33] * scale); o.y = pk2(s[2 * 33] * scale, s[3 * 33] * scale); o.z = pk2(s[4 * 33] * scale, s[5 * 33] * scale); o.w = pk2(s[6 * 33] * scale, s[7 * 33] * scale);
        *(u32x4*)(WT + (size_t)(r0 + n) * ldk + k0 + 8 * c) = o; }
    asm volatile("s_waitcnt lgkmcnt(0)" ::: "memory");
}

__device__ __forceinline__ void phase_p0(ArgsRef a, ldsp lds) {
    const int tid = launder((int)threadIdx.x), lane = tid & 63, wave = tid >> 6, G = gridDim.x;
    const int gw = blockIdx.x * 8 + wave, NGW = G * 8;
    LAS float* scr = (LAS float*)(lds + wave * 8448);
    const float* x = a.in[I_X]; bf16_t* xb = (bf16_t*)(a.ws + WS_XB);
    bf16_t* wint = (bf16_t*)(a.ws + WS_WIN); bf16_t* woutt = (bf16_t*)(a.ws + WS_WOUT);
    constexpr int NI_WIN = 192 * 16, NI_WOUT = 32 * 32;
    for (int it = gw; it < NI_WIN + NI_WOUT; it += NGW) {
        if (it < NI_WIN) {
            const int cb = it % 192, kb = it / 192; const int dr = cb * 32;
            int sc; float scale = 1.f;
            if (dr < 512) sc = dr; else if (dr < 1024) { sc = dr; scale = 0.08838834764831845f; } else if (dr < 3072) sc = dr; else sc = dr + 16;
            transpose_item(a.in[I_WIN], NIN, kb * 64, sc, wint, DM, dr, scale, scr, lane);
        } else {
            const int r = it - NI_WIN; const int cb = r % 32, kb = r / 32;
            transpose_item(a.in[I_WOUT], DM, kb * 64, cb * 32, woutt, 2048, cb * 32, 1.f, scr, lane);
        }
    }
    LDS_BARRIER();
    constexpr int WP = 2064;
    for (int e = tid; e < 48 * DM; e += 512) { const int k = e / 48, n = e % 48; const int col = n < 16 ? 3072 + n : 6160 + (n - 16);
        *(LAS unsigned short*)(lds + n * WP + k * 2) = (unsigned short)f2bf(a.in[I_WIN][(size_t)k * NIN + col]); }
    LDS_BARRIER();
    float* gates = (float*)(a.ws + WS_GATES);
    const int fr = lane & 15, fq = lane >> 4;
    for (int grp = gw; grp < T / 16; grp += NGW) {
        const float* xr = x + (size_t)(grp * 16 + fr) * DM + 8 * fq; bf16_t* xo = xb + (size_t)(grp * 16 + fr) * DM + 8 * fq;
        f32x4 acc[3];
#pragma unroll
        for (int nt = 0; nt < 3; ++nt) acc[nt] = (f32x4){0.f, 0.f, 0.f, 0.f};
#pragma unroll 1
        for (int kc = 0; kc < 4; ++kc) {
            f32x4 v[8][2];
#pragma unroll
            for (int ks = 0; ks < 8; ++ks) { v[ks][0] = *(const f32x4*)(xr + 256 * kc + 32 * ks); v[ks][1] = *(const f32x4*)(xr + 256 * kc + 32 * ks + 4); }
#pragma unroll
            for (int ks = 0; ks < 8; ++ks) {
                u32x4 pk; pk.x = pk2(v[ks][0][0], v[ks][0][1]); pk.y = pk2(v[ks][0][2], v[ks][0][3]); pk.z = pk2(v[ks][1][0], v[ks][1][1]); pk.w = pk2(v[ks][1][2], v[ks][1][3]);
                *(u32x4*)(xo + 256 * kc + 32 * ks) = pk;
                const bf16x8 af = __builtin_bit_cast(bf16x8, pk);
#pragma unroll
                for (int nt = 0; nt < 3; ++nt) { const bf16x8 wf = *(const LAS bf16x8*)(lds + (16 * nt + fr) * WP + (256 * kc + 32 * ks + 8 * fq) * 2);
                    acc[nt] = __builtin_amdgcn_mfma_f32_16x16x32_bf16(wf, af, acc[nt], 0, 0, 0); }
            }
        }
#pragma unroll
        for (int nt = 0; nt < 3; ++nt) *(f32x4*)(gates + (size_t)(grp * 16 + fr) * 48 + 16 * nt + 4 * fq) = acc[nt];
    }
    LDS_BARRIER();
}

__device__ __forceinline__ void chunk_state_gemm(ldscp P, int pitchP, ldscp Q, int pitchQ, const LAS float* w, bf16_t* out, int lane) {
    const int g = lane >> 4, q = (lane & 15) >> 2, p = lane & 3, fr = lane & 15;
    f32x4 acc[8][4];
#pragma unroll
    for (int i = 0; i < 8; ++i)
#pragma unroll
        for (int j = 0; j < 4; ++j) acc[i][j] = (f32x4){0.f, 0.f, 0.f, 0.f};
#pragma unroll 1
    for (int ks = 0; ks < 4; ++ks) {
        const int srow = 32 * ks + 8 * g;
        const f32x4 w0 = *(const LAS f32x4*)(w + srow), w1 = *(const LAS f32x4*)(w + srow + 4);
        bf16x8 qf[4];
#pragma unroll
        for (int jt = 0; jt < 4; ++jt) {
            ldscp ad = Q + (srow + q) * pitchQ + (16 * jt + 4 * p) * 2;
            const s16x4 lo = vtr(ad), hi = vtr(ad + 4 * pitchQ);
            u32x4 pk; pk.x = pk2(bf2f(lo[0]) * w0[0], bf2f(lo[1]) * w0[1]); pk.y = pk2(bf2f(lo[2]) * w0[2], bf2f(lo[3]) * w0[3]);
            pk.z = pk2(bf2f(hi[0]) * w1[0], bf2f(hi[1]) * w1[1]); pk.w = pk2(bf2f(hi[2]) * w1[2], bf2f(hi[3]) * w1[3]);
            qf[jt] = __builtin_bit_cast(bf16x8, pk);
        }
#pragma unroll
        for (int it = 0; it < 8; ++it) {
            ldscp ad = P + (srow + q) * pitchP + (16 * it + 4 * p) * 2;
            const bf16x8 pf = cat8(vtr(ad), vtr(ad + 4 * pitchP));
#pragma unroll
            for (int jt = 0; jt < 4; ++jt) acc[it][jt] = __builtin_amdgcn_mfma_f32_16x16x32_bf16(pf, qf[jt], acc[it][jt], 0, 0, 0);
        }
    }
#pragma unroll
    for (int it = 0; it < 8; ++it)
#pragma unroll
        for (int jt = 0; jt < 4; ++jt) { u32x2 o; o.x = pk2(acc[it][jt][0], acc[it][jt][1]); o.y = pk2(acc[it][jt][2], acc[it][jt][3]);
            *(u32x2*)(out + (size_t)(16 * jt + fr) * 128 + 16 * it + 4 * g) = o; }
}

constexpr int P128 = 288, P256 = 544;
constexpr int P128R = 272;

struct MlVec { float ig[2], bb[2], colw[2]; float g; };
__device__ __forceinline__ MlVec ml_chunk_vec(const float* gates, int row0, int d, int h, float ib, float fb, int lane) {
    MlVec r; float lf[2];
#pragma unroll
    for (int j = 0; j < 2; ++j) { const int u = 2 * lane + j, t = d ? 127 - u : u; const float* gr = gates + (size_t)(row0 + t) * 48;
        r.ig[j] = gr[d * 4 + h] + ib; lf[j] = logsigmoidf_(gr[8 + d * 4 + h] + fb); }
    const float loc1 = lf[0] + lf[1]; const float s = wave_scan_add(loc1, lane); const float ex = s - loc1;
    r.bb[0] = ex + lf[0]; r.bb[1] = s; r.g = __shfl(s, 63);
    r.colw[0] = r.ig[0] - r.bb[0]; r.colw[1] = r.ig[1] - r.bb[1];
    return r;
}

__device__ __forceinline__ void phase_ml_states(ArgsRef a, ldsp lds) {
    const int tid = launder((int)threadIdx.x), lane = tid & 63, wave = __builtin_amdgcn_readfirstlane(tid >> 6), G = gridDim.x;
    const bf16_t* Kb = (const bf16_t*)(a.ws + WS_K); const bf16_t* Vb = (const bf16_t*)(a.ws + WS_V);
    const float* gates = (const float*)(a.ws + WS_GATES); float* ms = (float*)(a.ws + WS_MSTAT);
    bf16_t* ST = (bf16_t*)a.out;
    ldsp Kt = lds, Vt = lds + 36864; LAS float* wv = (LAS float*)(lds + 106496);
    for (int item = blockIdx.x; item < BATCH * 4 * NC; item += G) {
        const int c = item % NC, h = (item / NC) % 4, b = item / (NC * 4); const int row0 = b * SEQ + c * CH;
#pragma unroll
        for (int i = 0; i < 4; ++i) { const int id = tid + 512 * i, r = id >> 4, ch = id & 15;
            *(LAS u32x4*)(Kt + r * P128 + ch * 16) = *(const u32x4*)(Kb + (size_t)(row0 + r) * 512 + h * 128 + ch * 8); }
#pragma unroll
        for (int i = 0; i < 8; ++i) { const int id = tid + 512 * i, r = id >> 5, ch = id & 31;
            *(LAS u32x4*)(Vt + r * P256 + ch * 16) = *(const u32x4*)(Vb + (size_t)(row0 + r) * 1024 + h * 256 + ch * 8); }
        if (wave < 2) {
            const int d = wave; const MlVec v = ml_chunk_vec(gates, row0, d, h, a.in[I_MLIB][d * 4 + h], a.in[I_MLFB][d * 4 + h], lane);
            const float a0 = v.g + v.colw[0], a1 = v.g + v.colw[1]; const float ml = wave_max(fmaxf(a0, a1));
#pragma unroll
            for (int j = 0; j < 2; ++j) { const int u = 2 * lane + j, t = d ? 127 - u : u; wv[d * 128 + t] = __expf((j ? a1 : a0) - ml); }
            if (lane == 0) { const int chain = (b * 4 + h) * 2 + d; ms[MS_GM + (chain * 32 + c) * 2] = v.g; ms[MS_GM + (chain * 32 + c) * 2 + 1] = ml; }
        }
        LDS_BARRIER();
        if (tid < 256) { const int d = tid >> 7, dk = tid & 127; float s = 0.f;
            for (int r = 0; r < 128; ++r) s += wv[d * 128 + r] * bf2f(*(const LAS short*)(Kt + r * P128 + dk * 2));
            ms[MS_U + (size_t)(((b * 4 + h) * 2 + d) * 32 + c) * 128 + dk] = s; }
        { const int d = wave >> 2, qd = wave & 3;
          bf16_t* out = ST + ((size_t)(((b * 4 + h) * 2 + d) * 32 + c) * 256 + 64 * qd) * 128;
          chunk_state_gemm(Kt, P128, Vt + 64 * qd * 2, P256, wv + d * 128, out, lane); }
        LDS_BARRIER();
    }
}

template <bool ML, bool REV>
__device__ __forceinline__ void scan_chain(const float* ms, const bf16_t* base, bf16_t* wbase, int chain, float (&st)[8], float& m) {
    constexpr int E = ML ? 32768 : 8192;
#pragma unroll 1
    for (int half = 0; half < 2; ++half) {
        const int cb0 = (REV ? 1 - half : half) * 16;
        u32x4 buf[16]; float dcy[16], scl[16];
#pragma unroll
        for (int j = 0; j < 16; ++j) buf[j] = *(const u32x4*)(base + (size_t)(cb0 + j) * E);
#pragma unroll
        for (int j = 0; j < 16; ++j) { const int c = cb0 + j;
            if (ML) { dcy[j] = ms[MS_GM + (chain * 32 + c) * 2]; scl[j] = ms[MS_GM + (chain * 32 + c) * 2 + 1]; }
            else { dcy[j] = ms[MS_SD + chain * 32 + c]; scl[j] = 1.f; } }
#pragma unroll
        for (int step = 0; step < 16; ++step) {
            const int j = REV ? 15 - step : step; const int c = cb0 + j;
            const u32x4 cur = buf[j];
            float decay = dcy[j], scale = scl[j];
            if (ML) { const float g = decay, ml = scale; const float mn = fmaxf(g + m, ml); decay = __expf(g + m - mn); scale = __expf(ml - mn); m = mn; }
            u32x4 o; o.x = pk2(st[0], st[1]); o.y = pk2(st[2], st[3]); o.z = pk2(st[4], st[5]); o.w = pk2(st[6], st[7]);
            *(u32x4*)(wbase + (size_t)c * E) = o;
            st[0] = decay * st[0] + scale * bflo(cur.x); st[1] = decay * st[1] + scale * bfhi(cur.x);
            st[2] = decay * st[2] + scale * bflo(cur.y); st[3] = decay * st[3] + scale * bfhi(cur.y);
            st[4] = decay * st[4] + scale * bflo(cur.z); st[5] = decay * st[5] + scale * bfhi(cur.z);
            st[6] = decay * st[6] + scale * bflo(cur.w); st[7] = decay * st[7] + scale * bfhi(cur.w);
        }
    }
}

template <bool ML>
__device__ __forceinline__ void phase_scan(ArgsRef a, bool dry = false) {
    const int tid = launder((int)threadIdx.x), G = gridDim.x;
    float* ms = (float*)(a.ws + WS_MSTAT); bf16_t* ST = (bf16_t*)a.out;
    constexpr int E = ML ? 32768 : 8192, VPC = E / 8, NCHAIN = ML ? 64 : 256, NV = NCHAIN * VPC, NX = ML ? 64 * 128 : 0;
    for (int it = blockIdx.x * 512 + tid; it < (dry ? NV / 2 : NV + NX); it += G * 512) {
        if (it < NV) {
            const int chain = it / VPC, vi = it % VPC, d = chain & 1;
            float st[8];
#pragma unroll
            for (int j = 0; j < 8; ++j) st[j] = 0.f;
            float m = NEG_BIG;
            bf16_t* base = ST + (size_t)chain * 32 * E + vi * 8;
            bf16_t* wbase = dry ? (bf16_t*)(a.ws + WS_XB) + (base - ST) : base;
            if (d == 0) scan_chain<ML, false>(ms, base, wbase, chain, st, m);
            else scan_chain<ML, true>(ms, base, wbase, chain, st, m);
        } else if (ML) {
            const int idx = it - NV, chain = idx >> 7, dk = idx & 127, d = chain & 1;
            float n = 0.f, m = NEG_BIG;
            for (int step = 0; step < 32; ++step) {
                const int c = d ? 31 - step : step;
                const float g = ms[MS_GM + (chain * 32 + c) * 2], ml = ms[MS_GM + (chain * 32 + c) * 2 + 1]; const float mn = fmaxf(g + m, ml);
                const float decay = __expf(g + m - mn), scale = __expf(ml - mn);
                float* up = ms + MS_U + (size_t)(chain * 32 + c) * 128 + dk; const float u = *up; *up = n;
                if (dk == 0) ms[MS_MP + chain * 32 + c] = m;
                n = decay * n + scale * u; m = mn;
            }
        }
    }
}

__device__ __forceinline__ void phase_ml_out(ArgsRef a, ldsp lds, int dry = 0) {
    const int tid = launder((int)threadIdx.x), lane = tid & 63, wave = __builtin_amdgcn_readfirstlane(tid >> 6), G = gridDim.x;
    const int fr_ = lane & 15, fq_ = lane >> 4;
    const bf16_t* Qb = (const bf16_t*)(a.ws + WS_Q); const bf16_t* Kb = (const bf16_t*)(a.ws + WS_K); const bf16_t* Vb = (const bf16_t*)(a.ws + WS_V);
    bf16_t* OZ = (bf16_t*)(a.ws + WS_OZ);
    const float* gates = (const float*)(a.ws + WS_GATES); const float* ms = (const float*)(a.ws + WS_MSTAT);
    const bf16_t* ST = (const bf16_t*)a.out;
    ldsp Qt = lds, Kt = lds + 36864, Xt = lds + 73728;
    LAS float* vec = (LAS float*)(lds + 147456);
    LAS float* npv = vec + 1280;
    LAS float* nwl = npv + 256;
    for (int i = tid; i < 1024; i += 512) nwl[i] = a.in[I_MLNW][i];
    for (int item = blockIdx.x; item < BATCH * 4 * NC; item += G) {
        const int c = item % NC, h = (item / NC) % 4, b = item / (NC * 4); const int row0 = b * SEQ + c * CH;
        const int chain0 = (b * 4 + h) * 2;
        const int fr = launder(fr_), fq = launder(fq_), g4 = fq, q4 = fr >> 2, p4 = fr & 3;
#pragma unroll
        for (int i = 0; i < 4; ++i) { const int id = tid + 512 * i, r = id >> 4, ch = id & 15;
            *(LAS u32x4*)(Qt + r * P128R + ch * 16) = *(const u32x4*)(Qb + (size_t)(row0 + r) * 512 + h * 128 + ch * 8);
            *(LAS u32x4*)(Kt + r * P128R + ch * 16) = *(const u32x4*)(Kb + (size_t)(row0 + r) * 512 + h * 128 + ch * 8); }
        { const bf16_t* cp = ST + (size_t)((chain0 + 0) * 32 + c) * 32768;
#pragma unroll
          for (int i = 0; i < 8; ++i) { const int id = tid + 512 * i, r = id >> 4, ch = id & 15;
              *(LAS u32x4*)(Xt + r * P128R + ch * 16) = *(const u32x4*)(cp + (size_t)r * 128 + ch * 8); } }
        if (wave < 2) {
            const int d = wave; const MlVec v = ml_chunk_vec(gates, row0, d, h, a.in[I_MLIB][d * 4 + h], a.in[I_MLFB][d * 4 + h], lane);
            const float mp = ms[MS_MP + (chain0 + d) * 32 + c];
            const float cm1 = fmaxf(v.colw[0], v.colw[1]); const float sc = wave_scan_max(cm1, lane); float ex = __shfl_up(sc, 1); if (lane == 0) ex = NEG_BIG;
            const float cmax[2] = {fmaxf(ex, v.colw[0]), sc};
#pragma unroll
            for (int j = 0; j < 2; ++j) { const int u = 2 * lane + j, t = d ? 127 - u : u; const float ro = fmaxf(mp, cmax[j]);
                LAS float* vd = vec + d * 640;
                vd[t] = v.colw[j]; vd[128 + t] = ro; vd[256 + t] = __expf(mp - ro); vd[384 + t] = __expf(-(v.bb[j] + ro)); }
        } else if (wave < 6) {
            const int i2 = tid - 128; const int d = i2 >> 7, dk = i2 & 127; npv[d * 128 + dk] = ms[MS_U + (size_t)((chain0 + d) * 32 + c) * 128 + dk];
        }
        LDS_BARRIER();
        if (dry == 2) { LDS_BARRIER(); continue; }

        { const int pr = tid >> 1, part = tid & 1, d = pr >> 7, t = pr & 127; float s = 0.f;
          for (int k = 0; k < 64; ++k) { const int dk = part * 64 + k; s += bf2f(*(const LAS short*)(Qt + t * P128R + dk * 2)) * npv[d * 128 + dk]; }
          s += __shfl_xor(s, 1); if (part == 0) vec[d * 640 + 512 + t] = s; }
        f32x4 sacc[8];
#pragma unroll
        for (int i = 0; i < 8; ++i) sacc[i] = (f32x4){0.f, 0.f, 0.f, 0.f};
        bf16x8 qf[4];
#pragma unroll
        for (int ks = 0; ks < 4; ++ks) qf[ks] = *(const LAS bf16x8*)(Qt + (16 * wave + fr) * P128R + (32 * ks + 8 * fq) * 2);
#pragma unroll
        for (int ks = 0; ks < 4; ++ks)
#pragma unroll
            for (int i = 0; i < 8; ++i) { const bf16x8 kf = *(const LAS bf16x8*)(Kt + (16 * i + fr) * P128R + (32 * ks + 8 * fq) * 2);
                sacc[i] = __builtin_amdgcn_mfma_f32_16x16x32_bf16(kf, qf[ks], sacc[i], 0, 0, 0); }
        LDS_BARRIER();
        if (dry == 3) { asm volatile("" :: "v"(sacc[0]), "v"(sacc[1]), "v"(sacc[2]), "v"(sacc[3]), "v"(sacc[4]), "v"(sacc[5]), "v"(sacc[6]), "v"(sacc[7])); LDS_BARRIER(); continue; }
        const int t = 16 * wave + fr;
        const float rof = vec[128 + t], rob = vec[640 + 128 + t];
        float rsf = 0.f, rsb = 0.f;
#pragma unroll
        for (int i = 0; i < 8; ++i) {
            if (i < wave) { const f32x4 cwf = *(const LAS f32x4*)(vec + 16 * i + 4 * fq);
#pragma unroll
                for (int r = 0; r < 4; ++r) rsf += sacc[i][r] * __expf(cwf[r] - rof); }
            else if (i > wave) { const f32x4 cwb = *(const LAS f32x4*)(vec + 640 + 16 * i + 4 * fq);
#pragma unroll
                for (int r = 0; r < 4; ++r) rsb += sacc[i][r] * __expf(cwb[r] - rob); }
            else { const f32x4 cwf = *(const LAS f32x4*)(vec + 16 * i + 4 * fq), cwb = *(const LAS f32x4*)(vec + 640 + 16 * i + 4 * fq);
#pragma unroll
                for (int r = 0; r < 4; ++r) { const int s = 16 * i + 4 * fq + r; const float sv = sacc[i][r];
                    float ef = __expf(fminf(cwf[r] - rof, 0.f)), eb = __expf(fminf(cwb[r] - rob, 0.f));
                    ef = (s <= t) ? ef : 0.f; eb = (s >= t) ? eb : 0.f;
                    rsf += sv * ef; rsb += sv * eb; } }
        }
        rsf += __shfl_xor(rsf, 16); rsf += __shfl_xor(rsf, 32); rsb += __shfl_xor(rsb, 16); rsb += __shfl_xor(rsb, 32);
        const float iwf = vec[256 + t], iwb = vec[640 + 256 + t];
        const float denf = rsf + iwf * vec[512 + t], denb = rsb + iwb * vec[640 + 512 + t];
        const float rinvf = 1.f / fmaxf(fabsf(denf), vec[384 + t]), rinvb = 1.f / fmaxf(fabsf(denb), vec[640 + 384 + t]);
        const float cf = iwf * rinvf, cb = iwb * rinvb;
        asm volatile("" ::: "memory");
        { const int fq2 = launder(fq), t2 = launder(t);
#pragma unroll
        for (int i = 0; i < 8; ++i) { float pv[4];
            if (i < wave) { const f32x4 cwf = *(const LAS f32x4*)(vec + 16 * i + 4 * fq2);
#pragma unroll
                for (int r = 0; r < 4; ++r) pv[r] = sacc[i][r] * (__expf(cwf[r] - rof) * rinvf); }
            else if (i > wave) { const f32x4 cwb = *(const LAS f32x4*)(vec + 640 + 16 * i + 4 * fq2);
#pragma unroll
                for (int r = 0; r < 4; ++r) pv[r] = sacc[i][r] * (__expf(cwb[r] - rob) * rinvb); }
            else { const f32x4 cwf = *(const LAS f32x4*)(vec + 16 * i + 4 * fq2), cwb = *(const LAS f32x4*)(vec + 640 + 16 * i + 4 * fq2);
#pragma unroll
                for (int r = 0; r < 4; ++r) { const int s = 16 * i + 4 * fq2 + r;
                    float ef = __expf(fminf(cwf[r] - rof, 0.f)), eb = __expf(fminf(cwb[r] - rob, 0.f));
                    ef = (s <= t2) ? ef : 0.f; eb = (s >= t2) ? eb : 0.f;
                    pv[r] = sacc[i][r] * (ef * rinvf + eb * rinvb); } }
            u32x2 o; o.x = pk2(pv[0], pv[1]); o.y = pk2(pv[2], pv[3]);
            *(LAS u32x2*)(Kt + t2 * P128R + (16 * i + 4 * fq2) * 2) = o; } }
        asm volatile("" ::: "memory");
        f32x4 hacc[16];
#pragma unroll
        for (int n = 0; n < 16; ++n) hacc[n] = (f32x4){0.f, 0.f, 0.f, 0.f};
#pragma unroll
        for (int nh = 0; nh < 2; ++nh) {
#pragma unroll
            for (int ks = 0; ks < 4; ++ks)
#pragma unroll
                for (int n = 8 * nh; n < 8 * nh + 8; ++n) { const bf16x8 cfr = *(const LAS bf16x8*)(Xt + (16 * n + fr) * P128R + (32 * ks + 8 * fq) * 2);
                    hacc[n] = __builtin_amdgcn_mfma_f32_16x16x32_bf16(cfr, qf[ks], hacc[n], 0, 0, 0); }
            asm volatile("" ::: "memory");
        }
#pragma unroll
        for (int n = 0; n < 16; ++n) hacc[n] = hacc[n] * cf;
        LDS_BARRIER();
        if (dry == 4) {
#pragma unroll
            for (int n = 0; n < 16; ++n) asm volatile("" :: "v"(hacc[n]));
            continue; }
        { const bf16_t* cp = ST + (size_t)((chain0 + 1) * 32 + c) * 32768;
#pragma unroll
          for (int i = 0; i < 8; ++i) { const int id = tid + 512 * i, r = id >> 4, ch = id & 15;
              *(LAS u32x4*)(Xt + r * P128R + ch * 16) = *(const u32x4*)(cp + (size_t)r * 128 + ch * 8); } }
        LDS_BARRIER();
#pragma unroll
        for (int nh = 0; nh < 2; ++nh) {
            f32x4 tacc[8];
#pragma unroll
            for (int n = 0; n < 8; ++n) tacc[n] = (f32x4){0.f, 0.f, 0.f, 0.f};
#pragma unroll
            for (int ks = 0; ks < 4; ++ks)
#pragma unroll
                for (int n = 0; n < 8; ++n) { const bf16x8 cfr = *(const LAS bf16x8*)(Xt + (16 * (8 * nh + n) + fr) * P128R + (32 * ks + 8 * fq) * 2);
                    tacc[n] = __builtin_amdgcn_mfma_f32_16x16x32_bf16(cfr, qf[ks], tacc[n], 0, 0, 0); }
#pragma unroll
            for (int n = 0; n < 8; ++n) hacc[8 * nh + n] = hacc[8 * nh + n] + tacc[n] * cb;
            asm volatile("" ::: "memory");
        }
        LDS_BARRIER();
        if (dry == 5) {
#pragma unroll
            for (int n = 0; n < 16; ++n) asm volatile("" :: "v"(hacc[n]));
            continue; }
#pragma unroll
        for (int i = 0; i < 8; ++i) { const int id = tid + 512 * i, r = id >> 5, ch = id & 31;
            *(LAS u32x4*)(Xt + r * P256 + ch * 16) = *(const u32x4*)(Vb + (size_t)(row0 + r) * 1024 + h * 256 + ch * 8); }
        LDS_BARRIER();
#pragma unroll
        for (int ks = 0; ks < 4; ++ks) {
            const bf16x8 pf = *(const LAS bf16x8*)(Kt + t * P128R + (32 * ks + 8 * fq) * 2);
#pragma unroll
            for (int n = 0; n < 16; ++n) { ldscp ad = Xt + (32 * ks + 8 * g4 + q4) * P256 + (16 * n + 4 * p4) * 2;
                const bf16x8 vf = cat8(vtr(ad), vtr(ad + 4 * P256));
                hacc[n] = __builtin_amdgcn_mfma_f32_16x16x32_bf16(vf, pf, hacc[n], 0, 0, 0); }
        }
        if (dry == 6) {
#pragma unroll
            for (int n = 0; n < 16; ++n) asm volatile("" :: "v"(hacc[n]));
            LDS_BARRIER(); continue; }
        float s1 = 0.f;
#pragma unroll
        for (int n = 0; n < 16; ++n) s1 += (hacc[n][0] + hacc[n][1]) + (hacc[n][2] + hacc[n][3]);
        s1 += __shfl_xor(s1, 16); s1 += __shfl_xor(s1, 32);
        const float mu = s1 * (1.f / 256.f); float s2 = 0.f;
#pragma unroll
        for (int n = 0; n < 16; ++n) { const f32x4 dd = hacc[n] - mu; s2 += (dd[0] * dd[0] + dd[1] * dd[1]) + (dd[2] * dd[2] + dd[3] * dd[3]); }
        s2 += __shfl_xor(s2, 16); s2 += __shfl_xor(s2, 32);
        const float rstd = 1.f / sqrtf(s2 * (1.f / 256.f) + LN_EPS);
        bf16_t* orow = OZ + (size_t)(row0 + t) * 2048 + h * 256;
        u32x2 ovv[16];
#pragma unroll
        for (int n = 0; n < 16; ++n) ovv[n] = *(const u32x2*)(orow + 16 * n + 4 * fq);
        bf16_t* owr = dry ? (bf16_t*)(a.ws + WS_XB) + (size_t)(row0 + t) * 1024 + h * 256 : orow;
        const LAS float* nw = nwl + h * 256;
#pragma unroll
        for (int n = 0; n < 16; ++n) { const int dv = 16 * n + 4 * fq; const u32x2 ov = ovv[n]; const f32x4 w4 = *(const LAS f32x4*)(nw + dv);
            const float y0 = (hacc[n][0] - mu) * rstd * w4[0] * sigmoidf_(bflo(ov.x)), y1 = (hacc[n][1] - mu) * rstd * w4[1] * sigmoidf_(bfhi(ov.x));
            const float y2 = (hacc[n][2] - mu) * rstd * w4[2] * sigmoidf_(bflo(ov.y)), y3 = (hacc[n][3] - mu) * rstd * w4[3] * sigmoidf_(bfhi(ov.y));
            u32x2 o; o.x = pk2(y0, y1); o.y = pk2(y2, y3); if (dry == 7) asm volatile("" :: "v"(o)); else *(u32x2*)(owr + dv) = o; }
        LDS_BARRIER();
    }
}

__device__ __forceinline__ void ssd_conv_tiles(ArgsRef a, int b, int c, int g, ldsp Xt, ldsp Bt, ldsp Ct, int want, int pitchBC) {
    const int tid = launder((int)threadIdx.x), ch64 = tid & 63, strip = tid >> 6;
    int col, pitch; ldsp dst; bool on;
    if (ch64 < 32) { col = 256 * g + 8 * ch64; dst = Xt + ch64 * 16; pitch = P256; on = want & 1; }
    else if (ch64 < 48) { col = 1024 + 128 * g + 8 * (ch64 - 32); dst = Bt + (ch64 - 32) * 16; pitch = pitchBC; on = want & 2; }
    else { col = 1536 + 128 * g + 8 * (ch64 - 48); dst = Ct + (ch64 - 48) * 16; pitch = pitchBC; on = want & 4; }
    if (!on) return;
    const bf16_t* X = (const bf16_t*)(a.ws + WS_XBC) + (size_t)b * SEQ * 2048 + col;
    const float* cw = a.in[I_CONVW] + col; const float* cbp = a.in[I_CONVB] + col;
    f32x2 w2[5][4], bias2[4];
#pragma unroll
    for (int j = 0; j < 5; ++j) { const f32x4 w0 = *(const f32x4*)(cw + j * 2048), w1 = *(const f32x4*)(cw + j * 2048 + 4);
        w2[j][0] = (f32x2){w0[0], w0[1]}; w2[j][1] = (f32x2){w0[2], w0[3]}; w2[j][2] = (f32x2){w1[0], w1[1]}; w2[j][3] = (f32x2){w1[2], w1[3]}; }
    { const f32x4 b0 = *(const f32x4*)cbp, b1 = *(const f32x4*)(cbp + 4); bias2[0] = (f32x2){b0[0], b0[1]}; bias2[1] = (f32x2){b0[2], b0[3]}; bias2[2] = (f32x2){b1[0], b1[1]}; bias2[3] = (f32x2){b1[2], b1[3]}; }
    const int t0 = c * CH + strip * 16;
    u32x4 rows[20];
#pragma unroll
    for (int j = 0; j < 20; ++j) { const int tt = t0 - 2 + j; const int tc = tt < 0 ? 0 : (tt >= SEQ ? SEQ - 1 : tt);
        const u32x4 v = *(const u32x4*)(X + (size_t)tc * 2048); rows[j] = (tt >= 0 && tt < SEQ) ? v : (u32x4){0u, 0u, 0u, 0u}; }
#pragma unroll
    for (int r = 0; r < 16; ++r) {
        f32x2 o2[4];
#pragma unroll
        for (int e = 0; e < 4; ++e) o2[e] = bias2[e];
#pragma unroll
        for (int j = 0; j < 5; ++j) { const u32x4 v = rows[r + j];
            o2[0] += w2[j][0] * (f32x2){bflo(v.x), bfhi(v.x)}; o2[1] += w2[j][1] * (f32x2){bflo(v.y), bfhi(v.y)};
            o2[2] += w2[j][2] * (f32x2){bflo(v.z), bfhi(v.z)}; o2[3] += w2[j][3] * (f32x2){bflo(v.w), bfhi(v.w)}; }
        u32x4 pk;
#pragma unroll
        for (int e = 0; e < 4; ++e) { const f32x2 ng = o2[e] * -1.4426950408889634f; f32x2 ex; ex.x = __builtin_amdgcn_exp2f(ng.x); ex.y = __builtin_amdgcn_exp2f(ng.y);
            const f32x2 dn = ex + 1.0f; f32x2 rc; rc.x = __builtin_amdgcn_rcpf(dn.x); rc.y = __builtin_amdgcn_rcpf(dn.y); const f32x2 sv = o2[e] * rc;
            pk[e] = pk2(sv.x, sv.y); }
        *(LAS u32x4*)(dst + (strip * 16 + r) * pitch) = pk;
    }
}

struct SsVec { float dt[2], ac[2]; float tot; };
__device__ __forceinline__ SsVec ss_chunk_vec(const float* gates, int row0, int d, int h16, float dtb, float A, int lane) {
    SsVec r; float da[2];
#pragma unroll
    for (int j = 0; j < 2; ++j) { const int u = 2 * lane + j, t = d ? 127 - u : u;
        r.dt[j] = softplusf_(gates[(size_t)(row0 + t) * 48 + 16 + d * 16 + h16] + dtb); da[j] = r.dt[j] * A; }
    const float loc1 = da[0] + da[1]; const float s = wave_scan_add(loc1, lane); const float ex = s - loc1;
    r.ac[0] = ex + da[0]; r.ac[1] = s; r.tot = __shfl(s, 63);
    return r;
}

__device__ __forceinline__ void phase_ssd_states(ArgsRef a, ldsp lds) {
    const int tid = launder((int)threadIdx.x), lane = tid & 63, wave = __builtin_amdgcn_readfirstlane(tid >> 6), G = gridDim.x;
    const float* gates = (const float*)(a.ws + WS_GATES); float* ms = (float*)(a.ws + WS_MSTAT);
    bf16_t* ST = (bf16_t*)a.out;
    ldsp Bt = lds, Xt = lds + 36864; LAS float* wv = (LAS float*)(lds + 106496);
    for (int item = blockIdx.x; item < BATCH * NC * 4; item += G) {
        const int g = item % 4, c = (item / 4) % NC, b = item / (4 * NC); const int row0 = b * SEQ + c * CH;
        ssd_conv_tiles(a, b, c, g, Xt, Bt, Bt, 3, P128);
        const int hh = wave >> 1, d = wave & 1, h16 = 4 * g + hh;
        { const SsVec v = ss_chunk_vec(gates, row0, d, h16, a.in[I_DTB][d * 16 + h16], -__expf(a.in[I_ALOG][d * 16 + h16]), lane);
#pragma unroll
          for (int j = 0; j < 2; ++j) { const int u = 2 * lane + j, t = d ? 127 - u : u; wv[wave * 128 + t] = v.dt[j] * __expf(v.tot - v.ac[j]); }
          if (lane == 0) ms[MS_SD + ((b * 16 + h16) * 2 + d) * 32 + c] = __expf(v.tot); }
        LDS_BARRIER();
        { bf16_t* out = ST + (size_t)(((b * 16 + h16) * 2 + d) * 32 + c) * 8192;
          chunk_state_gemm(Bt, P128, Xt + 64 * hh * 2, P256, wv + wave * 128, out, lane); }
        LDS_BARRIER();
    }
}

__device__ __forceinline__ void phase_ssd_out(ArgsRef a, ldsp lds, int dry = 0) {
    const int tid = launder((int)threadIdx.x), lane = tid & 63, wave = __builtin_amdgcn_readfirstlane(tid >> 6), G = gridDim.x;
    const int fr_ = lane & 15, fq_ = lane >> 4;
    const float* gates = (const float*)(a.ws + WS_GATES);
    bf16_t* OZ = (bf16_t*)(a.ws + WS_OZ); const bf16_t* ST = (const bf16_t*)a.out;
    ldsp Ct = lds, Bt = lds + 36864, Xt = lds + 73728;
    LAS float* vec = (LAS float*)(lds + 73728 + 69632);
    static_assert(73728 + 69632 + 8192 + 4096 <= MISC_OFF, "layout");
    LAS float* nwl = vec + 2048;
    for (int i = tid; i < 1024; i += 512) nwl[i] = a.in[I_SSMNW][i];
    for (int item = blockIdx.x; item < BATCH * NC * 4; item += G) {
        const int g = item % 4, c = (item / 4) % NC, b = item / (4 * NC); const int row0 = b * SEQ + c * CH;
        const int fr = launder(fr_), fq = launder(fq_), g4 = fq, q4 = fr >> 2, p4 = fr & 3;
        ssd_conv_tiles(a, b, c, g, Xt, Bt, Ct, 7, P128R);
        { const int hh = wave >> 1, d = wave & 1, h16 = 4 * g + hh;
          const SsVec v = ss_chunk_vec(gates, row0, d, h16, a.in[I_DTB][d * 16 + h16], -__expf(a.in[I_ALOG][d * 16 + h16]), lane);
#pragma unroll
          for (int j = 0; j < 2; ++j) { const int u = 2 * lane + j, t = d ? 127 - u : u; vec[wave * 256 + t] = v.ac[j]; vec[wave * 256 + 128 + t] = v.dt[j]; } }
        LDS_BARRIER();
        if (dry == 2) { LDS_BARRIER(); continue; }
        f32x4 cbv[8];
#pragma unroll
        for (int i = 0; i < 8; ++i) cbv[i] = (f32x4){0.f, 0.f, 0.f, 0.f};
        bf16x8 cf[4];
#pragma unroll
        for (int ks = 0; ks < 4; ++ks) cf[ks] = *(const LAS bf16x8*)(Ct + (16 * wave + fr) * P128R + (32 * ks + 8 * fq) * 2);
#pragma unroll
        for (int ks = 0; ks < 4; ++ks)
#pragma unroll
            for (int i = 0; i < 8; ++i) { const bf16x8 bfr = *(const LAS bf16x8*)(Bt + (16 * i + fr) * P128R + (32 * ks + 8 * fq) * 2);
                cbv[i] = __builtin_amdgcn_mfma_f32_16x16x32_bf16(bfr, cf[ks], cbv[i], 0, 0, 0); }
        LDS_BARRIER();
        if (dry == 3) { asm volatile("" :: "v"(cbv[0]), "v"(cbv[1]), "v"(cbv[2]), "v"(cbv[3]), "v"(cbv[4]), "v"(cbv[5]), "v"(cbv[6]), "v"(cbv[7])); continue; }
        const int t = 16 * wave + fr;
        ldsp Ht = Ct;
        u32x4 pre[4];
#pragma unroll
        for (int i = 0; i < 4; ++i) { const int id = tid + 512 * i, d = id >> 10, r = (id >> 4) & 63, ch = id & 15;
            pre[i] = *(const u32x4*)(ST + (size_t)(((b * 16 + 4 * g) * 2 + d) * 32 + c) * 8192 + r * 128 + ch * 8); }
        float s2 = 0.f;
        bf16_t* yrow = dry ? (bf16_t*)(a.ws + WS_XB) + (size_t)(row0 + t) * 1024 + 256 * g : OZ + (size_t)(row0 + t) * 2048 + 1024 + 256 * g;
#pragma unroll 1
        for (int hh = 0; hh < 4; ++hh) {
            const int h16 = 4 * g + hh;
#pragma unroll
            for (int i = 0; i < 4; ++i) { const int id = tid + 512 * i, d = id >> 10, r = (id >> 4) & 63, ch = id & 15;
                *(LAS u32x4*)(Ht + d * 18432 + r * P128R + ch * 16) = pre[i]; }
            LDS_BARRIER();
            if (hh < 3) {
#pragma unroll
                for (int i = 0; i < 4; ++i) { const int id = tid + 512 * i, d = id >> 10, r = (id >> 4) & 63, ch = id & 15;
                    pre[i] = *(const u32x4*)(ST + (size_t)(((b * 16 + h16 + 1) * 2 + d) * 32 + c) * 8192 + r * 128 + ch * 8); }
            }
            const bf16_t* zrow = OZ + (size_t)(row0 + t) * 2048 + 1024 + 256 * g + 64 * hh;
            u32x2 zpre[4];
#pragma unroll
            for (int n = 0; n < 4; ++n) zpre[n] = *(const u32x2*)(zrow + 16 * n + 4 * fq);
            f32x4 y[4];
            if (dry == 5) {
#pragma unroll
                for (int n = 0; n < 4; ++n) y[n] = (f32x4){0.f, 0.f, 0.f, 0.f};
            } else {
                f32x4 yf[4], yb[4];
#pragma unroll
                for (int n = 0; n < 4; ++n) { yf[n] = (f32x4){0.f, 0.f, 0.f, 0.f}; yb[n] = (f32x4){0.f, 0.f, 0.f, 0.f}; }
#pragma unroll
                for (int ks = 0; ks < 4; ++ks)
#pragma unroll
                    for (int n = 0; n < 4; ++n) {
                        const bf16x8 h0 = *(const LAS bf16x8*)(Ht + (16 * n + fr) * P128R + (32 * ks + 8 * fq) * 2);
                        const bf16x8 h1 = *(const LAS bf16x8*)(Ht + 18432 + (16 * n + fr) * P128R + (32 * ks + 8 * fq) * 2);
                        yf[n] = __builtin_amdgcn_mfma_f32_16x16x32_bf16(h0, cf[ks], yf[n], 0, 0, 0);
                        yb[n] = __builtin_amdgcn_mfma_f32_16x16x32_bf16(h1, cf[ks], yb[n], 0, 0, 0); }
                const float ef = __expf(vec[(hh * 2 + 0) * 256 + t]), eb = __expf(vec[(hh * 2 + 1) * 256 + t]);
#pragma unroll
                for (int n = 0; n < 4; ++n) y[n] = yf[n] * ef + yb[n] * eb;
            }
            if (dry != 4) {
            { const int fq2 = launder(fq), t2 = launder(t);
              const float af = vec[(hh * 2 + 0) * 256 + t2], ab = vec[(hh * 2 + 1) * 256 + t2];
#pragma unroll
              for (int i = 0; i < 8; ++i) { float pv[4]; const LAS float* vb = vec + hh * 512 + 16 * i + 4 * fq2;
                  if (i < wave) { const f32x4 acf = *(const LAS f32x4*)(vb), dtf = *(const LAS f32x4*)(vb + 128);
#pragma unroll
                      for (int r = 0; r < 4; ++r) pv[r] = cbv[i][r] * (__expf(af - acf[r]) * dtf[r]); }
                  else if (i > wave) { const f32x4 acb = *(const LAS f32x4*)(vb + 256), dtb = *(const LAS f32x4*)(vb + 384);
#pragma unroll
                      for (int r = 0; r < 4; ++r) pv[r] = cbv[i][r] * (__expf(ab - acb[r]) * dtb[r]); }
                  else { const f32x4 acf = *(const LAS f32x4*)(vb), dtf = *(const LAS f32x4*)(vb + 128), acb = *(const LAS f32x4*)(vb + 256), dtb = *(const LAS f32x4*)(vb + 384);
#pragma unroll
                      for (int r = 0; r < 4; ++r) { const int s = 16 * i + 4 * fq2 + r;
                          float lf = __expf(fminf(af - acf[r], 0.f)) * dtf[r], lb = __expf(fminf(ab - acb[r], 0.f)) * dtb[r];
                          lf = (s <= t2) ? lf : 0.f; lb = (s >= t2) ? lb : 0.f;
                          pv[r] = cbv[i][r] * (lf + lb); } }
                  u32x2 o; o.x = pk2(pv[0], pv[1]); o.y = pk2(pv[2], pv[3]);
                  *(LAS u32x2*)(Bt + t2 * P128R + (16 * i + 4 * fq2) * 2) = o; } }
            asm volatile("s_waitcnt lgkmcnt(0)" ::: "memory");
#pragma unroll
            for (int ks = 0; ks < 4; ++ks) {
                const bf16x8 pf = *(const LAS bf16x8*)(Bt + t * P128R + (32 * ks + 8 * fq) * 2);
#pragma unroll
                for (int n = 0; n < 4; ++n) { ldscp ad = Xt + (32 * ks + 8 * g4 + q4) * P256 + (64 * hh + 16 * n + 4 * p4) * 2;
                    const bf16x8 xf = cat8(vtr(ad), vtr(ad + 4 * P256));
                    y[n] = __builtin_amdgcn_mfma_f32_16x16x32_bf16(xf, pf, y[n], 0, 0, 0); }
            }
            }
            { const float dsk = a.in[I_DSKIP][h16];
#pragma unroll
              for (int n = 0; n < 4; ++n) { const int p = 16 * n + 4 * fq;
                  const u32x2 xv = *(const LAS u32x2*)(Xt + t * P256 + (64 * hh + p) * 2); const u32x2 zv = zpre[n];
                  f32x4 o;
                  o[0] = (y[n][0] + dsk * bflo(xv.x)) * siluf_(bflo(zv.x)); o[1] = (y[n][1] + dsk * bfhi(xv.x)) * siluf_(bfhi(zv.x));
                  o[2] = (y[n][2] + dsk * bflo(xv.y)) * siluf_(bflo(zv.y)); o[3] = (y[n][3] + dsk * bfhi(xv.y)) * siluf_(bfhi(zv.y));
                  s2 += (o[0] * o[0] + o[1] * o[1]) + (o[2] * o[2] + o[3] * o[3]);
                  u32x2 ow; ow.x = pk2(o[0], o[1]); ow.y = pk2(o[2], o[3]); *(u32x2*)(yrow + 64 * hh + p) = ow; } }
            LDS_BARRIER();
        }
        s2 += __shfl_xor(s2, 16); s2 += __shfl_xor(s2, 32);
        const float rs = 1.f / sqrtf(s2 * (1.f / 256.f) + RMS_EPS);
        const LAS float* nw = nwl + 256 * g;
        u32x2 yvv[16];
#pragma unroll
        for (int hn = 0; hn < 16; ++hn) yvv[hn] = *(const u32x2*)(yrow + 16 * hn + 4 * fq);
#pragma unroll
        for (int hn = 0; hn < 16; ++hn) { const int ch = 16 * hn + 4 * fq; const f32x4 w4 = *(const LAS f32x4*)(nw + ch); const u32x2 yv = yvv[hn];
            u32x2 o; o.x = pk2(bflo(yv.x) * rs * w4[0], bfhi(yv.x) * rs * w4[1]); o.y = pk2(bflo(yv.y) * rs * w4[2], bfhi(yv.y) * rs * w4[3]); *(u32x2*)(yrow + ch) = o; }
        LDS_BARRIER();
    }
}

__device__ __forceinline__ void phase_ln1_router(ArgsRef a, ldsp lds) {
    const int tid = launder((int)threadIdx.x), lane = tid & 63, wave = __builtin_amdgcn_readfirstlane(tid >> 6), G = gridDim.x;
    const int gw = blockIdx.x * 8 + wave, NGW = G * 8;
    {
        LAS float* scr = (LAS float*)(lds + 81920 + wave * 8448);
        bf16_t* W1T = (bf16_t*)(a.ws + WS_W1T); bf16_t* W2T = (bf16_t*)(a.ws + WS_W2T);
        for (int it = gw; it < 65 * 384; it += NGW) {
            const int e = it / 384, r = it % 384;
            const float* wg = e < 64 ? a.in[I_WEG] + (size_t)e * DM * DE : a.in[I_WSG];
            const float* wu = e < 64 ? a.in[I_WEU] + (size_t)e * DM * DE : a.in[I_WSU];
            const float* wd = e < 64 ? a.in[I_WED] + (size_t)e * DE * DM : a.in[I_WSD];
            if (r < 256) { const int up = r >> 7, q = r & 127, cb = q & 7, kb = q >> 3;
                transpose_item(up ? wu : wg, DE, kb * 64, cb * 32, W1T + (size_t)e * 512 * DM, DM, 256 * (cb >> 2) + 32 * (cb & 3) + 128 * up, 1.f, scr, lane); }
            else { const int q = r - 256, cb = q & 31, kb = q >> 5;
                transpose_item(wd, DM, kb * 64, cb * 32, W2T + (size_t)e * DM * DE, DE, cb * 32, 1.f, scr, lane); }
        }
    }
    LDS_BARRIER();
    const float* r1 = a.out; bf16_t* H = (bf16_t*)(a.ws + WS_H);
    int* sele = (int*)(a.ws + WS_SELE); float* selw = (float*)(a.ws + WS_SELW);
    unsigned* ctl = (unsigned*)(a.ws + WS_CTL);
    constexpr int WPT = 160;
    ldsp Whi = lds, Wlo = lds + 40960;
    LAS float* lg = (LAS float*)(lds + 81920);
    LAS unsigned* cnt = (LAS unsigned*)(lds + 81920 + 33280);
    const float* g1 = a.in[I_LN1G]; const float* b1 = a.in[I_LN1B]; const float* wr = a.in[I_WR];
    const int fr = lane & 15, fq = lane >> 4, q4 = fr >> 2, p4 = fr & 3;
    for (int vb = blockIdx.x; vb < 256; vb += G) {
        const int tok0 = vb * 128;
        if (tid < 64) cnt[tid] = 0u;
        f32x4 ggv[4], bbv[4];
#pragma unroll
        for (int j = 0; j < 4; ++j) { ggv[j] = *((const f32x4*)g1 + lane + 64 * j); bbv[j] = *((const f32x4*)b1 + lane + 64 * j); }
        for (int rr = 0; rr < 16; rr += 4) {
            f32x4 v[4][4];
#pragma unroll
            for (int q = 0; q < 4; ++q) { const f32x4* xr = (const f32x4*)(r1 + (size_t)(tok0 + 16 * wave + rr + q) * DM) + lane;
#pragma unroll
                for (int j = 0; j < 4; ++j) v[q][j] = xr[64 * j]; }
#pragma unroll
            for (int q = 0; q < 4; ++q) {
                const int t = tok0 + 16 * wave + rr + q; float s = 0.f;
#pragma unroll
                for (int j = 0; j < 4; ++j) s += (v[q][j].x + v[q][j].y) + (v[q][j].z + v[q][j].w);
                const float mean = wave_sum(s) * (1.f / DM); float s2 = 0.f;
#pragma unroll
                for (int j = 0; j < 4; ++j) { v[q][j] = v[q][j] - mean; s2 += (v[q][j].x * v[q][j].x + v[q][j].y * v[q][j].y) + (v[q][j].z * v[q][j].z + v[q][j].w * v[q][j].w); }
                const float rstd = __builtin_amdgcn_rsqf(wave_sum(s2) * (1.f / DM) + LN_EPS);
                unsigned long long* o8 = (unsigned long long*)(H + (size_t)t * DM) + lane;
#pragma unroll
                for (int j = 0; j < 4; ++j) { const f32x4 hv = v[q][j] * rstd * ggv[j] + bbv[j];
                    o8[64 * j] = (unsigned long long)pk2(hv.x, hv.y) | ((unsigned long long)pk2(hv.z, hv.w) << 32); }
            }
        }
        asm volatile("s_waitcnt vmcnt(0)" ::: "memory");
        f32x4 lacc[4];
#pragma unroll
        for (int nt = 0; nt < 4; ++nt) lacc[nt] = (f32x4){0.f, 0.f, 0.f, 0.f};
        f32x4 pw[8];
#pragma unroll
        for (int i = 0; i < 8; ++i) pw[i] = *(const f32x4*)(wr + (size_t)(tid + 512 * i) * 4);
        const bf16_t* hrow = H + (size_t)(tok0 + 16 * wave + fr) * DM + 8 * fq;
#pragma unroll 1
        for (int kc = 0; kc < 4; ++kc) {
#pragma unroll
            for (int i = 0; i < 8; ++i) { const int id = tid + 512 * i, k = id >> 4, e4 = (id & 15) * 4; const f32x4 w = pw[i];
                u32x2 hi; hi.x = pk2(w[0], w[1]); hi.y = pk2(w[2], w[3]);
                u32x2 lo; lo.x = pk2(w[0] - bflo(hi.x), w[1] - bfhi(hi.x)); lo.y = pk2(w[2] - bflo(hi.y), w[3] - bfhi(hi.y));
                *(LAS u32x2*)(Whi + k * WPT + e4 * 2) = hi; *(LAS u32x2*)(Wlo + k * WPT + e4 * 2) = lo; }
            if (kc < 3) {
#pragma unroll
                for (int i = 0; i < 8; ++i) pw[i] = *(const f32x4*)(wr + (size_t)(kc + 1) * 256 * NE + (size_t)(tid + 512 * i) * 4);
            }
            bf16x8 af[8];
#pragma unroll
            for (int ks = 0; ks < 8; ++ks) af[ks] = *(const bf16x8*)(hrow + 256 * kc + 32 * ks);
            LDS_BARRIER();
#pragma unroll
            for (int ks = 0; ks < 8; ++ks)
#pragma unroll
                for (int nt = 0; nt < 4; ++nt) { const int off = (32 * ks + 8 * fq + q4) * WPT + (16 * nt + 4 * p4) * 2;
                    const bf16x8 wh = cat8(vtr(Whi + off), vtr(Whi + off + 4 * WPT)), wl = cat8(vtr(Wlo + off), vtr(Wlo + off + 4 * WPT));
                    lacc[nt] = __builtin_amdgcn_mfma_f32_16x16x32_bf16(af[ks], wh, lacc[nt], 0, 0, 0);
                    lacc[nt] = __builtin_amdgcn_mfma_f32_16x16x32_bf16(af[ks], wl, lacc[nt], 0, 0, 0); }
            LDS_BARRIER();
        }
#pragma unroll
        for (int nt = 0; nt < 4; ++nt)
#pragma unroll
            for (int r = 0; r < 4; ++r) lg[(16 * wave + 4 * fq + r) * 65 + 16 * nt + fr] = lacc[nt][r];
        asm volatile("s_waitcnt lgkmcnt(0)" ::: "memory");
        const float rb = a.in[I_RB][lane]; unsigned mycnt = 0u;
        for (int rr = 0; rr < 16; ++rr) {
            const int row = 16 * wave + rr; const int t = tok0 + row;
            const float score = sigmoidf_(lg[row * 65 + lane]); const float choice = score + rb;
            float m1 = choice; m1 = fmaxf(m1, __shfl_xor(m1, 1)); m1 = fmaxf(m1, __shfl_xor(m1, 2)); m1 = fmaxf(m1, __shfl_xor(m1, 4));
            const unsigned long long eq = __ballot(choice == m1); const int gbase = lane & ~7;
            const unsigned gm = (unsigned)(eq >> gbase) & 0xffu; const int first = gbase + __builtin_ctz(gm);
            float m2 = (lane == first) ? -INFINITY : choice; m2 = fmaxf(m2, __shfl_xor(m2, 1)); m2 = fmaxf(m2, __shfl_xor(m2, 2)); m2 = fmaxf(m2, __shfl_xor(m2, 4));
            const float gs = m1 + m2; const int grp = lane >> 3;
            int grank = 0;
#pragma unroll
            for (int g2 = 0; g2 < 8; ++g2) { const float og = __shfl(gs, 8 * g2); grank += (og > gs || (og == gs && g2 < grp)) ? 1 : 0; }
            float curv = (grank < 4) ? choice : -INFINITY; int rank = -1;
#pragma unroll
            for (int r = 0; r < TOPK; ++r) { const float mx = wave_max(curv); const unsigned long long bal = __ballot(curv == mx);
                const int win = __builtin_ctzll(bal); if (lane == win) { rank = r; curv = -INFINITY; } }
            const bool sel = rank >= 0;
            const float wsum = wave_sum(sel ? score : 0.f);
            if (sel) { sele[t * 8 + rank] = lane; selw[t * 8 + rank] = score / wsum * 2.5f; mycnt++; }
        }
        if (mycnt) atomicAdd((unsigned*)&cnt[lane], mycnt);
        LDS_BARRIER();
        if (tid < 64) ctl[CW_BLOCKCNT + vb * 64 + tid] = cnt[tid];
        LDS_BARRIER();
    }
}

__device__ __forceinline__ void phase_lists(ArgsRef a, ldsp lds) {
    const int tid = launder((int)threadIdx.x), lane = tid & 63, wave = __builtin_amdgcn_readfirstlane(tid >> 6), G = gridDim.x;
    const unsigned* ctl = (const unsigned*)(a.ws + WS_CTL); unsigned* ctlw = (unsigned*)(a.ws + WS_CTL);
    const int* sele = (const int*)(a.ws + WS_SELE); const float* selw = (const float*)(a.ws + WS_SELW);
    int* tokpos = (int*)(a.ws + WS_TOKPOS);
    LAS unsigned* part = (LAS unsigned*)lds;
    LAS unsigned* pre = part + 1024;
    LAS unsigned* cntp = pre + 64;
    LAS unsigned* pstart = cntp + 64;
    LAS unsigned* cstart = pstart + 64;
    LAS unsigned* lcnt = cstart + 64;
    for (int vb = blockIdx.x; vb < 256; vb += G) {
        const int p = vb < PASS_VB0[1] ? 0 : (vb < PASS_VB0[2] ? 1 : 2); const int vb0 = PASS_VB0[p], vb1 = PASS_VB0[p + 1];
        int* rowtok = (int*)(a.ws + WS_ROWTOK) + p * PASS_MAXROWS; float* rowgate = (float*)(a.ws + WS_ROWGATE) + p * PASS_MAXROWS;
        int* rowy = (int*)(a.ws + WS_ROWY) + p * PASS_MAXROWS; int* tilee = (int*)(a.ws + WS_TILEE) + p * PASS_MAXTILES;
        { const int e = tid & 63, pt = tid >> 6; unsigned tot = 0u, bel = 0u;
          for (int v2 = vb0 + pt; v2 < vb1; v2 += 8) { const unsigned cv = ctl[CW_BLOCKCNT + v2 * 64 + e]; tot += cv; if (v2 < vb) bel += cv; }
          part[(pt * 64 + e) * 2] = tot; part[(pt * 64 + e) * 2 + 1] = bel; }
        BLOCK_SYNC();
        if (tid < 64) { unsigned tot = 0u, bel = 0u;
#pragma unroll
            for (int pt = 0; pt < 8; ++pt) { tot += part[(pt * 64 + tid) * 2]; bel += part[(pt * 64 + tid) * 2 + 1]; }
            const unsigned pad = (tot + 255u) & ~255u;
            unsigned ps = pad, cs = tot;
#pragma unroll
            for (int o = 1; o < 64; o <<= 1) { const unsigned t1 = __shfl_up(ps, o), t2 = __shfl_up(cs, o); if (lane >= o) { ps += t1; cs += t2; } }
            pre[tid] = bel; cntp[tid] = tot; pstart[tid] = ps - pad; cstart[tid] = cs - tot; lcnt[tid] = 0u;
            if (tid == 63) lcnt[64] = ps;
            if (vb == vb0 && tid == 63) ctlw[CW_NTILES + p] = (ps >> 8) + (p == 0 ? T / 256 : 0); }
        BLOCK_SYNC();
#pragma unroll
        for (int i = 0; i < 2; ++i) { const int sidx = tid + 512 * i, tl = sidx >> 3, k = sidx & 7; const int t = vb * 128 + tl;
            const int e = sele[t * 8 + k]; const float w = selw[t * 8 + k];
            const unsigned rank = pre[e] + atomicAdd((unsigned*)&lcnt[e], 1u);
            const unsigned prow = pstart[e] + rank, yrow = cstart[e] + rank + 1u;
            rowtok[prow] = t; rowgate[prow] = w; rowy[prow] = (int)yrow; tokpos[t * 8 + k] = (int)yrow; }
        if (vb == vb0) {
            for (int e = wave; e < 64; e += 8) { const unsigned c0 = cntp[e], ps = pstart[e], pad = (c0 + 255u) & ~255u;
                for (unsigned r = c0 + lane; r < pad; r += 64) { rowtok[ps + r] = vb0 * 128; rowgate[ps + r] = 0.f; rowy[ps + r] = 0; }
                for (unsigned tl = lane; tl < (pad >> 8); tl += 64) tilee[(ps >> 8) + tl] = e; }
            if (p == 0) { const unsigned ps = lcnt[64];
                for (int r = tid; r < T; r += 512) { rowtok[ps + r] = r; rowgate[ps + r] = 1.f; rowy[ps + r] = YS_ROW0 + r; }
                for (int tl = tid; tl < T / 256; tl += 512) tilee[(ps >> 8) + tl] = 64; }
        }
        BLOCK_SYNC();
    }
}

__device__ __forceinline__ void moe_gemm1(ArgsRef a, ldsp lds, int p) {
    const unsigned* ctl = (const unsigned*)(a.ws + WS_CTL);
    const int ntile = (int)ctl[CW_NTILES + p];
    pg8::Gemm g{(const bf16_t*)(a.ws + WS_H), (const bf16_t*)(a.ws + WS_W1T), 0, 512, DM, (size_t)512 * DM * 2, (const int*)(a.ws + WS_ROWTOK) + p * PASS_MAXROWS};
    pg8::MoeOrder<2, true> S{ntile, (int)gridDim.x, (int)blockIdx.x, 0, (const int*)(a.ws + WS_TILEE) + p * PASS_MAXTILES};
    pg8::EpiSwiGLU E{(bf16_t*)(a.ws + WS_ACT)};
    pg8::gemm_phase<pg8::EpiSwiGLU, pg8::MoeOrder<2, true>, true>(lds, g, S, E);
}
__device__ __forceinline__ void moe_gemm2(ArgsRef a, ldsp lds, int p) {
    const unsigned* ctl = (const unsigned*)(a.ws + WS_CTL);
    const int ntile = (int)ctl[CW_NTILES + p];
    pg8::Gemm g{(const bf16_t*)(a.ws + WS_ACT), (const bf16_t*)(a.ws + WS_W2T), 0, DM, DE, (size_t)DM * DE * 2, nullptr};
    pg8::MoeOrder<4, true> S{ntile, (int)gridDim.x, (int)blockIdx.x, 0, (const int*)(a.ws + WS_TILEE) + p * PASS_MAXTILES};
    pg8::EpiDownY E{(bf16_t*)(a.ws + WS_Y), (const int*)(a.ws + WS_ROWY) + p * PASS_MAXROWS, (const float*)(a.ws + WS_ROWGATE) + p * PASS_MAXROWS};
    pg8::gemm_phase<pg8::EpiDownY, pg8::MoeOrder<4, true>, false>(lds, g, S, E);
}
__device__ __forceinline__ void moe_combine(ArgsRef a, int p) {
    const int tid = launder((int)threadIdx.x), lane = tid & 63, wave = tid >> 6, G = gridDim.x;
    const bf16_t* H = (const bf16_t*)(a.ws + WS_H); const bf16_t* Y = (const bf16_t*)(a.ws + WS_Y); const int* tokpos = (const int*)(a.ws + WS_TOKPOS);
    const float* g2 = a.in[I_LN2G]; const float* b2 = a.in[I_LN2B];
    const int t0 = PASS_VB0[p] * 128, t1 = PASS_VB0[p + 1] * 128;
    f32x4 gav[2], gbv[2], bav[2], bbv[2];
#pragma unroll
    for (int j = 0; j < 2; ++j) { const int c = 8 * lane + 512 * j; gav[j] = *(const f32x4*)(g2 + c); gbv[j] = *(const f32x4*)(g2 + c + 4); bav[j] = *(const f32x4*)(b2 + c); bbv[j] = *(const f32x4*)(b2 + c + 4); }
    for (int tb = t0 + (blockIdx.x * 8 + wave) * 2; tb < t1; tb += G * 16) {
        int yr[2][8]; u32x4 hv[2][2], sv[2][2];
#pragma unroll
        for (int u = 0; u < 2; ++u) { const int t = tb + u;
#pragma unroll
            for (int k = 0; k < 8; ++k) yr[u][k] = tokpos[t * 8 + k];
#pragma unroll
            for (int j = 0; j < 2; ++j) { const int c = 8 * lane + 512 * j; hv[u][j] = *(const u32x4*)(H + (size_t)t * DM + c); sv[u][j] = *(const u32x4*)(Y + (size_t)(YS_ROW0 + t) * DM + c); } }
        u32x4 yv[2][8][2];
#pragma unroll
        for (int u = 0; u < 2; ++u)
#pragma unroll
            for (int k = 0; k < 8; ++k)
#pragma unroll
                for (int j = 0; j < 2; ++j) yv[u][k][j] = *(const u32x4*)(Y + (size_t)yr[u][k] * DM + 8 * lane + 512 * j);
#pragma unroll
        for (int u = 0; u < 2; ++u) { const int t = tb + u;
            float v[2][8];
#pragma unroll
            for (int j = 0; j < 2; ++j) { const u32x4 h4 = hv[u][j], s4 = sv[u][j];
                v[j][0] = bflo(s4.x) + ALPHA * bflo(h4.x); v[j][1] = bfhi(s4.x) + ALPHA * bfhi(h4.x); v[j][2] = bflo(s4.y) + ALPHA * bflo(h4.y); v[j][3] = bfhi(s4.y) + ALPHA * bfhi(h4.y);
                v[j][4] = bflo(s4.z) + ALPHA * bflo(h4.z); v[j][5] = bfhi(s4.z) + ALPHA * bfhi(h4.z); v[j][6] = bflo(s4.w) + ALPHA * bflo(h4.w); v[j][7] = bfhi(s4.w) + ALPHA * bfhi(h4.w); }
#pragma unroll
            for (int k = 0; k < 8; ++k)
#pragma unroll
                for (int j = 0; j < 2; ++j) { const u32x4 y4 = yv[u][k][j];
                    v[j][0] += bflo(y4.x); v[j][1] += bfhi(y4.x); v[j][2] += bflo(y4.y); v[j][3] += bfhi(y4.y);
                    v[j][4] += bflo(y4.z); v[j][5] += bfhi(y4.z); v[j][6] += bflo(y4.w); v[j][7] += bfhi(y4.w); }
            float s = 0.f;
#pragma unroll
            for (int j = 0; j < 2; ++j)
#pragma unroll
                for (int e = 0; e < 8; ++e) s += v[j][e];
            const float mean = wave_sum(s) * (1.f / DM); float s2 = 0.f;
#pragma unroll
            for (int j = 0; j < 2; ++j)
#pragma unroll
                for (int e = 0; e < 8; ++e) { v[j][e] -= mean; s2 += v[j][e] * v[j][e]; }
            const float rstd = __builtin_amdgcn_rsqf(wave_sum(s2) * (1.f / DM) + LN_EPS);
#pragma unroll
            for (int j = 0; j < 2; ++j) { const int c = 8 * lane + 512 * j;
                const f32x4 ga = gav[j], gb = gbv[j], ba = bav[j], bb = bbv[j];
                f32x4 o0, o1;
                o0[0] = v[j][0] * rstd * ga[0] + ba[0]; o0[1] = v[j][1] * rstd * ga[1] + ba[1]; o0[2] = v[j][2] * rstd * ga[2] + ba[2]; o0[3] = v[j][3] * rstd * ga[3] + ba[3];
                o1[0] = v[j][4] * rstd * gb[0] + bb[0]; o1[1] = v[j][5] * rstd * gb[1] + bb[1]; o1[2] = v[j][6] * rstd * gb[2] + bb[2]; o1[3] = v[j][7] * rstd * gb[3] + bb[3];
                *(f32x4*)(a.out + (size_t)t * DM + c) = o0; *(f32x4*)(a.out + (size_t)t * DM + c + 4) = o1; }
        }
    }
}

#define XB_TMO      128
#define XB_XCNT(j)  (256  + 64 * (j))
#define XB_XSUB(j)  (1280 + 64 * (j))
#define XB_XGEN(j)  (2304 + 64 * (j))
#define XB_TOP      3328
#define XB_TOPGEN   3392
#define XCD_BAR_WORDS 3456
#define XB_SPIN_CAP (1u << 18)
__device__ __forceinline__ unsigned xb_ld(unsigned* p)              { return __hip_atomic_load(p, __ATOMIC_RELAXED, __HIP_MEMORY_SCOPE_AGENT); }
__device__ __forceinline__ unsigned xb_add(unsigned* p, unsigned v) { return __hip_atomic_fetch_add(p, v, __ATOMIC_RELAXED, __HIP_MEMORY_SCOPE_AGENT); }
__device__ __forceinline__ unsigned xb_xcc_id() { return (unsigned)__builtin_amdgcn_s_getreg((3 << 11) | 20) & 0xFu; }
#define XB_SPIN(cond, bar) do { unsigned _sp = 0; while (cond) { __builtin_amdgcn_s_sleep(1); \
    if ((++_sp & 255u) == 0u) { if (xb_ld(&(bar)[XB_TMO])) break; if (_sp > XB_SPIN_CAP) { atomicAdd(&(bar)[XB_TMO], 1u); break; } } } } while (0)
struct XcdBarrier { unsigned* bar; unsigned x; volatile LAS unsigned* st; };
__device__ __forceinline__ XcdBarrier xcd_barrier_post(unsigned* bar, volatile LAS unsigned* st) {
    XcdBarrier b; b.bar = bar; b.x = xb_xcc_id(); b.st = st;
    if (threadIdx.x == 0) (void)xb_add(&bar[XB_XCNT(b.x)], 1u);
    return b;
}
__device__ __forceinline__ void xcd_barrier_complete(unsigned* bar, unsigned x, unsigned& nloc, unsigned& nx) {
    const unsigned G = gridDim.x * gridDim.y * gridDim.z;
    unsigned sum, cnt, mine, sp = 0u;
    for (;;) {
        sum = 0u; cnt = 0u; mine = 0u;
#pragma unroll
        for (unsigned j = 0; j < 16; ++j) { const unsigned c = xb_ld(&bar[XB_XCNT(j)]); sum += c; cnt += (c > 0u) ? 1u : 0u; mine = (j == x) ? c : mine; }
        if (sum == G) break;
        __builtin_amdgcn_s_sleep(1);
        if ((++sp & 255u) == 0u) { if (xb_ld(&bar[XB_TMO])) break; if (sp > XB_SPIN_CAP) { atomicAdd(&bar[XB_TMO], 1u); break; } }
    }
    nloc = mine > 0u ? mine : 1u; nx = cnt > 0u ? cnt : 1u;
}
__device__ __forceinline__ void xcd_barrier(const XcdBarrier& b) {
    asm volatile("s_waitcnt vmcnt(0)" ::: "memory");
    __syncthreads();
    if (threadIdx.x == 0) {
        unsigned* bar = b.bar;
        __builtin_amdgcn_s_waitcnt(0);
        unsigned nloc = b.st[0], nx = b.st[1];
        if (nloc == 0u) { xcd_barrier_complete(bar, b.x, nloc, nx); b.st[0] = nloc; b.st[1] = nx; }
        const unsigned old = xb_add(&bar[XB_XSUB(b.x)], 1u);
        const unsigned gen = old / nloc;
        if (old + 1u == (gen + 1u) * nloc) {
            __builtin_amdgcn_fence(__ATOMIC_RELEASE, "agent");
            asm volatile("s_waitcnt vmcnt(0)" ::: "memory");
            const unsigned og = xb_add(&bar[XB_TOP], 1u);
            const unsigned tg = og / nx;
            if (og + 1u == (tg + 1u) * nx) xb_add(&bar[XB_TOPGEN], 1u);
            else XB_SPIN(xb_ld(&bar[XB_TOPGEN]) == tg, bar);
            __builtin_amdgcn_fence(__ATOMIC_ACQUIRE, "agent");
            xb_add(&bar[XB_XGEN(b.x)], 1u);
            asm volatile("s_waitcnt vmcnt(0)" ::: "memory");
        } else {
            XB_SPIN(xb_ld(&bar[XB_XGEN(b.x)]) == gen, bar);
            __builtin_amdgcn_fence(__ATOMIC_ACQUIRE, "agent");
            asm volatile("s_waitcnt vmcnt(0)" ::: "memory");
        }
    }
    __syncthreads();
}

constexpr int N_PHASES = 18;
#ifndef REP_MASK
#define REP_MASK 0
#endif
#define REP(k) (((REP_MASK) >> (k)) & 1)
#ifndef DRYLVL
#define DRYLVL 1
#endif
__device__ __forceinline__ const __attribute__((address_space(4))) Args* kargs() {
    const __attribute__((address_space(4))) Args* p = (const __attribute__((address_space(4))) Args*)__builtin_amdgcn_kernarg_segment_ptr();
    asm volatile("" : "+s"(p)); return p;
}
__global__ void __launch_bounds__(512, 2) fwd_megakernel(Args a_unused) {
    extern __shared__ __attribute__((aligned(16))) unsigned char lds_raw[];
    ldsp lds = (ldsp)lds_raw;
    cg::grid_group grid = cg::this_grid();
#define lo (kargs()->ph_lo)
#define hi (kargs()->ph_hi)
    if (threadIdx.x < 16) ((LAS unsigned*)(lds + MISC_OFF))[threadIdx.x] = 0u;
    __syncthreads();
    (void)xcd_barrier_post((unsigned*)(kargs()->ws + WS_CTL) + CW_BAR, (volatile LAS unsigned*)(lds + MISC_OFF));
#define a (*kargs())
#ifdef PHASE_ONLY
#define IN(k) ((k) == PHASE_ONLY && lo <= (k) && (k) < hi)
#elif defined(PHASE_MASK)
#define IN(k) ((((PHASE_MASK) >> (k)) & 1) && lo <= (k) && (k) < hi)
#else
#define IN(k) (lo <= (k) && (k) < hi)
#endif
#define SEAM(k) do { if (IN(k) && IN((k) + 1)) { XcdBarrier bar_; bar_.bar = (unsigned*)(kargs()->ws + WS_CTL) + CW_BAR; bar_.x = xb_xcc_id(); bar_.st = (volatile LAS unsigned*)(lds + MISC_OFF); xcd_barrier(bar_); } } while (0)
    if (lo < -12345) grid.sync();
    if (IN(0)) { if (REP(0)) phase_p0(a, lds); phase_p0(a, lds); }
    SEAM(0);
    if (IN(1)) for (int rep_ = 0; rep_ < 1 + REP(1); ++rep_) {
        pg8::Gemm g{(const bf16_t*)(a.ws + WS_XB), (const bf16_t*)(a.ws + WS_WIN), T, NINP, DM, 0, nullptr};
        pg8::StaticOrder S; S.init(T, NINP, (int)gridDim.x, (int)blockIdx.x);
        pg8::EpiInProj E{(bf16_t*)(a.ws + WS_Q), (bf16_t*)(a.ws + WS_K), (bf16_t*)(a.ws + WS_V), (bf16_t*)(a.ws + WS_OZ), (bf16_t*)(a.ws + WS_XBC), (float*)(a.ws + WS_GATES)};
        pg8::gemm_phase<pg8::EpiInProj, pg8::StaticOrder, false>(lds, g, S, E);
    }
    SEAM(1);
    if (IN(2)) { if (REP(2)) phase_ml_states(a, lds); phase_ml_states(a, lds); }
    SEAM(2);
    if (IN(3)) { if (REP(3)) phase_scan<true>(a, true); phase_scan<true>(a); }
    SEAM(3);
    if (IN(4)) { if (REP(4)) phase_ml_out(a, lds, DRYLVL); phase_ml_out(a, lds); }
    SEAM(4);
    if (IN(5)) { if (REP(5)) phase_ssd_states(a, lds); phase_ssd_states(a, lds); }
    SEAM(5);
    if (IN(6)) { if (REP(6)) phase_scan<false>(a, true); phase_scan<false>(a); }
    SEAM(6);
    if (IN(7)) { if (REP(7)) phase_ssd_out(a, lds, DRYLVL); phase_ssd_out(a, lds); }
    SEAM(7);
    if (IN(8)) for (int rep_ = 0; rep_ < 1 + REP(8); ++rep_) {
        pg8::Gemm g{(const bf16_t*)(a.ws + WS_OZ), (const bf16_t*)(a.ws + WS_WOUT), T, DM, 2048, 0, nullptr};
        pg8::StaticOrder S; S.init(T, DM, (int)gridDim.x, (int)blockIdx.x);
        pg8::EpiResF32 E{a.in[I_X], a.out, DM, ALPHA};
        pg8::gemm_phase<pg8::EpiResF32, pg8::StaticOrder, false>(lds, g, S, E);
    }
    SEAM(8);
    if (IN(9)) { if (REP(9)) phase_ln1_router(a, lds); phase_ln1_router(a, lds); }
    SEAM(9);
    if (IN(10)) { if (REP(10)) phase_lists(a, lds); phase_lists(a, lds); }
    SEAM(10);
    if (IN(11)) for (int rep_ = 0; rep_ < 1 + REP(11); ++rep_) moe_gemm1(a, lds, 0);
    SEAM(11);
    if (IN(12)) for (int rep_ = 0; rep_ < 1 + REP(12); ++rep_) moe_gemm2(a, lds, 0);
    SEAM(12);
    if (IN(13)) for (int rep_ = 0; rep_ < 1 + REP(13); ++rep_) { moe_combine(a, 0); moe_gemm1(a, lds, 1); }
    SEAM(13);
    if (IN(14)) for (int rep_ = 0; rep_ < 1 + REP(14); ++rep_) moe_gemm2(a, lds, 1);
    SEAM(14);
    if (IN(15)) for (int rep_ = 0; rep_ < 1 + REP(15); ++rep_) { moe_combine(a, 1); moe_gemm1(a, lds, 2); }
    SEAM(15);
    if (IN(16)) for (int rep_ = 0; rep_ < 1 + REP(16); ++rep_) moe_gemm2(a, lds, 2);
    SEAM(16);
    if (IN(17)) { if (REP(17)) moe_combine(a, 2); moe_combine(a, 2); }
#undef IN
#undef SEAM
#undef a
#undef lo
#undef hi
}

extern "C" void kernel_launch(void* const* d_in, const int* in_sizes, int n_in, void* d_out, int out_size, void* d_ws, size_t ws_size, hipStream_t stream) {
    static int grid = 0;
    if (grid == 0) {
        if (n_in != 24 || out_size != T * DM || ws_size < WS_END) { fprintf(stderr, "kernel_launch: unexpected problem (n_in %d, out %d, ws %zu); nothing launched\n", n_in, out_size, ws_size); grid = -1; return; }
        int dev = 0, cus = 0, per_cu = 0;
        hipGetDevice(&dev); hipDeviceGetAttribute(&cus, hipDeviceAttributeMultiprocessorCount, dev);
        hipFuncSetAttribute((const void*)fwd_megakernel, hipFuncAttributeMaxDynamicSharedMemorySize, LDS_BYTES);
        hipOccupancyMaxActiveBlocksPerMultiprocessor(&per_cu, (const void*)fwd_megakernel, 512, LDS_BYTES);
        if (per_cu < 1) { fprintf(stderr, "kernel_launch: occupancy query says %d blocks per CU\n", per_cu); per_cu = 1; }
        (void)hipGetLastError();
        grid = cus * per_cu; if (grid > 256) grid = 256;
    }
    if (grid < 0) return;
    hipMemsetAsync((char*)d_ws + WS_CTL, 0, 1 * MiB, stream);
    Args a{};
    for (int i = 0; i < 24; ++i) a.in[i] = (const float*)d_in[i];
    a.out = (float*)d_out; a.ws = (unsigned char*)d_ws; a.ph_lo = 0; a.ph_hi = N_PHASES;
    void* args[] = {&a};
    hipError_t e = hipLaunchCooperativeKernel((const void*)fwd_megakernel, dim3(grid), dim3(512), args, LDS_BYTES, stream);
    if (e != hipSuccess) fprintf(stderr, "cooperative launch failed: %s (grid %d)\n", hipGetErrorString(e), grid);
}
```

```cpp
#include <hip/hip_runtime.h>
#include <hip/hip_cooperative_groups.h>
#include <cstdio>
#include <cstdint>
namespace cg = cooperative_groups;

#define LAS __attribute__((address_space(3)))
typedef unsigned short bf16_t;
typedef short bf16x8 __attribute__((ext_vector_type(8)));
typedef short s16x4 __attribute__((ext_vector_type(4)));
typedef short v4i16_t __attribute__((ext_vector_type(4)));
typedef float f32x4 __attribute__((ext_vector_type(4)));
typedef float f32x2 __attribute__((ext_vector_type(2)));
typedef unsigned u32x4 __attribute__((ext_vector_type(4)));
typedef unsigned u32x2 __attribute__((ext_vector_type(2)));
typedef LAS unsigned char* ldsp;
typedef LAS const unsigned char* ldscp;

constexpr int BATCH = 8, SEQ = 4096, DM = 1024, T = BATCH * SEQ;
constexpr int NC = 32, CH = 128;
constexpr int NIN = 6192, NINP = 6144;
constexpr int NE = 64, TOPK = 8, DE = 256;
constexpr float LN_EPS = 1e-5f, RMS_EPS = 1e-5f;
constexpr float ALPHA = 1.189207115002721f;
constexpr float NEG_BIG = -1e30f;
constexpr int NPASS = 3;
constexpr int PASS_VB0[NPASS + 1] = {0, 86, 171, 256};
constexpr int PASS_MAXROWS = 106496 + 32768;
constexpr int PASS_MAXTILES = PASS_MAXROWS / 256;
constexpr int YS_ROW0 = 90624;

constexpr size_t MiB = 1u << 20;
constexpr size_t WS_CTL = 0;
constexpr size_t WS_WIN = 1 * MiB;
constexpr size_t WS_WOUT = 14 * MiB;
constexpr size_t WS_GATES = 18 * MiB;
constexpr size_t WS_MSTAT = 24 * MiB;
constexpr size_t WS_Q = 26 * MiB;
constexpr size_t WS_K = 58 * MiB;
constexpr size_t WS_V = 90 * MiB;
constexpr size_t WS_OZ = 154 * MiB;
constexpr size_t WS_XBC = 282 * MiB;
constexpr size_t WS_XB = 410 * MiB;
constexpr size_t WS_H = 26 * MiB;
constexpr size_t WS_W1T = 90 * MiB;
constexpr size_t WS_W2T = 155 * MiB;
constexpr size_t WS_Y = 188 * MiB;
constexpr size_t WS_ACT = 429 * MiB;
constexpr size_t WS_SELE = 497 * MiB;
constexpr size_t WS_SELW = 498 * MiB;
constexpr size_t WS_TOKPOS = 499 * MiB;
constexpr size_t WS_ROWTOK = 500 * MiB;
constexpr size_t WS_ROWGATE = 502 * MiB;
constexpr size_t WS_ROWY = 504 * MiB;
constexpr size_t WS_TILEE = 506 * MiB;
constexpr size_t WS_END = 507 * MiB;
static_assert((size_t)(YS_ROW0 + T) * DM * 2 <= (WS_ACT - WS_Y) && (size_t)PASS_MAXROWS * DE * 2 <= (WS_SELE - WS_ACT) && (size_t)NPASS * PASS_MAXROWS * 4 <= 2 * MiB, "MoE workspace map");
constexpr int MS_GM = 0;
constexpr int MS_MP = 4096;
constexpr int MS_U = 8192;
constexpr int MS_SD = 8192 + 262144;
constexpr int CW_BLOCKCNT = 1024;
constexpr int CW_NTILES = 512;
constexpr int CW_BAR = 32768;
constexpr int MISC_OFF = 159744 - 64;
#define lds_probe_base ((ldsp)(size_t)0 + MISC_OFF)

constexpr int LDS_BYTES = 159744;

typedef __bf16 bf16x2_t __attribute__((ext_vector_type(2)));
__device__ __forceinline__ unsigned pk2(float lo, float hi) { const f32x2 v = {lo, hi}; const bf16x2_t b = __builtin_convertvector(v, bf16x2_t); return __builtin_bit_cast(unsigned, b); }
__device__ __forceinline__ unsigned f2bf(float f) { return pk2(f, 0.f) & 0xffffu; }
__device__ __forceinline__ float bflo(unsigned u) { return __builtin_bit_cast(float, u << 16); }
__device__ __forceinline__ float bfhi(unsigned u) { return __builtin_bit_cast(float, u & 0xffff0000u); }
__device__ __forceinline__ float bf2f(short s) { return __builtin_bit_cast(float, ((unsigned)(unsigned short)s) << 16); }
template <int CTRL> __device__ __forceinline__ float dpp_f(float v) { return __builtin_bit_cast(float, __builtin_amdgcn_update_dpp(0, __builtin_bit_cast(int, v), CTRL, 0xF, 0xF, true)); }
__device__ __forceinline__ float rdlane_f(float v, int l) { return __builtin_bit_cast(float, __builtin_amdgcn_readlane(__builtin_bit_cast(int, v), l)); }
__device__ __forceinline__ float wave_sum(float v) {
    v += dpp_f<0x121>(v); v += dpp_f<0x122>(v); v += dpp_f<0x124>(v); v += dpp_f<0x128>(v);
    return (rdlane_f(v, 0) + rdlane_f(v, 16)) + (rdlane_f(v, 32) + rdlane_f(v, 48));
}
__device__ __forceinline__ float wave_max(float v) {
    v = fmaxf(v, dpp_f<0x121>(v)); v = fmaxf(v, dpp_f<0x122>(v)); v = fmaxf(v, dpp_f<0x124>(v)); v = fmaxf(v, dpp_f<0x128>(v));
    return fmaxf(fmaxf(rdlane_f(v, 0), rdlane_f(v, 16)), fmaxf(rdlane_f(v, 32), rdlane_f(v, 48)));
}
__device__ __forceinline__ float xor16_add(float v) { const unsigned u = __builtin_bit_cast(unsigned, v); const auto r = __builtin_amdgcn_permlane16_swap(u, u, false, false); return __builtin_bit_cast(float, r[0]) + __builtin_bit_cast(float, r[1]); }
__device__ __forceinline__ float xor32_add(float v) { const unsigned u = __builtin_bit_cast(unsigned, v); const auto r = __builtin_amdgcn_permlane32_swap(u, u, false, false); return __builtin_bit_cast(float, r[0]) + __builtin_bit_cast(float, r[1]); }
__device__ __forceinline__ float fq_sum(float v) { v += __shfl_xor(v, 16); v += __shfl_xor(v, 32); return v; }
__device__ __forceinline__ float group8_max(float v) {
    v = fmaxf(v, dpp_f<0xB1>(v)); v = fmaxf(v, dpp_f<0x4E>(v)); v = fmaxf(v, dpp_f<0x141>(v));
    return v;
}
template <int CTRL> __device__ __forceinline__ float dpp_keep_f(float v) { return __builtin_bit_cast(float, __builtin_amdgcn_update_dpp(__builtin_bit_cast(int, v), __builtin_bit_cast(int, v), CTRL, 0xF, 0xF, false)); }
__device__ __forceinline__ float wave_scan_add(float v, int lane) {
    v += dpp_f<0x111>(v); v += dpp_f<0x112>(v); v += dpp_f<0x114>(v); v += dpp_f<0x118>(v);
    const float t0 = rdlane_f(v, 15), t1 = rdlane_f(v, 31), t2 = rdlane_f(v, 47); const int row = lane >> 4;
    return v + (row == 0 ? 0.f : (row == 1 ? t0 : (row == 2 ? t0 + t1 : (t0 + t1) + t2)));
}
__device__ __forceinline__ float wave_scan_max(float v, int lane) {
    v = fmaxf(v, dpp_keep_f<0x111>(v)); v = fmaxf(v, dpp_keep_f<0x112>(v)); v = fmaxf(v, dpp_keep_f<0x114>(v)); v = fmaxf(v, dpp_keep_f<0x118>(v));
    const float t0 = rdlane_f(v, 15), t1 = rdlane_f(v, 31), t2 = rdlane_f(v, 47); const int row = lane >> 4;
    return row == 0 ? v : fmaxf(v, row == 1 ? t0 : (row == 2 ? fmaxf(t0, t1) : fmaxf(fmaxf(t0, t1), t2)));
}
__device__ __forceinline__ float sigmoidf_(float x) { return __builtin_amdgcn_rcpf(1.f + __expf(-x)); }
__device__ __forceinline__ float siluf_(float x) { return x * __builtin_amdgcn_rcpf(1.f + __expf(-x)); }
__device__ __forceinline__ float logsigmoidf_(float x) { return fminf(x, 0.f) - log1pf(__expf(-fabsf(x))); }
__device__ __forceinline__ float softplusf_(float x) { return fmaxf(x, 0.f) + log1pf(__expf(-fabsf(x))); }
__device__ __forceinline__ s16x4 vtr(ldscp p) { return __builtin_bit_cast(s16x4, __builtin_amdgcn_ds_read_tr16_b64_v4i16((LAS v4i16_t*)p)); }
__device__ __forceinline__ bf16x8 cat8(s16x4 lo, s16x4 hi) { return (bf16x8){lo[0], lo[1], lo[2], lo[3], hi[0], hi[1], hi[2], hi[3]}; }
#define BLOCK_SYNC() __syncthreads()
#ifndef PROBE_SEG
#define PROBE_SEG 0
#endif
#ifndef PROBE_SCALE
#define PROBE_SCALE 20
#endif
#define TSEG_BEGIN(id) do { if (PROBE_SEG == (id) && blockIdx.x == 0 && threadIdx.x == 0) { *(volatile LAS unsigned long long*)(lds_probe_base + 24) = __builtin_amdgcn_s_memrealtime(); } } while (0)
#define TSEG_END(id) do { if (PROBE_SEG == (id) && blockIdx.x == 0 && threadIdx.x == 0) { volatile LAS unsigned long long* p_ = (volatile LAS unsigned long long*)(lds_probe_base + 16); p_[0] = p_[0] + (__builtin_amdgcn_s_memrealtime() - p_[1]); } } while (0)
#define LDS_BARRIER() do { asm volatile("s_waitcnt lgkmcnt(0)" ::: "memory"); __builtin_amdgcn_s_barrier(); asm volatile("" ::: "memory"); } while (0)
__device__ __forceinline__ int launder(int v) { asm volatile("" : "+v"(v)); return v; }

namespace pg8 {
constexpr int BM = 256, BK = 64, HALF = 128, HTB = HALF * BK * 2, STAGE_BYTES = 8 * HTB, NXCD = 8, WGM = 8;
__host__ __device__ __forceinline__ int lds_byte(int r, int c) { const int st = (r >> 4) * 2 + (c >> 5), rr = r & 15, cc = c & 31, ob = rr * 64 + cc * 2; return st * 1024 + (ob ^ (((ob >> 9) & 1) << 5)); }
__host__ __device__ __forceinline__ void stage_rc(int b, int& R, int& C) { const int st = b / 1024, sb = b % 1024, swz = sb ^ (((sb >> 9) & 1) << 5); R = (st >> 1) * 16 + swz / 64; C = (st & 1) * 32 + (swz % 64) / 2; }
__host__ __device__ __forceinline__ int perm32(int rho) { const int n = rho >> 4, i = rho & 15; return 8 * (i >> 2) + 4 * n + (i & 3); }

struct Unit { int pm, pn, e; };
struct Gemm { const bf16_t* A; const bf16_t* Bt; int M, N, K; size_t bstride; const int* rowidx; };

struct StaticOrder {
    int nM, nN, nwg, G, c;
    __device__ void init(int M, int N, int G_, int c_) { nM = M / BM; nN = N / BM; nwg = nM * nN; G = G_; c = c_; }
    __device__ bool next(int i, Unit& u) const {
        const long L = (long)i * G + c; if (L >= nwg) return false;
        int wgid = (int)L; { const int q = nwg / NXCD, r = nwg % NXCD, xcd = wgid % NXCD, off = wgid / NXCD; wgid = (xcd < r ? xcd * (q + 1) : r * (q + 1) + (xcd - r) * q) + off; }
        const int nig = WGM * nN, gid = wgid / nig, fm = gid * WGM, gsz = (nM - fm) < WGM ? (nM - fm) : WGM;
        u.pm = fm + ((wgid % nig) % gsz); u.pn = (wgid % nig) / gsz; u.e = 0; return true;
    }
};
template <int NN, bool DYN> struct MoeOrder {
    int ntile, G, c, efix; const int* tile_e;
    __device__ __forceinline__ bool next(int i, Unit& u) const {
        const int L = i * G + c; if (L >= ntile * NN) return false;
        u.pm = L / NN; u.pn = L % NN; u.e = DYN ? tile_e[u.pm] : efix; return true;
    }
};

__device__ __forceinline__ unsigned cvt_pk_bf16(float lo, float hi) { unsigned r; asm volatile("v_cvt_pk_bf16_f32 %0, %1, %2" : "=v"(r) : "v"(lo), "v"(hi)); return r; }

template <class Epi, class Sched, bool GATHER>
__device__ __forceinline__ void gemm_phase(ldsp lds, const Gemm g, const Sched& S, const Epi& E) {
    const int tid = launder((int)threadIdx.x), wid = __builtin_amdgcn_readfirstlane(tid >> 6), lane = tid & 63, wr = wid >> 2, wc = wid & 3, fr = lane & 15, fq = lane >> 4;
    const int K = g.K, nt = K / BK;
    unsigned voffA[2], voffB[2]; int stR[2], stC[2];
#pragma unroll
    for (int i = 0; i < 2; ++i) { int R, C; stage_rc(tid * 16 + i * 8192, R, C); const int Rb = Epi::PERM ? ((R & ~31) + perm32(R & 31)) : R;
        stR[i] = R; stC[i] = C; voffA[i] = (unsigned)(R * K + C) * 2u; voffB[i] = (unsigned)(Rb * K + C) * 2u; }
    const size_t kstep = (size_t)(BK * 2);
    const size_t hstep = (size_t)HALF * K * 2;
    const size_t tstep = 2 * hstep;
    const unsigned ldsw = (unsigned)wid * 1024u;
    const int aoff = lds_byte(wr * 64 + fr, fq * 8), boff = lds_byte(wc * 32 + fr, fq * 8);
#define PG8_SA(b, h) (((b) * 2 + (h)) * HTB)
#define PG8_SB(b, h) ((4 + (b) * 2 + (h)) * HTB)
#define PG8_STAGE(bufoff, gbase, voff) do { _Pragma("unroll") for (int _i = 0; _i < 2; ++_i) \
        __builtin_amdgcn_global_load_lds((const unsigned*)((const char*)(gbase) + (voff)[_i]), (LAS unsigned*)(lds + (bufoff) + ldsw + _i * 8192), 16, 0, 0); } while (0)
#define PG8_LDA(dst, b, h) do { _Pragma("unroll") for (int m = 0; m < 4; ++m) _Pragma("unroll") for (int k = 0; k < 2; ++k) dst[m][k] = *(const LAS bf16x8*)(lds + PG8_SA(b, h) + aoff + m * 2048 + k * 1024); } while (0)
#define PG8_LDB(dst, b, h) do { _Pragma("unroll") for (int n = 0; n < 2; ++n) _Pragma("unroll") for (int k = 0; k < 2; ++k) dst[n][k] = *(const LAS bf16x8*)(lds + PG8_SB(b, h) + boff + n * 2048 + k * 1024); } while (0)
#define PG8_MMA(ai, bj, At, Bt) do { __builtin_amdgcn_s_setprio(1); _Pragma("unroll") for (int m = 0; m < 4; ++m) _Pragma("unroll") for (int n = 0; n < 2; ++n) _Pragma("unroll") for (int k = 0; k < 2; ++k) \
        acc[ai][bj][m][n] = __builtin_amdgcn_mfma_f32_16x16x32_bf16(Bt[n][k], At[m][k], acc[ai][bj][m][n], 0, 0, 0); __builtin_amdgcn_s_setprio(0); } while (0)
#define PG8_WAIT_V(n) asm volatile("s_waitcnt vmcnt(" #n ")" ::: "memory")
#define PG8_WAIT_L(n) asm volatile("s_waitcnt lgkmcnt(" #n ")" ::: "memory")
#define PG8_BAR __builtin_amdgcn_s_barrier()
#define PG8_SCHED __builtin_amdgcn_sched_barrier(0)
    Unit cur, nxt; int ui = 0;
    if (!S.next(0, cur)) return;
    f32x4 acc[2][2][4][2];
#pragma unroll
    for (int a = 0; a < 2; ++a)
#pragma unroll
        for (int b = 0; b < 2; ++b)
#pragma unroll
            for (int m = 0; m < 4; ++m)
#pragma unroll
                for (int n = 0; n < 2; ++n) acc[a][b][m][n] = (f32x4){0.f, 0.f, 0.f, 0.f};
    bf16x8 At[4][2], B0[2][2], B1[2][2];
    unsigned gc[2][2], gn[2][2];
    auto load_g = [&](unsigned (&dst)[2][2], const Unit& u) {
#pragma unroll
        for (int h = 0; h < 2; ++h)
#pragma unroll
            for (int i = 0; i < 2; ++i) { const int src = g.rowidx[u.pm * BM + h * HALF + stR[i]]; dst[h][i] = (unsigned)(src * K + stC[i]) * 2u; }
    };
    const char* cA = GATHER ? (const char*)g.A : (const char*)g.A + (size_t)cur.pm * tstep;
    const char* cB = (const char*)g.Bt + (size_t)cur.e * g.bstride + (size_t)cur.pn * tstep;
#define PG8_STA(bufoff, h, ptr, garr) do { if constexpr (GATHER) { PG8_STAGE(bufoff, ptr, garr[h]); } else { PG8_STAGE(bufoff, (ptr) + (h) * hstep, voffA); } } while (0)
    if constexpr (GATHER) { load_g(gc, cur); }
    PG8_STAGE(PG8_SB(0, 0), cB, voffB); PG8_STAGE(PG8_SB(0, 1), cB + hstep, voffB); PG8_STA(PG8_SA(0, 0), 0, cA, gc); PG8_STA(PG8_SA(0, 1), 1, cA, gc);
    if (wr == 1) PG8_BAR;
    PG8_WAIT_V(2); PG8_BAR;
    PG8_STAGE(PG8_SB(1, 0), cB + kstep, voffB); PG8_STA(PG8_SA(1, 0), 0, cA + kstep, gc); PG8_STAGE(PG8_SB(1, 1), cB + hstep + kstep, voffB);
    PG8_WAIT_V(6); PG8_BAR;
    for (;;) {
        const bool has_next = S.next(ui + 1, nxt);
        const char* nA = GATHER ? (const char*)g.A : (has_next ? (const char*)g.A + (size_t)nxt.pm * tstep : cA);
        const char* nB = has_next ? (const char*)g.Bt + (size_t)nxt.e * g.bstride + (size_t)nxt.pn * tstep : cB;
        if constexpr (GATHER) { if (has_next) load_g(gn, nxt); else {
#pragma unroll
            for (int h = 0; h < 2; ++h)
#pragma unroll
                for (int i = 0; i < 2; ++i) gn[h][i] = gc[h][i]; } }
        for (int t = 0; t < nt; t += 2) {
            const bool last = (t == nt - 2);
            const char* a1 = cA + (size_t)(t + 1) * kstep;
            const char* a2 = last ? nA : cA + (size_t)(t + 2) * kstep; const char* b2 = last ? nB : cB + (size_t)(t + 2) * kstep;
            const char* a3 = a2 + kstep; const char* b3 = b2 + kstep;
#define PG8_STA2(bufoff, h, ptr) do { if constexpr (GATHER) { if (last) { PG8_STAGE(bufoff, ptr, gn[h]); } else { PG8_STAGE(bufoff, ptr, gc[h]); } } else { PG8_STAGE(bufoff, (ptr) + (h) * hstep, voffA); } } while (0)
            PG8_LDB(B0, 0, 0); PG8_LDB(B1, 0, 1); PG8_SCHED; PG8_LDA(At, 0, 0); PG8_STA(PG8_SA(1, 1), 1, a1, gc);
            PG8_WAIT_V(8); PG8_WAIT_L(0); PG8_BAR; PG8_MMA(0, 0, At, B0); PG8_MMA(0, 1, At, B1); PG8_BAR; PG8_SCHED;
            PG8_LDA(At, 0, 1); PG8_STAGE(PG8_SB(0, 0), b2, voffB); PG8_STAGE(PG8_SB(0, 1), b2 + hstep, voffB); PG8_STA2(PG8_SA(0, 0), 0, a2);
            PG8_WAIT_V(8); PG8_WAIT_L(0); PG8_BAR; PG8_MMA(1, 0, At, B0); PG8_MMA(1, 1, At, B1); PG8_BAR; PG8_SCHED;
            PG8_LDB(B0, 1, 0); PG8_LDB(B1, 1, 1); PG8_SCHED; PG8_LDA(At, 1, 0); PG8_STA2(PG8_SA(0, 1), 1, a2);
            PG8_WAIT_V(8); PG8_WAIT_L(0); PG8_BAR; PG8_MMA(0, 0, At, B0); PG8_MMA(0, 1, At, B1); PG8_BAR; PG8_SCHED;
            PG8_LDA(At, 1, 1); PG8_STAGE(PG8_SB(1, 0), b3, voffB); PG8_STAGE(PG8_SB(1, 1), b3 + hstep, voffB); PG8_STA2(PG8_SA(1, 0), 0, a3);
            PG8_WAIT_V(8); PG8_WAIT_L(0); PG8_BAR; PG8_MMA(1, 0, At, B0); PG8_MMA(1, 1, At, B1); PG8_BAR; PG8_SCHED;
        }
        TSEG_BEGIN(70);
        if (wr == 0) PG8_BAR;
        E(acc, cur, wr, wc, launder(fr), launder(fq));
        TSEG_END(70);
        if (!has_next) break;
#pragma unroll
        for (int a = 0; a < 2; ++a)
#pragma unroll
            for (int b = 0; b < 2; ++b)
#pragma unroll
                for (int m = 0; m < 4; ++m)
#pragma unroll
                    for (int n = 0; n < 2; ++n) acc[a][b][m][n] = (f32x4){0.f, 0.f, 0.f, 0.f};
        cur = nxt; cA = nA; cB = nB; ++ui;
        if constexpr (GATHER) {
#pragma unroll
            for (int h = 0; h < 2; ++h)
#pragma unroll
                for (int i = 0; i < 2; ++i) gc[h][i] = gn[h][i];
        }
        if (wr == 1) PG8_BAR;
    }
    PG8_WAIT_V(0);
    PG8_BAR;
#undef PG8_SA
#undef PG8_SB
#undef PG8_STAGE
#undef PG8_STA
#undef PG8_STA2
#undef PG8_LDA
#undef PG8_LDB
#undef PG8_MMA
#undef PG8_WAIT_V
#undef PG8_WAIT_L
#undef PG8_BAR
#undef PG8_SCHED
}

struct EpiInProj {
    static constexpr bool PERM = true;
    bf16_t *q, *k, *v, *oz, *xbc; float* gates;
    __device__ __forceinline__ void operator()(const f32x4 (&acc)[2][2][4][2], const Unit& u, int wr, int wc, int fr, int fq) const {
        const int row0 = u.pm * BM + wr * 64 + fr, pn = u.pn;
        bf16_t* base; int ld, colt;
        if (pn < 2) { base = q; ld = 512; colt = pn * 256; }
        else if (pn < 4) { base = k; ld = 512; colt = (pn - 2) * 256; }
        else if (pn < 8) { base = v; ld = 1024; colt = (pn - 4) * 256; }
        else if (pn < 16) { base = oz; ld = 2048; colt = (pn - 8) * 256; }
        else { base = xbc; ld = 2048; colt = (pn - 16) * 256; }
        const int col0 = colt + wc * 32 + 8 * fq;
#pragma unroll
        for (int ai = 0; ai < 2; ++ai)
#pragma unroll
            for (int m = 0; m < 4; ++m) { bf16_t* rowp = base + (size_t)(row0 + ai * HALF + m * 16) * ld + col0;
#pragma unroll
                for (int bj = 0; bj < 2; ++bj) { const f32x4 v0 = acc[ai][bj][m][0], v1 = acc[ai][bj][m][1];
                    u32x4 w; w.x = cvt_pk_bf16(v0[0], v0[1]); w.y = cvt_pk_bf16(v0[2], v0[3]); w.z = cvt_pk_bf16(v1[0], v1[1]); w.w = cvt_pk_bf16(v1[2], v1[3]);
                    *(u32x4*)(rowp + bj * HALF) = w; } }
    }
};
struct EpiResF32 {
    static constexpr bool PERM = false;
    const float* res; float* out; int ldc; float alpha;
    __device__ __forceinline__ void operator()(const f32x4 (&acc)[2][2][4][2], const Unit& u, int wr, int wc, int fr, int fq) const {
        const int col0 = u.pn * BM + wc * 32 + 4 * fq;
#pragma unroll
        for (int ai = 0; ai < 2; ++ai)
#pragma unroll
            for (int m = 0; m < 4; ++m) { const size_t off = (size_t)(u.pm * BM + ai * HALF + wr * 64 + m * 16 + fr) * ldc + col0;
                f32x4 r[2][2];
#pragma unroll
                for (int bj = 0; bj < 2; ++bj)
#pragma unroll
                    for (int n = 0; n < 2; ++n) r[bj][n] = *(const f32x4*)(res + off + bj * HALF + n * 16);
#pragma unroll
                for (int bj = 0; bj < 2; ++bj)
#pragma unroll
                    for (int n = 0; n < 2; ++n) *(f32x4*)(out + off + bj * HALF + n * 16) = acc[ai][bj][m][n] + r[bj][n] * alpha;
                asm volatile("" ::: "memory"); }
    }
};
struct EpiResBf16 {
    static constexpr bool PERM = true;
    const float* res; bf16_t* out; int ldc; float alpha;
    __device__ __forceinline__ void operator()(const f32x4 (&acc)[2][2][4][2], const Unit& u, int wr, int wc, int fr, int fq) const {
        const int col0 = u.pn * BM + wc * 32 + 8 * fq;
#pragma unroll
        for (int ai = 0; ai < 2; ++ai)
#pragma unroll
            for (int m = 0; m < 4; ++m) { const size_t off = (size_t)(u.pm * BM + ai * HALF + wr * 64 + m * 16 + fr) * ldc + col0;
                f32x4 r[2][2];
#pragma unroll
                for (int bj = 0; bj < 2; ++bj)
#pragma unroll
                    for (int n = 0; n < 2; ++n) r[bj][n] = *(const f32x4*)(res + off + bj * HALF + n * 4);
#pragma unroll
                for (int bj = 0; bj < 2; ++bj) { const f32x4 v0 = acc[ai][bj][m][0] + r[bj][0] * alpha, v1 = acc[ai][bj][m][1] + r[bj][1] * alpha;
                    u32x4 w; w.x = cvt_pk_bf16(v0[0], v0[1]); w.y = cvt_pk_bf16(v0[2], v0[3]); w.z = cvt_pk_bf16(v1[0], v1[1]); w.w = cvt_pk_bf16(v1[2], v1[3]);
                    *(u32x4*)(out + off + bj * HALF) = w; }
                asm volatile("" ::: "memory"); }
    }
};
struct EpiF32 {
    static constexpr bool PERM = false;
    float* out; int ldc;
    __device__ __forceinline__ void operator()(const f32x4 (&acc)[2][2][4][2], const Unit& u, int wr, int wc, int fr, int fq) const {
        const int col0 = u.pn * BM + wc * 32 + 4 * fq;
#pragma unroll
        for (int ai = 0; ai < 2; ++ai)
#pragma unroll
            for (int m = 0; m < 4; ++m) { float* rowp = out + (size_t)(u.pm * BM + ai * HALF + wr * 64 + m * 16 + fr) * ldc + col0;
#pragma unroll
                for (int bj = 0; bj < 2; ++bj)
#pragma unroll
                    for (int n = 0; n < 2; ++n) *(f32x4*)(rowp + bj * HALF + n * 16) = acc[ai][bj][m][n];
                asm volatile("" ::: "memory"); }
    }
};
struct EpiSwiGLU {
    static constexpr bool PERM = true;
    bf16_t* act;
    __device__ __forceinline__ void operator()(const f32x4 (&acc)[2][2][4][2], const Unit& u, int wr, int wc, int fr, int fq) const {
        const int row0 = u.pm * BM + wr * 64 + fr, col0 = u.pn * 128 + wc * 32 + 8 * fq;
#pragma unroll
        for (int ai = 0; ai < 2; ++ai)
#pragma unroll
            for (int m = 0; m < 4; ++m) { bf16_t* rowp = act + (size_t)(row0 + ai * HALF + m * 16) * DE + col0;
                float r[8];
#pragma unroll
                for (int n = 0; n < 2; ++n)
#pragma unroll
                    for (int j = 0; j < 4; ++j) { const float gt = acc[ai][0][m][n][j], up = acc[ai][1][m][n][j]; r[n * 4 + j] = gt * __builtin_amdgcn_rcpf(1.f + __expf(-gt)) * up; }
                u32x4 w; w.x = cvt_pk_bf16(r[0], r[1]); w.y = cvt_pk_bf16(r[2], r[3]); w.z = cvt_pk_bf16(r[4], r[5]); w.w = cvt_pk_bf16(r[6], r[7]);
                *(u32x4*)rowp = w; asm volatile("" ::: "memory"); }
    }
};
struct EpiDownY {
    static constexpr bool PERM = true;
    unsigned char* Y; const int* rowy; const float* rowgate;
    __device__ __forceinline__ void operator()(const f32x4 (&acc)[2][2][4][2], const Unit& u, int wr, int wc, int fr, int fq) const {
        const int row0 = u.pm * BM + wr * 64 + fr, col0 = u.pn * BM + wc * 32 + 8 * fq;
#pragma unroll
        for (int ai = 0; ai < 2; ++ai) {
            int yrv[4]; float gtv[4];
#pragma unroll
            for (int m = 0; m < 4; ++m) { const int row = row0 + ai * HALF + m * 16; yrv[m] = rowy[row]; gtv[m] = rowgate[row]; }
#pragma unroll
            for (int m = 0; m < 4; ++m) { const int yr = yrv[m]; const float gt = gtv[m] * 64.f;
                unsigned char* rowp = Y + (size_t)yr * DM + col0;
#pragma unroll
                for (int bj = 0; bj < 2; ++bj) { const f32x4 v0 = acc[ai][bj][m][0] * gt, v1 = acc[ai][bj][m][1] * gt;
                    int w0 = 0, w1 = 0;
                    w0 = __builtin_amdgcn_cvt_pk_fp8_f32(__builtin_amdgcn_fmed3f(v0[0], -448.f, 448.f), __builtin_amdgcn_fmed3f(v0[1], -448.f, 448.f), w0, false);
                    w0 = __builtin_amdgcn_cvt_pk_fp8_f32(__builtin_amdgcn_fmed3f(v0[2], -448.f, 448.f), __builtin_amdgcn_fmed3f(v0[3], -448.f, 448.f), w0, true);
                    w1 = __builtin_amdgcn_cvt_pk_fp8_f32(__builtin_amdgcn_fmed3f(v1[0], -448.f, 448.f), __builtin_amdgcn_fmed3f(v1[1], -448.f, 448.f), w1, false);
                    w1 = __builtin_amdgcn_cvt_pk_fp8_f32(__builtin_amdgcn_fmed3f(v1[2], -448.f, 448.f), __builtin_amdgcn_fmed3f(v1[3], -448.f, 448.f), w1, true);
                    u32x2 w; w.x = (unsigned)w0; w.y = (unsigned)w1;
                    *(u32x2*)(rowp + bj * HALF) = w; asm volatile("" ::: "memory"); }
            }
        }
    }
};
}

struct Args { const float* in[24]; float* out; unsigned char* ws; int ph_lo, ph_hi; };
typedef const __attribute__((address_space(4))) Args& ArgsRef;
enum { I_X = 0, I_WIN, I_MLIB, I_MLFB, I_MLNW, I_CONVW, I_CONVB, I_DTB, I_ALOG, I_DSKIP, I_SSMNW, I_WOUT, I_LN1G, I_LN1B, I_WR, I_RB, I_WEG, I_WEU, I_WED, I_WSG, I_WSU, I_WSD, I_LN2G, I_LN2B };

__device__ __forceinline__ void transpose_item(const float* W, int ldw, int k0, int c0, bf16_t* WT, int ldk, int r0, float scale, LAS float* scr, int lane) {
#pragma unroll 8
    for (int i = 0; i < 32; ++i) { const int kk = 2 * i + (lane >> 5); scr[kk * 33 + (lane & 31)] = W[(size_t)(k0 + kk) * ldw + c0 + (lane & 31)]; }
    asm volatile("s_waitcnt lgkmcnt(0)" ::: "memory");
    const int c = lane & 7;
#pragma unroll
    for (int j = 0; j < 4; ++j) { const int n = (lane >> 3) + 8 * j; const LAS float* s = scr + (8 * c) * 33 + n;
        u32x4 o; o.x = pk2(s[0 * 33] * scale, s[1 * 33] * scale); o.y = pk2(s[2 * 33] * scale, s[3 * 33] * scale); o.z = pk2(s[4 * 33] * scale, s[5 * 33] * scale); o.w = pk2(s[6 * 33] * scale, s[7 * 33] * scale);
        *(u32x4*)(WT + (size_t)(r0 + n) * ldk + k0 + 8 * c) = o; }
    asm volatile("s_waitcnt lgkmcnt(0)" ::: "memory");
}

__device__ __forceinline__ void phase_p0(ArgsRef a, ldsp lds) {
    const int tid = launder((int)threadIdx.x), lane = tid & 63, wave = tid >> 6, G = gridDim.x;
    const int gw = blockIdx.x * 8 + wave, NGW = G * 8;
    LAS float* scr = (LAS float*)(lds + wave * 8448);
    const float* x = a.in[I_X]; bf16_t* xb = (bf16_t*)(a.ws + WS_XB);
    bf16_t* wint = (bf16_t*)(a.ws + WS_WIN); bf16_t* woutt = (bf16_t*)(a.ws + WS_WOUT);
    constexpr int NI_WIN = 192 * 16, NI_WOUT = 32 * 32;
    TSEG_BEGIN(51);
    for (int it = gw; it < NI_WIN + NI_WOUT; it += NGW) {
        if (it < NI_WIN) {
            const int cb = it % 192, kb = it / 192; const int dr = cb * 32;
            int sc; float scale = 1.f;
            if (dr < 512) sc = dr; else if (dr < 1024) { sc = dr; scale = 0.08838834764831845f; } else if (dr < 3072) sc = dr; else sc = dr + 16;
            transpose_item(a.in[I_WIN], NIN, kb * 64, sc, wint, DM, dr, scale, scr, lane);
        } else {
            const int r = it - NI_WIN; const int cb = r % 32, kb = r / 32;
            transpose_item(a.in[I_WOUT], DM, kb * 64, cb * 32, woutt, 2048, cb * 32, 1.f, scr, lane);
        }
    }
    LDS_BARRIER();
    TSEG_END(51); TSEG_BEGIN(54);
    constexpr int WP = 2064;
#pragma unroll 1
    for (int e0 = tid; e0 < 12 * DM; e0 += 512 * 8) {
        f32x4 wv[8];
#pragma unroll
        for (int u = 0; u < 8; ++u) { const int e = e0 + 512 * u, k = e / 12, pc = e % 12; const int col = pc < 4 ? 3072 + 4 * pc : 6160 + 4 * (pc - 4);
            wv[u] = *(const f32x4*)(a.in[I_WIN] + (size_t)k * NIN + col); }
#pragma unroll
        for (int u = 0; u < 8; ++u) { const int e = e0 + 512 * u, k = e / 12, pc = e % 12; const int n0 = 4 * pc;
#pragma unroll
            for (int j = 0; j < 4; ++j) *(LAS unsigned short*)(lds + (n0 + j) * WP + k * 2) = (unsigned short)f2bf(wv[u][j]); }
    }
    LDS_BARRIER();
    float* gates = (float*)(a.ws + WS_GATES);
    const int fr = lane & 15, fq = lane >> 4;
    TSEG_END(54); TSEG_BEGIN(57);
    for (int grp = gw; grp < T / 16; grp += NGW) {
        const float* xr = x + (size_t)(grp * 16 + fr) * DM + 8 * fq; bf16_t* xo = xb + (size_t)(grp * 16 + fr) * DM + 8 * fq;
        f32x4 acc[3];
#pragma unroll
        for (int nt = 0; nt < 3; ++nt) acc[nt] = (f32x4){0.f, 0.f, 0.f, 0.f};
#pragma unroll 1
        for (int kc = 0; kc < 4; ++kc) {
            f32x4 v[8][2];
#pragma unroll
            for (int ks = 0; ks < 8; ++ks) { v[ks][0] = *(const f32x4*)(xr + 256 * kc + 32 * ks); v[ks][1] = *(const f32x4*)(xr + 256 * kc + 32 * ks + 4); }
#pragma unroll
            for (int ks = 0; ks < 8; ++ks) {
                u32x4 pk; pk.x = pk2(v[ks][0][0], v[ks][0][1]); pk.y = pk2(v[ks][0][2], v[ks][0][3]); pk.z = pk2(v[ks][1][0], v[ks][1][1]); pk.w = pk2(v[ks][1][2], v[ks][1][3]);
                *(u32x4*)(xo + 256 * kc + 32 * ks) = pk;
                const bf16x8 af = __builtin_bit_cast(bf16x8, pk);
#pragma unroll
                for (int nt = 0; nt < 3; ++nt) { const bf16x8 wf = *(const LAS bf16x8*)(lds + (16 * nt + fr) * WP + (256 * kc + 32 * ks + 8 * fq) * 2);
                    acc[nt] = __builtin_amdgcn_mfma_f32_16x16x32_bf16(wf, af, acc[nt], 0, 0, 0); }
            }
        }
#pragma unroll
        for (int nt = 0; nt < 3; ++nt) *(f32x4*)(gates + (size_t)(grp * 16 + fr) * 48 + 16 * nt + 4 * fq) = acc[nt];
    }
    LDS_BARRIER();
    TSEG_END(57);
}

__device__ __forceinline__ void chunk_state_gemm(ldscp P, int pitchP, ldscp Q, int pitchQ, const LAS float* w, bf16_t* out, int lane) {
    const int g = lane >> 4, q = (lane & 15) >> 2, p = lane & 3, fr = lane & 15;
#pragma unroll 1
    for (int ih = 0; ih < 2; ++ih) {
        f32x4 acc[4][4];
#pragma unroll
        for (int i = 0; i < 4; ++i)
#pragma unroll
            for (int j = 0; j < 4; ++j) acc[i][j] = (f32x4){0.f, 0.f, 0.f, 0.f};
#pragma unroll 1
        for (int ks = 0; ks < 4; ++ks) {
            const int srow = 32 * ks + 8 * g;
            const f32x4 w0 = *(const LAS f32x4*)(w + srow), w1 = *(const LAS f32x4*)(w + srow + 4);
            bf16x8 qf[4];
#pragma unroll
            for (int jt = 0; jt < 4; ++jt) {
                ldscp ad = Q + (srow + q) * pitchQ + (16 * jt + 4 * p) * 2;
                const s16x4 lo = vtr(ad), hi = vtr(ad + 4 * pitchQ);
                u32x4 pk; pk.x = pk2(bf2f(lo[0]) * w0[0], bf2f(lo[1]) * w0[1]); pk.y = pk2(bf2f(lo[2]) * w0[2], bf2f(lo[3]) * w0[3]);
                pk.z = pk2(bf2f(hi[0]) * w1[0], bf2f(hi[1]) * w1[1]); pk.w = pk2(bf2f(hi[2]) * w1[2], bf2f(hi[3]) * w1[3]);
                qf[jt] = __builtin_bit_cast(bf16x8, pk);
            }
#pragma unroll
            for (int it = 0; it < 4; ++it) {
                ldscp ad = P + (srow + q) * pitchP + (16 * (4 * ih + it) + 4 * p) * 2;
                const bf16x8 pf = cat8(vtr(ad), vtr(ad + 4 * pitchP));
#pragma unroll
                for (int jt = 0; jt < 4; ++jt) acc[it][jt] = __builtin_amdgcn_mfma_f32_16x16x32_bf16(pf, qf[jt], acc[it][jt], 0, 0, 0);
            }
        }
#pragma unroll
        for (int it = 0; it < 4; ++it)
#pragma unroll
            for (int jt = 0; jt < 4; ++jt) { u32x2 o; o.x = pk2(acc[it][jt][0], acc[it][jt][1]); o.y = pk2(acc[it][jt][2], acc[it][jt][3]);
                *(u32x2*)(out + (size_t)(16 * jt + fr) * 128 + 16 * (4 * ih + it) + 4 * g) = o; }
    }
}

constexpr int P128 = 288, P256 = 544;
constexpr int P128R = 272;

struct MlVec { float ig[2], bb[2], colw[2]; float g; };
__device__ __forceinline__ MlVec ml_chunk_vec(const float* gates, int row0, int d, int h, float ib, float fb, int lane) {
    MlVec r; float lf[2];
#pragma unroll
    for (int j = 0; j < 2; ++j) { const int u = 2 * lane + j, t = d ? 127 - u : u; const float* gr = gates + (size_t)(row0 + t) * 48;
        r.ig[j] = gr[d * 4 + h] + ib; lf[j] = logsigmoidf_(gr[8 + d * 4 + h] + fb); }
    const float loc1 = lf[0] + lf[1]; const float s = wave_scan_add(loc1, lane); const float ex = s - loc1;
    r.bb[0] = ex + lf[0]; r.bb[1] = s; r.g = rdlane_f(s, 63);
    r.colw[0] = r.ig[0] - r.bb[0]; r.colw[1] = r.ig[1] - r.bb[1];
    return r;
}

__device__ __forceinline__ void phase_ml_states(ArgsRef a, ldsp lds) {
    const int tid = launder((int)threadIdx.x), lane = tid & 63, wave = __builtin_amdgcn_readfirstlane(tid >> 6), G = gridDim.x;
    const bf16_t* Kb = (const bf16_t*)(a.ws + WS_K); const bf16_t* Vb = (const bf16_t*)(a.ws + WS_V);
    const float* gates = (const float*)(a.ws + WS_GATES); float* ms = (float*)(a.ws + WS_MSTAT);
    bf16_t* ST = (bf16_t*)a.out;
    ldsp Kt = lds, Vt = lds + 36864; LAS float* wv = (LAS float*)(lds + 106496);
    u32x4 kreg[4], vreg[8];
    auto issue_tiles = [&](int item) {
        const int c = item % NC, h = (item / NC) % 4, b = item / (NC * 4); const int row0 = b * SEQ + c * CH;
#pragma unroll
        for (int i = 0; i < 4; ++i) { const int id = tid + 512 * i, r = id >> 4, ch = id & 15; kreg[i] = *(const u32x4*)(Kb + (size_t)(row0 + r) * 512 + h * 128 + ch * 8); }
#pragma unroll
        for (int i = 0; i < 8; ++i) { const int id = tid + 512 * i, r = id >> 5, ch = id & 31; vreg[i] = *(const u32x4*)(Vb + (size_t)(row0 + r) * 1024 + h * 256 + ch * 8); }
    };
    if ((int)blockIdx.x < BATCH * 4 * NC) issue_tiles(blockIdx.x);
    for (int item = blockIdx.x; item < BATCH * 4 * NC; item += G) {
        const int c = item % NC, h = (item / NC) % 4, b = item / (NC * 4); const int row0 = b * SEQ + c * CH;
        TSEG_BEGIN(35);
#pragma unroll
        for (int i = 0; i < 4; ++i) { const int id = tid + 512 * i, r = id >> 4, ch = id & 15; *(LAS u32x4*)(Kt + r * P128 + ch * 16) = kreg[i]; }
#pragma unroll
        for (int i = 0; i < 8; ++i) { const int id = tid + 512 * i, r = id >> 5, ch = id & 31; *(LAS u32x4*)(Vt + r * P256 + ch * 16) = vreg[i]; }
        if (wave < 2) {
            const int d = wave; const MlVec v = ml_chunk_vec(gates, row0, d, h, a.in[I_MLIB][d * 4 + h], a.in[I_MLFB][d * 4 + h], lane);
            const float a0 = v.g + v.colw[0], a1 = v.g + v.colw[1]; const float ml = wave_max(fmaxf(a0, a1));
#pragma unroll
            for (int j = 0; j < 2; ++j) { const int u = 2 * lane + j, t = d ? 127 - u : u; wv[d * 128 + t] = __expf((j ? a1 : a0) - ml); }
            if (lane == 0) { const int chain = (b * 4 + h) * 2 + d; ms[MS_GM + (chain * 32 + c) * 2] = v.g; ms[MS_GM + (chain * 32 + c) * 2 + 1] = ml; }
        }
        LDS_BARRIER();
        if (item + G < BATCH * 4 * NC) issue_tiles(item + G);
        TSEG_END(35); TSEG_BEGIN(36);
        if (tid < 256) { const int d = tid >> 7, dk = tid & 127; float s = 0.f;
            for (int r = 0; r < 128; ++r) s += wv[d * 128 + r] * bf2f(*(const LAS short*)(Kt + r * P128 + dk * 2));
            ms[MS_U + (size_t)(((b * 4 + h) * 2 + d) * 32 + c) * 128 + dk] = s; }
        TSEG_END(36); TSEG_BEGIN(37);
        { const int d = wave >> 2, qd = wave & 3;
          bf16_t* out = ST + ((size_t)(((b * 4 + h) * 2 + d) * 32 + c) * 256 + 64 * qd) * 128;
          chunk_state_gemm(Kt, P128, Vt + 64 * qd * 2, P256, wv + d * 128, out, lane); }
        LDS_BARRIER();
        TSEG_END(37);
    }
}

template <bool ML, bool REV>
__device__ __forceinline__ void scan_chain(const float* ms, const bf16_t* base, bf16_t* wbase, int chain, float (&st)[8], float& m) {
    constexpr int E = ML ? 32768 : 8192;
#pragma unroll 1
    for (int half = 0; half < 2; ++half) {
        const int cb0 = (REV ? 1 - half : half) * 16;
        u32x4 buf[16]; float dcy[16], scl[16];
#pragma unroll
        for (int j = 0; j < 16; ++j) buf[j] = *(const u32x4*)(base + (size_t)(cb0 + j) * E);
#pragma unroll
        for (int j = 0; j < 16; ++j) { const int c = cb0 + j;
            if (ML) { dcy[j] = ms[MS_GM + (chain * 32 + c) * 2]; scl[j] = ms[MS_GM + (chain * 32 + c) * 2 + 1]; }
            else { dcy[j] = ms[MS_SD + chain * 32 + c]; scl[j] = 1.f; } }
#pragma unroll
        for (int step = 0; step < 16; ++step) {
            const int j = REV ? 15 - step : step; const int c = cb0 + j;
            const u32x4 cur = buf[j];
            float decay = dcy[j], scale = scl[j];
            if (ML) { const float g = decay, ml = scale; const float mn = fmaxf(g + m, ml); decay = __expf(g + m - mn); scale = __expf(ml - mn); m = mn; }
            u32x4 o; o.x = pk2(st[0], st[1]); o.y = pk2(st[2], st[3]); o.z = pk2(st[4], st[5]); o.w = pk2(st[6], st[7]);
            *(u32x4*)(wbase + (size_t)c * E) = o;
            st[0] = decay * st[0] + scale * bflo(cur.x); st[1] = decay * st[1] + scale * bfhi(cur.x);
            st[2] = decay * st[2] + scale * bflo(cur.y); st[3] = decay * st[3] + scale * bfhi(cur.y);
            st[4] = decay * st[4] + scale * bflo(cur.z); st[5] = decay * st[5] + scale * bfhi(cur.z);
            st[6] = decay * st[6] + scale * bflo(cur.w); st[7] = decay * st[7] + scale * bfhi(cur.w);
        }
    }
}

template <bool ML>
__device__ __forceinline__ void phase_scan(ArgsRef a, bool dry = false) {
    const int tid = launder((int)threadIdx.x), G = gridDim.x;
    float* ms = (float*)(a.ws + WS_MSTAT); bf16_t* ST = (bf16_t*)a.out;
    constexpr int E = ML ? 32768 : 8192, VPC = E / 8, NCHAIN = ML ? 64 : 256, NV = NCHAIN * VPC, NX = ML ? 64 * 128 : 0;
    for (int it = blockIdx.x * 512 + tid; it < (dry ? NV / 2 : NV + NX); it += G * 512) {
        if (it < NV) {
            const int chain = it / VPC, vi = it % VPC, d = chain & 1;
            float st[8];
#pragma unroll
            for (int j = 0; j < 8; ++j) st[j] = 0.f;
            float m = NEG_BIG;
            bf16_t* base = ST + (size_t)chain * 32 * E + vi * 8;
            bf16_t* wbase = dry ? (bf16_t*)(a.ws + WS_XB) + (base - ST) : base;
            if (d == 0) scan_chain<ML, false>(ms, base, wbase, chain, st, m);
            else scan_chain<ML, true>(ms, base, wbase, chain, st, m);
        } else if (ML) {
            const int idx = it - NV, chain = idx >> 7, dk = idx & 127, d = chain & 1;
            float n = 0.f, m = NEG_BIG;
            for (int step = 0; step < 32; ++step) {
                const int c = d ? 31 - step : step;
                const float g = ms[MS_GM + (chain * 32 + c) * 2], ml = ms[MS_GM + (chain * 32 + c) * 2 + 1]; const float mn = fmaxf(g + m, ml);
                const float decay = __expf(g + m - mn), scale = __expf(ml - mn);
                float* up = ms + MS_U + (size_t)(chain * 32 + c) * 128 + dk; const float u = *up; *up = n;
                if (dk == 0) ms[MS_MP + chain * 32 + c] = m;
                n = decay * n + scale * u; m = mn;
            }
        }
    }
}

__device__ __forceinline__ void phase_ml_out(ArgsRef a, ldsp lds, int dry = 0) {
    const int tid_ = launder((int)threadIdx.x), lane = tid_ & 63, wave = __builtin_amdgcn_readfirstlane(tid_ >> 6), G = gridDim.x;
    const int fr_ = lane & 15, fq_ = lane >> 4;
    const bf16_t* Qb = (const bf16_t*)(a.ws + WS_Q); const bf16_t* Kb = (const bf16_t*)(a.ws + WS_K); const bf16_t* Vb = (const bf16_t*)(a.ws + WS_V);
    bf16_t* OZ = (bf16_t*)(a.ws + WS_OZ);
    const float* gates = (const float*)(a.ws + WS_GATES); const float* ms = (const float*)(a.ws + WS_MSTAT);
    const bf16_t* ST = (const bf16_t*)a.out;
    ldsp Qt = lds, Kt = lds + 36864, Xt = lds + 73728;
    LAS float* vec = (LAS float*)(lds + 147456);
    LAS float* npv = vec + 1280;
    LAS float* nwl = npv + 256;
    for (int i = tid_; i < 1024; i += 512) nwl[i] = a.in[I_MLNW][i];
    u32x4 pre[8];
    auto issue_qk = [&](int item) {
        const int c = item % NC, h = (item / NC) % 4, b = item / (NC * 4); const int row0 = b * SEQ + c * CH; const int tl = launder(tid_);
#pragma unroll
        for (int i = 0; i < 4; ++i) { const int id = tl + 512 * i, r = id >> 4, ch = id & 15;
            pre[i] = *(const u32x4*)(Qb + (size_t)(row0 + r) * 512 + h * 128 + ch * 8); pre[4 + i] = *(const u32x4*)(Kb + (size_t)(row0 + r) * 512 + h * 128 + ch * 8); }
    };
    if ((int)blockIdx.x < BATCH * 4 * NC) issue_qk(blockIdx.x);
    for (int item = blockIdx.x; item < BATCH * 4 * NC; item += G) {
        const int c = item % NC, h = (item / NC) % 4, b = item / (NC * 4); const int row0 = b * SEQ + c * CH;
        const int chain0 = (b * 4 + h) * 2;
        const int fr = launder(fr_), fq = launder(fq_), g4 = fq, q4 = fr >> 2, p4 = fr & 3;
        const int tid = launder(tid_);
        TSEG_BEGIN(1); TSEG_BEGIN(9);
#pragma unroll
        for (int i = 0; i < 4; ++i) { const int id = tid + 512 * i, r = id >> 4, ch = id & 15;
            *(LAS u32x4*)(Qt + r * P128R + ch * 16) = pre[i]; *(LAS u32x4*)(Kt + r * P128R + ch * 16) = pre[4 + i]; }
#pragma unroll
        for (int i = 0; i < 8; ++i) { const int id = tid + 512 * i, r = id >> 5, ch = id & 31; pre[i] = *(const u32x4*)(Vb + (size_t)(row0 + r) * 1024 + h * 256 + ch * 8); }
        { const bf16_t* cp = ST + (size_t)((chain0 + 0) * 32 + c) * 32768;
#pragma unroll
          for (int i = 0; i < 8; ++i) { const int id = tid + 512 * i, r = id >> 4, ch = id & 15;
              *(LAS u32x4*)(Xt + r * P128R + ch * 16) = *(const u32x4*)(cp + (size_t)r * 128 + ch * 8); } }
        if (wave < 2) {
            const int d = wave; const MlVec v = ml_chunk_vec(gates, row0, d, h, a.in[I_MLIB][d * 4 + h], a.in[I_MLFB][d * 4 + h], lane);
            const float mp = ms[MS_MP + (chain0 + d) * 32 + c];
            const float cm1 = fmaxf(v.colw[0], v.colw[1]); const float sc = wave_scan_max(cm1, lane); float ex = dpp_f<0x138>(sc); if (lane == 0) ex = NEG_BIG;
            const float cmax[2] = {fmaxf(ex, v.colw[0]), sc};
#pragma unroll
            for (int j = 0; j < 2; ++j) { const int u = 2 * lane + j, t = d ? 127 - u : u; const float ro = fmaxf(mp, cmax[j]);
                LAS float* vd = vec + d * 640;
                vd[t] = v.colw[j]; vd[128 + t] = ro; vd[256 + t] = __expf(mp - ro); vd[384 + t] = __expf(-(v.bb[j] + ro)); }
        } else if (wave < 6) {
            const int i2 = tid - 128; const int d = i2 >> 7, dk = i2 & 127; npv[d * 128 + dk] = ms[MS_U + (size_t)((chain0 + d) * 32 + c) * 128 + dk];
        }
        LDS_BARRIER();
        TSEG_END(1); TSEG_BEGIN(2);
        if (dry == 2) { LDS_BARRIER(); continue; }

        { const int pr = tid >> 1, part = tid & 1, d = pr >> 7, t = pr & 127; float s = 0.f;
          for (int k = 0; k < 64; ++k) { const int dk = part * 64 + k; s += bf2f(*(const LAS short*)(Qt + t * P128R + dk * 2)) * npv[d * 128 + dk]; }
          s += dpp_f<0xB1>(s); if (part == 0) vec[d * 640 + 512 + t] = s; }
        f32x4 sacc[8];
#pragma unroll
        for (int i = 0; i < 8; ++i) sacc[i] = (f32x4){0.f, 0.f, 0.f, 0.f};
        bf16x8 qf[4];
#pragma unroll
        for (int ks = 0; ks < 4; ++ks) qf[ks] = *(const LAS bf16x8*)(Qt + (16 * wave + fr) * P128R + (32 * ks + 8 * fq) * 2);
#pragma unroll
        for (int ks = 0; ks < 4; ++ks)
#pragma unroll
            for (int i = 0; i < 8; ++i) { const bf16x8 kf = *(const LAS bf16x8*)(Kt + (16 * i + fr) * P128R + (32 * ks + 8 * fq) * 2);
                sacc[i] = __builtin_amdgcn_mfma_f32_16x16x32_bf16(kf, qf[ks], sacc[i], 0, 0, 0); }
        LDS_BARRIER();
        TSEG_END(2); TSEG_BEGIN(3);
        if (dry == 3) { asm volatile("" :: "v"(sacc[0]), "v"(sacc[1]), "v"(sacc[2]), "v"(sacc[3]), "v"(sacc[4]), "v"(sacc[5]), "v"(sacc[6]), "v"(sacc[7])); LDS_BARRIER(); continue; }
        const int t = 16 * wave + fr;
        const float rof = vec[128 + t], rob = vec[640 + 128 + t];
        float rsf = 0.f, rsb = 0.f;
#pragma unroll
        for (int i = 0; i < 8; ++i) {
            if (i < wave) { const f32x4 cwf = *(const LAS f32x4*)(vec + 16 * i + 4 * fq);
#pragma unroll
                for (int r = 0; r < 4; ++r) rsf += sacc[i][r] * __expf(cwf[r] - rof); }
            else if (i > wave) { const f32x4 cwb = *(const LAS f32x4*)(vec + 640 + 16 * i + 4 * fq);
#pragma unroll
                for (int r = 0; r < 4; ++r) rsb += sacc[i][r] * __expf(cwb[r] - rob); }
            else { const f32x4 cwf = *(const LAS f32x4*)(vec + 16 * i + 4 * fq), cwb = *(const LAS f32x4*)(vec + 640 + 16 * i + 4 * fq);
#pragma unroll
                for (int r = 0; r < 4; ++r) { const int s = 16 * i + 4 * fq + r; const float sv = sacc[i][r];
                    float ef = __expf(fminf(cwf[r] - rof, 0.f)), eb = __expf(fminf(cwb[r] - rob, 0.f));
                    ef = (s <= t) ? ef : 0.f; eb = (s >= t) ? eb : 0.f;
                    rsf += sv * ef; rsb += sv * eb; } }
        }
        rsf = fq_sum(rsf); rsb = fq_sum(rsb);
        const float iwf = vec[256 + t], iwb = vec[640 + 256 + t];
        const float denf = rsf + iwf * vec[512 + t], denb = rsb + iwb * vec[640 + 512 + t];
        const float rinvf = 1.f / fmaxf(fabsf(denf), vec[384 + t]), rinvb = 1.f / fmaxf(fabsf(denb), vec[640 + 384 + t]);
        const float cf = iwf * rinvf, cb = iwb * rinvb;
        asm volatile("" ::: "memory");
        { const int fq2 = launder(fq), t2 = launder(t);
#pragma unroll
        for (int i = 0; i < 8; ++i) { float pv[4];
            if (i < wave) { const f32x4 cwf = *(const LAS f32x4*)(vec + 16 * i + 4 * fq2);
#pragma unroll
                for (int r = 0; r < 4; ++r) pv[r] = sacc[i][r] * (__expf(cwf[r] - rof) * rinvf); }
            else if (i > wave) { const f32x4 cwb = *(const LAS f32x4*)(vec + 640 + 16 * i + 4 * fq2);
#pragma unroll
                for (int r = 0; r < 4; ++r) pv[r] = sacc[i][r] * (__expf(cwb[r] - rob) * rinvb); }
            else { const f32x4 cwf = *(const LAS f32x4*)(vec + 16 * i + 4 * fq2), cwb = *(const LAS f32x4*)(vec + 640 + 16 * i + 4 * fq2);
#pragma unroll
                for (int r = 0; r < 4; ++r) { const int s = 16 * i + 4 * fq2 + r;
                    float ef = __expf(fminf(cwf[r] - rof, 0.f)), eb = __expf(fminf(cwb[r] - rob, 0.f));
                    ef = (s <= t2) ? ef : 0.f; eb = (s >= t2) ? eb : 0.f;
                    pv[r] = sacc[i][r] * (ef * rinvf + eb * rinvb); } }
            u32x2 o; o.x = pk2(pv[0], pv[1]); o.y = pk2(pv[2], pv[3]);
            *(LAS u32x2*)(Kt + t2 * P128R + (16 * i + 4 * fq2) * 2) = o; } }
        asm volatile("" ::: "memory");
        f32x4 hacc[16];
#pragma unroll
        for (int n = 0; n < 16; ++n) hacc[n] = (f32x4){0.f, 0.f, 0.f, 0.f};
#pragma unroll
        for (int nh = 0; nh < 2; ++nh) {
#pragma unroll
            for (int ks = 0; ks < 4; ++ks)
#pragma unroll
                for (int n = 8 * nh; n < 8 * nh + 8; ++n) { const bf16x8 cfr = *(const LAS bf16x8*)(Xt + (16 * n + fr) * P128R + (32 * ks + 8 * fq) * 2);
                    hacc[n] = __builtin_amdgcn_mfma_f32_16x16x32_bf16(cfr, qf[ks], hacc[n], 0, 0, 0); }
            asm volatile("" ::: "memory");
        }
#pragma unroll
        for (int n = 0; n < 16; ++n) hacc[n] = hacc[n] * cf;
        LDS_BARRIER();
        TSEG_END(3); TSEG_BEGIN(4);
        if (dry == 4) {
#pragma unroll
            for (int n = 0; n < 16; ++n) asm volatile("" :: "v"(hacc[n]));
            continue; }
        { const bf16_t* cp = ST + (size_t)((chain0 + 1) * 32 + c) * 32768;
#pragma unroll
          for (int i = 0; i < 8; ++i) { const int id = tid + 512 * i, r = id >> 4, ch = id & 15;
              *(LAS u32x4*)(Xt + r * P128R + ch * 16) = *(const u32x4*)(cp + (size_t)r * 128 + ch * 8); } }
        LDS_BARRIER();
        TSEG_END(4); TSEG_BEGIN(5);
#pragma unroll
        for (int nh = 0; nh < 4; ++nh) {
            f32x4 tacc[4];
#pragma unroll
            for (int n = 0; n < 4; ++n) tacc[n] = (f32x4){0.f, 0.f, 0.f, 0.f};
#pragma unroll
            for (int ks = 0; ks < 4; ++ks)
#pragma unroll
                for (int n = 0; n < 4; ++n) { const bf16x8 cfr = *(const LAS bf16x8*)(Xt + (16 * (4 * nh + n) + fr) * P128R + (32 * ks + 8 * fq) * 2);
                    tacc[n] = __builtin_amdgcn_mfma_f32_16x16x32_bf16(cfr, qf[ks], tacc[n], 0, 0, 0); }
#pragma unroll
            for (int n = 0; n < 4; ++n) hacc[4 * nh + n] = hacc[4 * nh + n] + tacc[n] * cb;
            asm volatile("" ::: "memory");
        }
        LDS_BARRIER();
        TSEG_END(5); TSEG_BEGIN(6);
        if (dry == 5) {
#pragma unroll
            for (int n = 0; n < 16; ++n) asm volatile("" :: "v"(hacc[n]));
            continue; }
#pragma unroll
        for (int i = 0; i < 8; ++i) { const int id = tid + 512 * i, r = id >> 5, ch = id & 31; *(LAS u32x4*)(Xt + r * P256 + ch * 16) = pre[i]; }
        if (item + G < BATCH * 4 * NC) issue_qk(item + G);
        bf16_t* orow = OZ + (size_t)(row0 + t) * 2048 + h * 256;
        u32x2 ovv[16];
#pragma unroll
        for (int n = 0; n < 16; ++n) ovv[n] = *(const u32x2*)(orow + 16 * n + 4 * fq);
        LDS_BARRIER();
        TSEG_END(6); TSEG_BEGIN(7);
#pragma unroll
        for (int ks = 0; ks < 4; ++ks) {
            const bf16x8 pf = *(const LAS bf16x8*)(Kt + t * P128R + (32 * ks + 8 * fq) * 2);
#pragma unroll
            for (int n = 0; n < 16; ++n) { ldscp ad = Xt + (32 * ks + 8 * g4 + q4) * P256 + (16 * n + 4 * p4) * 2;
                const bf16x8 vf = cat8(vtr(ad), vtr(ad + 4 * P256));
                hacc[n] = __builtin_amdgcn_mfma_f32_16x16x32_bf16(vf, pf, hacc[n], 0, 0, 0); }
        }
        TSEG_END(7); TSEG_BEGIN(8);
        if (dry == 6) {
#pragma unroll
            for (int n = 0; n < 16; ++n) asm volatile("" :: "v"(hacc[n]));
            LDS_BARRIER(); continue; }
        float s1 = 0.f;
#pragma unroll
        for (int n = 0; n < 16; ++n) s1 += (hacc[n][0] + hacc[n][1]) + (hacc[n][2] + hacc[n][3]);
        s1 = fq_sum(s1);
        const float mu = s1 * (1.f / 256.f); float s2 = 0.f;
#pragma unroll
        for (int n = 0; n < 16; ++n) { const f32x4 dd = hacc[n] - mu; s2 += (dd[0] * dd[0] + dd[1] * dd[1]) + (dd[2] * dd[2] + dd[3] * dd[3]); }
        s2 = fq_sum(s2);
        const float rstd = 1.f / sqrtf(s2 * (1.f / 256.f) + LN_EPS);
        bf16_t* owr = dry ? (bf16_t*)(a.ws + WS_XB) + (size_t)(row0 + t) * 1024 + h * 256 : orow;
        const LAS float* nw = nwl + h * 256;
#pragma unroll
        for (int n = 0; n < 16; ++n) { const int dv = 16 * n + 4 * fq; const u32x2 ov = ovv[n]; const f32x4 w4 = *(const LAS f32x4*)(nw + dv);
            const float y0 = (hacc[n][0] - mu) * rstd * w4[0] * sigmoidf_(bflo(ov.x)), y1 = (hacc[n][1] - mu) * rstd * w4[1] * sigmoidf_(bfhi(ov.x));
            const float y2 = (hacc[n][2] - mu) * rstd * w4[2] * sigmoidf_(bflo(ov.y)), y3 = (hacc[n][3] - mu) * rstd * w4[3] * sigmoidf_(bfhi(ov.y));
            u32x2 o; o.x = pk2(y0, y1); o.y = pk2(y2, y3); if (dry == 7) asm volatile("" :: "v"(o)); else *(u32x2*)(owr + dv) = o; }
        LDS_BARRIER();
        TSEG_END(8); TSEG_END(9);
    }
}

__device__ __forceinline__ void ssd_conv_issue(ArgsRef a, int b, int c, int g, int want, u32x4 (&rows)[20]) {
    const int tid = launder((int)threadIdx.x), ch64 = tid & 63, strip = tid >> 6;
    int col; bool on;
    if (ch64 < 32) { col = 256 * g + 8 * ch64; on = want & 1; }
    else if (ch64 < 48) { col = 1024 + 128 * g + 8 * (ch64 - 32); on = want & 2; }
    else { col = 1536 + 128 * g + 8 * (ch64 - 48); on = want & 4; }
    if (!on) return;
    const bf16_t* X = (const bf16_t*)(a.ws + WS_XBC) + (size_t)b * SEQ * 2048 + col;
    const int t0 = c * CH + strip * 16;
#pragma unroll
    for (int j = 0; j < 20; ++j) { const int tt = t0 - 2 + j; const int tc = tt < 0 ? 0 : (tt >= SEQ ? SEQ - 1 : tt);
        const u32x4 v = *(const u32x4*)(X + (size_t)tc * 2048); rows[j] = (tt >= 0 && tt < SEQ) ? v : (u32x4){0u, 0u, 0u, 0u}; }
}
__device__ __forceinline__ void ssd_conv_finish(ArgsRef a, int g, ldsp Xt, ldsp Bt, ldsp Ct, int want, int pitchBC, const u32x4 (&rows)[20]) {
    const int tid = launder((int)threadIdx.x), ch64 = tid & 63, strip = tid >> 6;
    int col, pitch; ldsp dst; bool on;
    if (ch64 < 32) { col = 256 * g + 8 * ch64; dst = Xt + ch64 * 16; pitch = P256; on = want & 1; }
    else if (ch64 < 48) { col = 1024 + 128 * g + 8 * (ch64 - 32); dst = Bt + (ch64 - 32) * 16; pitch = pitchBC; on = want & 2; }
    else { col = 1536 + 128 * g + 8 * (ch64 - 48); dst = Ct + (ch64 - 48) * 16; pitch = pitchBC; on = want & 4; }
    if (!on) return;
    const float* cw = a.in[I_CONVW] + col; const float* cbp = a.in[I_CONVB] + col;
    f32x2 w2[5][4], bias2[4];
#pragma unroll
    for (int j = 0; j < 5; ++j) { const f32x4 w0 = *(const f32x4*)(cw + j * 2048), w1 = *(const f32x4*)(cw + j * 2048 + 4);
        w2[j][0] = (f32x2){w0[0], w0[1]}; w2[j][1] = (f32x2){w0[2], w0[3]}; w2[j][2] = (f32x2){w1[0], w1[1]}; w2[j][3] = (f32x2){w1[2], w1[3]}; }
    { const f32x4 b0 = *(const f32x4*)cbp, b1 = *(const f32x4*)(cbp + 4); bias2[0] = (f32x2){b0[0], b0[1]}; bias2[1] = (f32x2){b0[2], b0[3]}; bias2[2] = (f32x2){b1[0], b1[1]}; bias2[3] = (f32x2){b1[2], b1[3]}; }
#pragma unroll
    for (int r = 0; r < 16; ++r) {
        f32x2 o2[4];
#pragma unroll
        for (int e = 0; e < 4; ++e) o2[e] = bias2[e];
#pragma unroll
        for (int j = 0; j < 5; ++j) { const u32x4 v = rows[r + j];
            o2[0] += w2[j][0] * (f32x2){bflo(v.x), bfhi(v.x)}; o2[1] += w2[j][1] * (f32x2){bflo(v.y), bfhi(v.y)};
            o2[2] += w2[j][2] * (f32x2){bflo(v.z), bfhi(v.z)}; o2[3] += w2[j][3] * (f32x2){bflo(v.w), bfhi(v.w)}; }
        u32x4 pk;
#pragma unroll
        for (int e = 0; e < 4; ++e) { const f32x2 ng = o2[e] * -1.4426950408889634f; f32x2 ex; ex.x = __builtin_amdgcn_exp2f(ng.x); ex.y = __builtin_amdgcn_exp2f(ng.y);
            const f32x2 dn = ex + 1.0f; f32x2 rc; rc.x = __builtin_amdgcn_rcpf(dn.x); rc.y = __builtin_amdgcn_rcpf(dn.y); const f32x2 sv = o2[e] * rc;
            pk[e] = pk2(sv.x, sv.y); }
        *(LAS u32x4*)(dst + (strip * 16 + r) * pitch) = pk;
    }
}
__device__ __forceinline__ void ssd_conv_tiles(ArgsRef a, int b, int c, int g, ldsp Xt, ldsp Bt, ldsp Ct, int want, int pitchBC) {
    u32x4 rows[20];
    ssd_conv_issue(a, b, c, g, want, rows);
    ssd_conv_finish(a, g, Xt, Bt, Ct, want, pitchBC, rows);
}

struct SsVec { float dt[2], ac[2]; float tot; };
__device__ __forceinline__ SsVec ss_chunk_vec(const float (&graw)[2], float dtb, float A, int lane) {
    SsVec r; float da[2];
#pragma unroll
    for (int j = 0; j < 2; ++j) { r.dt[j] = softplusf_(graw[j] + dtb); da[j] = r.dt[j] * A; }
    const float loc1 = da[0] + da[1]; const float s = wave_scan_add(loc1, lane); const float ex = s - loc1;
    r.ac[0] = ex + da[0]; r.ac[1] = s; r.tot = rdlane_f(s, 63);
    return r;
}

__device__ __forceinline__ void phase_ssd_states(ArgsRef a, ldsp lds) {
    const int tid = launder((int)threadIdx.x), lane = tid & 63, wave = __builtin_amdgcn_readfirstlane(tid >> 6), G = gridDim.x;
    const float* gates = (const float*)(a.ws + WS_GATES); float* ms = (float*)(a.ws + WS_MSTAT);
    bf16_t* ST = (bf16_t*)a.out;
    ldsp Bt = lds, Xt = lds + 36864; LAS float* wv = (LAS float*)(lds + 106496);
    u32x4 rows[20]; float graw[2];
    auto issue_item = [&](int item) {
        const int g = item % 4, c = (item / 4) % NC, b = item / (4 * NC); const int row0 = b * SEQ + c * CH; const int d = wave & 1, h16 = 4 * g + (wave >> 1);
#pragma unroll
        for (int j = 0; j < 2; ++j) { const int u = 2 * lane + j, t = d ? 127 - u : u; graw[j] = gates[(size_t)(row0 + t) * 48 + 16 + d * 16 + h16]; }
        ssd_conv_issue(a, b, c, g, 3, rows);
    };
    if ((int)blockIdx.x < BATCH * NC * 4) issue_item(blockIdx.x);
    for (int item = blockIdx.x; item < BATCH * NC * 4; item += G) {
        const int g = item % 4, c = (item / 4) % NC, b = item / (4 * NC);
        const int hh = wave >> 1, d = wave & 1, h16 = 4 * g + hh;
        TSEG_BEGIN(38);
        ssd_conv_finish(a, g, Xt, Bt, Bt, 3, P128, rows);
        { const SsVec v = ss_chunk_vec(graw, a.in[I_DTB][d * 16 + h16], -__expf(a.in[I_ALOG][d * 16 + h16]), lane);
#pragma unroll
          for (int j = 0; j < 2; ++j) { const int u = 2 * lane + j, t = d ? 127 - u : u; wv[wave * 128 + t] = v.dt[j] * __expf(v.tot - v.ac[j]); }
          if (lane == 0) ms[MS_SD + ((b * 16 + h16) * 2 + d) * 32 + c] = __expf(v.tot); }
        LDS_BARRIER();
        if (item + G < BATCH * NC * 4) issue_item(item + G);
        TSEG_END(38); TSEG_BEGIN(39);
        { bf16_t* out = ST + (size_t)(((b * 16 + h16) * 2 + d) * 32 + c) * 8192;
          chunk_state_gemm(Bt, P128, Xt + 64 * hh * 2, P256, wv + wave * 128, out, lane); }
        LDS_BARRIER();
        TSEG_END(39);
    }
}

__device__ __forceinline__ void phase_ssd_out(ArgsRef a, ldsp lds, int dry = 0) {
    const int tid = launder((int)threadIdx.x), lane = tid & 63, wave = __builtin_amdgcn_readfirstlane(tid >> 6), G = gridDim.x;
    const int fr_ = lane & 15, fq_ = lane >> 4;
    const float* gates = (const float*)(a.ws + WS_GATES);
    bf16_t* OZ = (bf16_t*)(a.ws + WS_OZ); const bf16_t* ST = (const bf16_t*)a.out;
    ldsp Ct = lds, Bt = lds + 36864, Xt = lds + 73728;
    LAS float* vec = (LAS float*)(lds + 73728 + 69632);
    static_assert(73728 + 69632 + 8192 + 4096 <= MISC_OFF, "layout");
    LAS float* nwl = vec + 2048;
    for (int i = tid; i < 1024; i += 512) nwl[i] = a.in[I_SSMNW][i];
    for (int item = blockIdx.x; item < BATCH * NC * 4; item += G) {
        const int g = item % 4, c = (item / 4) % NC, b = item / (4 * NC); const int row0 = b * SEQ + c * CH;
        const int fr = launder(fr_), fq = launder(fq_), g4 = fq, q4 = fr >> 2, p4 = fr & 3;
        TSEG_BEGIN(11); TSEG_BEGIN(20);
        float graw[2];
        { const int hh = wave >> 1, d = wave & 1, h16 = 4 * g + hh;
#pragma unroll
          for (int j = 0; j < 2; ++j) { const int u = 2 * lane + j, t = d ? 127 - u : u; graw[j] = gates[(size_t)(row0 + t) * 48 + 16 + d * 16 + h16]; } }
        ssd_conv_tiles(a, b, c, g, Xt, Bt, Ct, 7, P128R);
        { const int hh = wave >> 1, d = wave & 1, h16 = 4 * g + hh;
          const SsVec v = ss_chunk_vec(graw, a.in[I_DTB][d * 16 + h16], -__expf(a.in[I_ALOG][d * 16 + h16]), lane);
#pragma unroll
          for (int j = 0; j < 2; ++j) { const int u = 2 * lane + j, t = d ? 127 - u : u; vec[wave * 256 + t] = v.ac[j]; vec[wave * 256 + 128 + t] = v.dt[j]; } }
        LDS_BARRIER();
        TSEG_END(11); TSEG_BEGIN(12);
        if (dry == 2) { LDS_BARRIER(); continue; }
        f32x4 cbv[8];
#pragma unroll
        for (int i = 0; i < 8; ++i) cbv[i] = (f32x4){0.f, 0.f, 0.f, 0.f};
        bf16x8 cf[4];
#pragma unroll
        for (int ks = 0; ks < 4; ++ks) cf[ks] = *(const LAS bf16x8*)(Ct + (16 * wave + fr) * P128R + (32 * ks + 8 * fq) * 2);
#pragma unroll
        for (int ks = 0; ks < 4; ++ks)
#pragma unroll
            for (int i = 0; i < 8; ++i) { const bf16x8 bfr = *(const LAS bf16x8*)(Bt + (16 * i + fr) * P128R + (32 * ks + 8 * fq) * 2);
                cbv[i] = __builtin_amdgcn_mfma_f32_16x16x32_bf16(bfr, cf[ks], cbv[i], 0, 0, 0); }
        LDS_BARRIER();
        TSEG_END(12); TSEG_BEGIN(13);
        if (dry == 3) { asm volatile("" :: "v"(cbv[0]), "v"(cbv[1]), "v"(cbv[2]), "v"(cbv[3]), "v"(cbv[4]), "v"(cbv[5]), "v"(cbv[6]), "v"(cbv[7])); continue; }
        const int t = 16 * wave + fr;
        ldsp Ht = Ct;
        u32x4 pre[4];
#pragma unroll
        for (int i = 0; i < 4; ++i) { const int id = tid + 512 * i, d = id >> 10, r = (id >> 4) & 63, ch = id & 15;
            pre[i] = *(const u32x4*)(ST + (size_t)(((b * 16 + 4 * g) * 2 + d) * 32 + c) * 8192 + r * 128 + ch * 8); }
        float s2 = 0.f;
        u32x2 ypk[4][4];
        bf16_t* yrow = dry ? (bf16_t*)(a.ws + WS_XB) + (size_t)(row0 + t) * 1024 + 256 * g : OZ + (size_t)(row0 + t) * 2048 + 1024 + 256 * g;
#pragma unroll
        for (int hh = 0; hh < 4; ++hh) {
            const int h16 = 4 * g + hh;
            TSEG_BEGIN(15);
#pragma unroll
            for (int i = 0; i < 4; ++i) { const int id = tid + 512 * i, d = id >> 10, r = (id >> 4) & 63, ch = id & 15;
                *(LAS u32x4*)(Ht + d * 18432 + r * P128R + ch * 16) = pre[i]; }
            LDS_BARRIER();
            TSEG_END(15); TSEG_BEGIN(16);
            if (hh < 3) {
#pragma unroll
                for (int i = 0; i < 4; ++i) { const int id = tid + 512 * i, d = id >> 10, r = (id >> 4) & 63, ch = id & 15;
                    pre[i] = *(const u32x4*)(ST + (size_t)(((b * 16 + h16 + 1) * 2 + d) * 32 + c) * 8192 + r * 128 + ch * 8); }
            }
            const bf16_t* zrow = OZ + (size_t)(row0 + t) * 2048 + 1024 + 256 * g + 64 * hh;
            u32x2 zpre[4];
#pragma unroll
            for (int n = 0; n < 4; ++n) zpre[n] = *(const u32x2*)(zrow + 16 * n + 4 * fq);
            f32x4 y[4];
            if (dry == 5) {
#pragma unroll
                for (int n = 0; n < 4; ++n) y[n] = (f32x4){0.f, 0.f, 0.f, 0.f};
            } else {
                f32x4 yf[4], yb[4];
#pragma unroll
                for (int n = 0; n < 4; ++n) { yf[n] = (f32x4){0.f, 0.f, 0.f, 0.f}; yb[n] = (f32x4){0.f, 0.f, 0.f, 0.f}; }
#pragma unroll
                for (int ks = 0; ks < 4; ++ks)
#pragma unroll
                    for (int n = 0; n < 4; ++n) {
                        const bf16x8 h0 = *(const LAS bf16x8*)(Ht + (16 * n + fr) * P128R + (32 * ks + 8 * fq) * 2);
                        const bf16x8 h1 = *(const LAS bf16x8*)(Ht + 18432 + (16 * n + fr) * P128R + (32 * ks + 8 * fq) * 2);
                        yf[n] = __builtin_amdgcn_mfma_f32_16x16x32_bf16(h0, cf[ks], yf[n], 0, 0, 0);
                        yb[n] = __builtin_amdgcn_mfma_f32_16x16x32_bf16(h1, cf[ks], yb[n], 0, 0, 0); }
                const float ef = __expf(vec[(hh * 2 + 0) * 256 + t]), eb = __expf(vec[(hh * 2 + 1) * 256 + t]);
#pragma unroll
                for (int n = 0; n < 4; ++n) y[n] = yf[n] * ef + yb[n] * eb;
            }
            TSEG_END(16); TSEG_BEGIN(17);
            if (dry != 4) {
            { const int fq2 = launder(fq), t2 = launder(t);
              const float af = vec[(hh * 2 + 0) * 256 + t2], ab = vec[(hh * 2 + 1) * 256 + t2];
#pragma unroll
              for (int i = 0; i < 8; ++i) { float pv[4]; const LAS float* vb = vec + hh * 512 + 16 * i + 4 * fq2;
                  if (i < wave) { const f32x4 acf = *(const LAS f32x4*)(vb), dtf = *(const LAS f32x4*)(vb + 128);
#pragma unroll
                      for (int r = 0; r < 4; ++r) pv[r] = cbv[i][r] * (__expf(af - acf[r]) * dtf[r]); }
                  else if (i > wave) { const f32x4 acb = *(const LAS f32x4*)(vb + 256), dtb = *(const LAS f32x4*)(vb + 384);
#pragma unroll
                      for (int r = 0; r < 4; ++r) pv[r] = cbv[i][r] * (__expf(ab - acb[r]) * dtb[r]); }
                  else { const f32x4 acf = *(const LAS f32x4*)(vb), dtf = *(const LAS f32x4*)(vb + 128), acb = *(const LAS f32x4*)(vb + 256), dtb = *(const LAS f32x4*)(vb + 384);
#pragma unroll
                      for (int r = 0; r < 4; ++r) { const int s = 16 * i + 4 * fq2 + r;
                          float lf = __expf(fminf(af - acf[r], 0.f)) * dtf[r], lb = __expf(fminf(ab - acb[r], 0.f)) * dtb[r];
                          lf = (s <= t2) ? lf : 0.f; lb = (s >= t2) ? lb : 0.f;
                          pv[r] = cbv[i][r] * (lf + lb); } }
                  u32x2 o; o.x = pk2(pv[0], pv[1]); o.y = pk2(pv[2], pv[3]);
                  *(LAS u32x2*)(Bt + t2 * P128R + (16 * i + 4 * fq2) * 2) = o; } }
            asm volatile("s_waitcnt lgkmcnt(0)" ::: "memory");
            TSEG_END(17); TSEG_BEGIN(18);
#pragma unroll
            for (int ks = 0; ks < 4; ++ks) {
                const bf16x8 pf = *(const LAS bf16x8*)(Bt + t * P128R + (32 * ks + 8 * fq) * 2);
#pragma unroll
                for (int n = 0; n < 4; ++n) { ldscp ad = Xt + (32 * ks + 8 * g4 + q4) * P256 + (64 * hh + 16 * n + 4 * p4) * 2;
                    const bf16x8 xf = cat8(vtr(ad), vtr(ad + 4 * P256));
                    y[n] = __builtin_amdgcn_mfma_f32_16x16x32_bf16(xf, pf, y[n], 0, 0, 0); }
            }
            }
            TSEG_END(18); TSEG_BEGIN(19);
            { const float dsk = a.in[I_DSKIP][h16];
#pragma unroll
              for (int n = 0; n < 4; ++n) { const int p = 16 * n + 4 * fq;
                  const u32x2 xv = *(const LAS u32x2*)(Xt + t * P256 + (64 * hh + p) * 2); const u32x2 zv = zpre[n];
                  f32x4 o;
                  o[0] = (y[n][0] + dsk * bflo(xv.x)) * siluf_(bflo(zv.x)); o[1] = (y[n][1] + dsk * bfhi(xv.x)) * siluf_(bfhi(zv.x));
                  o[2] = (y[n][2] + dsk * bflo(xv.y)) * siluf_(bflo(zv.y)); o[3] = (y[n][3] + dsk * bfhi(xv.y)) * siluf_(bfhi(zv.y));
                  s2 += (o[0] * o[0] + o[1] * o[1]) + (o[2] * o[2] + o[3] * o[3]);
                  u32x2 ow; ow.x = pk2(o[0], o[1]); ow.y = pk2(o[2], o[3]); ypk[hh][n] = ow; } }
            LDS_BARRIER();
            TSEG_END(19);
        }
        TSEG_END(13); TSEG_BEGIN(14);
        s2 = fq_sum(s2);
        const float rs = 1.f / sqrtf(s2 * (1.f / 256.f) + RMS_EPS);
        const LAS float* nw = nwl + 256 * g;
#pragma unroll
        for (int hn = 0; hn < 16; ++hn) { const int ch = 16 * hn + 4 * fq; const f32x4 w4 = *(const LAS f32x4*)(nw + ch); const u32x2 yv = ypk[hn >> 2][hn & 3];
            u32x2 o; o.x = pk2(bflo(yv.x) * rs * w4[0], bfhi(yv.x) * rs * w4[1]); o.y = pk2(bflo(yv.y) * rs * w4[2], bfhi(yv.y) * rs * w4[3]); *(u32x2*)(yrow + ch) = o; }
        LDS_BARRIER();
        TSEG_END(14); TSEG_END(20);
    }
}

__device__ __forceinline__ void phase_ln1_router(ArgsRef a, ldsp lds) {
    const int tid = launder((int)threadIdx.x), lane = tid & 63, wave = __builtin_amdgcn_readfirstlane(tid >> 6), G = gridDim.x;
    const int gw = blockIdx.x * 8 + wave, NGW = G * 8;
    TSEG_BEGIN(31);
    {
        LAS float* scr = (LAS float*)(lds + 81920 + wave * 8448);
        bf16_t* W1T = (bf16_t*)(a.ws + WS_W1T); bf16_t* W2T = (bf16_t*)(a.ws + WS_W2T);
        for (int it = gw; it < 65 * 384; it += NGW) {
            const int e = it / 384, r = it % 384;
            const float* wg = e < 64 ? a.in[I_WEG] + (size_t)e * DM * DE : a.in[I_WSG];
            const float* wu = e < 64 ? a.in[I_WEU] + (size_t)e * DM * DE : a.in[I_WSU];
            const float* wd = e < 64 ? a.in[I_WED] + (size_t)e * DE * DM : a.in[I_WSD];
            if (r < 256) { const int up = r >> 7, q = r & 127, cb = q & 7, kb = q >> 3;
                transpose_item(up ? wu : wg, DE, kb * 64, cb * 32, W1T + (size_t)e * 512 * DM, DM, 256 * (cb >> 2) + 32 * (cb & 3) + 128 * up, 1.f, scr, lane); }
            else { const int q = r - 256, cb = q & 31, kb = q >> 5;
                transpose_item(wd, DM, kb * 64, cb * 32, W2T + (size_t)e * DM * DE, DE, cb * 32, 1.f, scr, lane); }
        }
    }
    LDS_BARRIER();
    TSEG_END(31);
    const bf16_t* r1 = (const bf16_t*)a.out; bf16_t* H = (bf16_t*)(a.ws + WS_H);
    int* sele = (int*)(a.ws + WS_SELE); float* selw = (float*)(a.ws + WS_SELW);
    unsigned* ctl = (unsigned*)(a.ws + WS_CTL);
    constexpr int WPT = 160;
    ldsp Whi = lds, Wlo = lds + 40960;
    LAS float* lg = (LAS float*)(lds + 81920);
    LAS unsigned* cnt = (LAS unsigned*)(lds + 81920 + 33280);
    const float* g1 = a.in[I_LN1G]; const float* b1 = a.in[I_LN1B]; const float* wr = a.in[I_WR];
    const int fr = lane & 15, fq = lane >> 4, q4 = fr >> 2, p4 = fr & 3;
    for (int vb = blockIdx.x; vb < 256; vb += G) {
        const int tok0 = vb * 128;
        if (tid < 64) cnt[tid] = 0u;
        TSEG_BEGIN(32);
        f32x4 ggv[4], bbv[4];
#pragma unroll
        for (int j = 0; j < 4; ++j) { ggv[j] = *((const f32x4*)g1 + lane + 64 * j); bbv[j] = *((const f32x4*)b1 + lane + 64 * j); }
        for (int rr = 0; rr < 16; rr += 4) {
            f32x4 v[4][4];
#pragma unroll
            for (int q = 0; q < 4; ++q) { const u32x2* xr = (const u32x2*)(r1 + (size_t)(tok0 + 16 * wave + rr + q) * DM) + lane;
#pragma unroll
                for (int j = 0; j < 4; ++j) { const u32x2 w = xr[64 * j]; v[q][j] = (f32x4){bflo(w.x), bfhi(w.x), bflo(w.y), bfhi(w.y)}; } }
#pragma unroll
            for (int q = 0; q < 4; ++q) {
                const int t = tok0 + 16 * wave + rr + q; float s = 0.f;
#pragma unroll
                for (int j = 0; j < 4; ++j) s += (v[q][j].x + v[q][j].y) + (v[q][j].z + v[q][j].w);
                const float mean = wave_sum(s) * (1.f / DM); float s2 = 0.f;
#pragma unroll
                for (int j = 0; j < 4; ++j) { v[q][j] = v[q][j] - mean; s2 += (v[q][j].x * v[q][j].x + v[q][j].y * v[q][j].y) + (v[q][j].z * v[q][j].z + v[q][j].w * v[q][j].w); }
                const float rstd = __builtin_amdgcn_rsqf(wave_sum(s2) * (1.f / DM) + LN_EPS);
                unsigned long long* o8 = (unsigned long long*)(H + (size_t)t * DM) + lane;
#pragma unroll
                for (int j = 0; j < 4; ++j) { const f32x4 hv = v[q][j] * rstd * ggv[j] + bbv[j];
                    o8[64 * j] = (unsigned long long)pk2(hv.x, hv.y) | ((unsigned long long)pk2(hv.z, hv.w) << 32); }
            }
        }
        asm volatile("s_waitcnt vmcnt(0)" ::: "memory");
        TSEG_END(32); TSEG_BEGIN(33);
        f32x4 lacc[4];
#pragma unroll
        for (int nt = 0; nt < 4; ++nt) lacc[nt] = (f32x4){0.f, 0.f, 0.f, 0.f};
        f32x4 pw[8];
#pragma unroll
        for (int i = 0; i < 8; ++i) pw[i] = *(const f32x4*)(wr + (size_t)(tid + 512 * i) * 4);
        const bf16_t* hrow = H + (size_t)(tok0 + 16 * wave + fr) * DM + 8 * fq;
#pragma unroll 1
        for (int kc = 0; kc < 4; ++kc) {
#pragma unroll
            for (int i = 0; i < 8; ++i) { const int id = tid + 512 * i, k = id >> 4, e4 = (id & 15) * 4; const f32x4 w = pw[i];
                u32x2 hi; hi.x = pk2(w[0], w[1]); hi.y = pk2(w[2], w[3]);
                u32x2 lo; lo.x = pk2(w[0] - bflo(hi.x), w[1] - bfhi(hi.x)); lo.y = pk2(w[2] - bflo(hi.y), w[3] - bfhi(hi.y));
                *(LAS u32x2*)(Whi + k * WPT + e4 * 2) = hi; *(LAS u32x2*)(Wlo + k * WPT + e4 * 2) = lo; }
            if (kc < 3) {
#pragma unroll
                for (int i = 0; i < 8; ++i) pw[i] = *(const f32x4*)(wr + (size_t)(kc + 1) * 256 * NE + (size_t)(tid + 512 * i) * 4);
            }
            bf16x8 af[8];
#pragma unroll
            for (int ks = 0; ks < 8; ++ks) af[ks] = *(const bf16x8*)(hrow + 256 * kc + 32 * ks);
            LDS_BARRIER();
#pragma unroll
            for (int ks = 0; ks < 8; ++ks)
#pragma unroll
                for (int nt = 0; nt < 4; ++nt) { const int off = (32 * ks + 8 * fq + q4) * WPT + (16 * nt + 4 * p4) * 2;
                    const bf16x8 wh = cat8(vtr(Whi + off), vtr(Whi + off + 4 * WPT)), wl = cat8(vtr(Wlo + off), vtr(Wlo + off + 4 * WPT));
                    lacc[nt] = __builtin_amdgcn_mfma_f32_16x16x32_bf16(af[ks], wh, lacc[nt], 0, 0, 0);
                    lacc[nt] = __builtin_amdgcn_mfma_f32_16x16x32_bf16(af[ks], wl, lacc[nt], 0, 0, 0); }
            LDS_BARRIER();
        }
#pragma unroll
        for (int nt = 0; nt < 4; ++nt)
#pragma unroll
            for (int r = 0; r < 4; ++r) lg[(16 * wave + 4 * fq + r) * 65 + 16 * nt + fr] = lacc[nt][r];
        asm volatile("s_waitcnt lgkmcnt(0)" ::: "memory");
        TSEG_END(33); TSEG_BEGIN(34);
        const float rb = a.in[I_RB][lane]; unsigned mycnt = 0u;
        for (int rr = 0; rr < 16; ++rr) {
            const int row = 16 * wave + rr; const int t = tok0 + row;
            const float score = sigmoidf_(lg[row * 65 + lane]); const float choice = score + rb;
            const float m1 = group8_max(choice);
            const unsigned long long eq = __ballot(choice == m1); const int gbase = lane & ~7;
            const unsigned gm = (unsigned)(eq >> gbase) & 0xffu; const int first = gbase + __builtin_ctz(gm);
            const float m2 = group8_max((lane == first) ? -INFINITY : choice);
            const float gs = m1 + m2; const int grp = lane >> 3;
            int grank = 0;
#pragma unroll
            for (int g2 = 0; g2 < 8; ++g2) { const float og = rdlane_f(gs, 8 * g2); grank += (og > gs || (og == gs && g2 < grp)) ? 1 : 0; }
            float curv = (grank < 4) ? choice : -INFINITY; int rank = -1;
#pragma unroll
            for (int r = 0; r < TOPK; ++r) { const float mx = wave_max(curv); const unsigned long long bal = __ballot(curv == mx);
                const int win = __builtin_ctzll(bal); if (lane == win) { rank = r; curv = -INFINITY; } }
            const bool sel = rank >= 0;
            const float wsum = wave_sum(sel ? score : 0.f);
            if (sel) { sele[t * 8 + rank] = lane; selw[t * 8 + rank] = score / wsum * 2.5f; mycnt++; }
        }
        TSEG_END(34);
        if (mycnt) atomicAdd((unsigned*)&cnt[lane], mycnt);
        LDS_BARRIER();
        if (tid < 64) ctl[CW_BLOCKCNT + vb * 64 + tid] = cnt[tid];
        LDS_BARRIER();
    }
}

__device__ __forceinline__ void phase_lists(ArgsRef a, ldsp lds) {
    const int tid = launder((int)threadIdx.x), lane = tid & 63, wave = __builtin_amdgcn_readfirstlane(tid >> 6), G = gridDim.x;
    const unsigned* ctl = (const unsigned*)(a.ws + WS_CTL); unsigned* ctlw = (unsigned*)(a.ws + WS_CTL);
    const int* sele = (const int*)(a.ws + WS_SELE); const float* selw = (const float*)(a.ws + WS_SELW);
    int* tokpos = (int*)(a.ws + WS_TOKPOS);
    LAS unsigned* part = (LAS unsigned*)lds;
    LAS unsigned* pre = part + 1024;
    LAS unsigned* cntp = pre + 64;
    LAS unsigned* pstart = cntp + 64;
    LAS unsigned* cstart = pstart + 64;
    LAS unsigned* lcnt = cstart + 64;
    for (int vb = blockIdx.x; vb < 256; vb += G) {
        const int p = vb < PASS_VB0[1] ? 0 : (vb < PASS_VB0[2] ? 1 : 2); const int vb0 = PASS_VB0[p], vb1 = PASS_VB0[p + 1];
        int* rowtok = (int*)(a.ws + WS_ROWTOK) + p * PASS_MAXROWS; float* rowgate = (float*)(a.ws + WS_ROWGATE) + p * PASS_MAXROWS;
        int* rowy = (int*)(a.ws + WS_ROWY) + p * PASS_MAXROWS; int* tilee = (int*)(a.ws + WS_TILEE) + p * PASS_MAXTILES;
        { const int e = tid & 63, pt = tid >> 6; unsigned tot = 0u, bel = 0u;
          for (int v2 = vb0 + pt; v2 < vb1; v2 += 8) { const unsigned cv = ctl[CW_BLOCKCNT + v2 * 64 + e]; tot += cv; if (v2 < vb) bel += cv; }
          part[(pt * 64 + e) * 2] = tot; part[(pt * 64 + e) * 2 + 1] = bel; }
        BLOCK_SYNC();
        if (tid < 64) { unsigned tot = 0u, bel = 0u;
#pragma unroll
            for (int pt = 0; pt < 8; ++pt) { tot += part[(pt * 64 + tid) * 2]; bel += part[(pt * 64 + tid) * 2 + 1]; }
            const unsigned pad = (tot + 255u) & ~255u;
            unsigned ps = pad, cs = tot;
#pragma unroll
            for (int o = 1; o < 64; o <<= 1) { const unsigned t1 = __shfl_up(ps, o), t2 = __shfl_up(cs, o); if (lane >= o) { ps += t1; cs += t2; } }
            const unsigned sh = (p == 0) ? (unsigned)T : 0u;
            pre[tid] = bel; cntp[tid] = tot; pstart[tid] = sh + ps - pad; cstart[tid] = cs - tot; lcnt[tid] = 0u;
            if (vb == vb0 && tid == 63) ctlw[CW_NTILES + p] = (sh + ps) >> 8; }
        BLOCK_SYNC();
#pragma unroll
        for (int i = 0; i < 2; ++i) { const int sidx = tid + 512 * i, tl = sidx >> 3, k = sidx & 7; const int t = vb * 128 + tl;
            const int e = sele[t * 8 + k]; const float w = selw[t * 8 + k];
            const unsigned rank = pre[e] + atomicAdd((unsigned*)&lcnt[e], 1u);
            const unsigned prow = pstart[e] + rank, yrow = cstart[e] + rank + 1u;
            rowtok[prow] = t; rowgate[prow] = w; rowy[prow] = (int)yrow; tokpos[t * 8 + k] = (int)yrow; }
        if (vb == vb0) {
            for (int e = wave; e < 64; e += 8) { const unsigned c0 = cntp[e], ps = pstart[e], pad = (c0 + 255u) & ~255u;
                for (unsigned r = c0 + lane; r < pad; r += 64) { rowtok[ps + r] = vb0 * 128; rowgate[ps + r] = 0.f; rowy[ps + r] = 0; }
                for (unsigned tl = lane; tl < (pad >> 8); tl += 64) tilee[(ps >> 8) + tl] = e; }
            if (p == 0) for (int tl = tid; tl < T / 256; tl += 512) tilee[tl] = 64;
        }
        if (tid < 128) { const int t = vb * 128 + tid; int* rt0 = (int*)(a.ws + WS_ROWTOK); float* rg0 = (float*)(a.ws + WS_ROWGATE); int* ry0 = (int*)(a.ws + WS_ROWY);
            rt0[t] = t; rg0[t] = 1.f; ry0[t] = YS_ROW0 + t; }
        BLOCK_SYNC();
    }
}

__device__ __forceinline__ void moe_gemm1(ArgsRef a, ldsp lds, int p) {
    const unsigned* ctl = (const unsigned*)(a.ws + WS_CTL);
    const int ntile = (int)ctl[CW_NTILES + p];
    pg8::Gemm g{(const bf16_t*)(a.ws + WS_H), (const bf16_t*)(a.ws + WS_W1T), 0, 512, DM, (size_t)512 * DM * 2, (const int*)(a.ws + WS_ROWTOK) + p * PASS_MAXROWS};
    pg8::MoeOrder<2, true> S{ntile, (int)gridDim.x, (int)blockIdx.x, 0, (const int*)(a.ws + WS_TILEE) + p * PASS_MAXTILES};
    pg8::EpiSwiGLU E{(bf16_t*)(a.ws + WS_ACT)};
    pg8::gemm_phase<pg8::EpiSwiGLU, pg8::MoeOrder<2, true>, true>(lds, g, S, E);
}
__device__ __forceinline__ void moe_gemm2(ArgsRef a, ldsp lds, int p) {
    const unsigned* ctl = (const unsigned*)(a.ws + WS_CTL);
    const int ntile = (int)ctl[CW_NTILES + p];
    pg8::Gemm g{(const bf16_t*)(a.ws + WS_ACT), (const bf16_t*)(a.ws + WS_W2T), 0, DM, DE, (size_t)DM * DE * 2, nullptr};
    pg8::MoeOrder<4, true> S{ntile, (int)gridDim.x, (int)blockIdx.x, 0, (const int*)(a.ws + WS_TILEE) + p * PASS_MAXTILES};
    pg8::EpiDownY E{(unsigned char*)(a.ws + WS_Y), (const int*)(a.ws + WS_ROWY) + p * PASS_MAXROWS, (const float*)(a.ws + WS_ROWGATE) + p * PASS_MAXROWS};
    pg8::gemm_phase<pg8::EpiDownY, pg8::MoeOrder<4, true>, false>(lds, g, S, E);
}
__device__ __forceinline__ void moe_combine(ArgsRef a, int p) {
    const int tid = launder((int)threadIdx.x), lane_ = tid & 63, wave = tid >> 6, G = gridDim.x;
    const bf16_t* H = (const bf16_t*)(a.ws + WS_H); const unsigned char* Y = (const unsigned char*)(a.ws + WS_Y); const int* tokpos = (const int*)(a.ws + WS_TOKPOS);
    const float* g2 = a.in[I_LN2G]; const float* b2 = a.in[I_LN2B];
    const int t0 = PASS_VB0[p] * 128, t1 = PASS_VB0[p + 1] * 128;
    for (int tb = t0 + (blockIdx.x * 8 + wave) * 2; tb < t1; tb += G * 16) {
        const int lane = launder(lane_);
        int yr[2][8]; u32x4 hv[2][2]; u32x2 sv[2][2];
#pragma unroll
        for (int u = 0; u < 2; ++u) { const int t = tb + u;
#pragma unroll
            for (int k = 0; k < 8; ++k) yr[u][k] = tokpos[t * 8 + k];
#pragma unroll
            for (int j = 0; j < 2; ++j) { const int c = 8 * lane + 512 * j; hv[u][j] = *(const u32x4*)(H + (size_t)t * DM + c); sv[u][j] = *(const u32x2*)(Y + (size_t)(YS_ROW0 + t) * DM + c); } }
        f32x4 gav[2], gbv[2], bav[2], bbv[2];
#pragma unroll
        for (int j = 0; j < 2; ++j) { const int c = 8 * lane + 512 * j; gav[j] = *(const f32x4*)(g2 + c); gbv[j] = *(const f32x4*)(g2 + c + 4); bav[j] = *(const f32x4*)(b2 + c); bbv[j] = *(const f32x4*)(b2 + c + 4); }
        u32x2 yv[2][8][2];
#pragma unroll
        for (int u = 0; u < 2; ++u)
#pragma unroll
            for (int k = 0; k < 8; ++k)
#pragma unroll
                for (int j = 0; j < 2; ++j) yv[u][k][j] = *(const u32x2*)(Y + (size_t)yr[u][k] * DM + 8 * lane + 512 * j);
#pragma unroll
        for (int u = 0; u < 2; ++u) { const int t = tb + u;
            float v[2][8];
#pragma unroll
            for (int j = 0; j < 2; ++j) { f32x2 q[4];
                { const u32x2 s4 = sv[u][j]; q[0] = __builtin_amdgcn_cvt_pk_f32_fp8((int)s4.x, false); q[1] = __builtin_amdgcn_cvt_pk_f32_fp8((int)s4.x, true);
                  q[2] = __builtin_amdgcn_cvt_pk_f32_fp8((int)s4.y, false); q[3] = __builtin_amdgcn_cvt_pk_f32_fp8((int)s4.y, true); }
#pragma unroll
                for (int k = 0; k < 8; ++k) { const u32x2 y4 = yv[u][k][j];
                    q[0] += __builtin_amdgcn_cvt_pk_f32_fp8((int)y4.x, false); q[1] += __builtin_amdgcn_cvt_pk_f32_fp8((int)y4.x, true);
                    q[2] += __builtin_amdgcn_cvt_pk_f32_fp8((int)y4.y, false); q[3] += __builtin_amdgcn_cvt_pk_f32_fp8((int)y4.y, true); }
                const u32x4 h4 = hv[u][j]; constexpr float IS = 1.f / 64.f;
                v[j][0] = q[0].x * IS + ALPHA * bflo(h4.x); v[j][1] = q[0].y * IS + ALPHA * bfhi(h4.x); v[j][2] = q[1].x * IS + ALPHA * bflo(h4.y); v[j][3] = q[1].y * IS + ALPHA * bfhi(h4.y);
                v[j][4] = q[2].x * IS + ALPHA * bflo(h4.z); v[j][5] = q[2].y * IS + ALPHA * bfhi(h4.z); v[j][6] = q[3].x * IS + ALPHA * bflo(h4.w); v[j][7] = q[3].y * IS + ALPHA * bfhi(h4.w); }
            float s = 0.f;
#pragma unroll
            for (int j = 0; j < 2; ++j)
#pragma unroll
                for (int e = 0; e < 8; ++e) s += v[j][e];
            const float mean = wave_sum(s) * (1.f / DM); float s2 = 0.f;
#pragma unroll
            for (int j = 0; j < 2; ++j)
#pragma unroll
                for (int e = 0; e < 8; ++e) { v[j][e] -= mean; s2 += v[j][e] * v[j][e]; }
            const float rstd = __builtin_amdgcn_rsqf(wave_sum(s2) * (1.f / DM) + LN_EPS);
#pragma unroll
            for (int j = 0; j < 2; ++j) { const int c = 8 * lane + 512 * j;
                const f32x4 ga = gav[j], gb = gbv[j], ba = bav[j], bb = bbv[j];
                f32x4 o0, o1;
                o0[0] = v[j][0] * rstd * ga[0] + ba[0]; o0[1] = v[j][1] * rstd * ga[1] + ba[1]; o0[2] = v[j][2] * rstd * ga[2] + ba[2]; o0[3] = v[j][3] * rstd * ga[3] + ba[3];
                o1[0] = v[j][4] * rstd * gb[0] + bb[0]; o1[1] = v[j][5] * rstd * gb[1] + bb[1]; o1[2] = v[j][6] * rstd * gb[2] + bb[2]; o1[3] = v[j][7] * rstd * gb[3] + bb[3];
                *(f32x4*)(a.out + (size_t)t * DM + c) = o0; *(f32x4*)(a.out + (size_t)t * DM + c + 4) = o1; }
        }
    }
}

#define XB_TMO      128
#define XB_XCNT(j)  (256  + 64 * (j))
#define XB_XSUB(j)  (1280 + 64 * (j))
#define XB_XGEN(j)  (2304 + 64 * (j))
#define XB_TOP      3328
#define XB_TOPGEN   3392
#define XCD_BAR_WORDS 3456
#define XB_SPIN_CAP (1u << 18)
__device__ __forceinline__ unsigned xb_ld(unsigned* p)              { return __hip_atomic_load(p, __ATOMIC_RELAXED, __HIP_MEMORY_SCOPE_AGENT); }
__device__ __forceinline__ unsigned xb_add(unsigned* p, unsigned v) { return __hip_atomic_fetch_add(p, v, __ATOMIC_RELAXED, __HIP_MEMORY_SCOPE_AGENT); }
__device__ __forceinline__ unsigned xb_xcc_id() { return (unsigned)__builtin_amdgcn_s_getreg((3 << 11) | 20) & 0xFu; }
#define XB_SPIN(cond, bar) do { unsigned _sp = 0; while (cond) { __builtin_amdgcn_s_sleep(1); \
    if ((++_sp & 255u) == 0u) { if (xb_ld(&(bar)[XB_TMO])) break; if (_sp > XB_SPIN_CAP) { atomicAdd(&(bar)[XB_TMO], 1u); break; } } } } while (0)
struct XcdBarrier { unsigned* bar; unsigned x; volatile LAS unsigned* st; };
__device__ __forceinline__ XcdBarrier xcd_barrier_post(unsigned* bar, volatile LAS unsigned* st) {
    XcdBarrier b; b.bar = bar; b.x = xb_xcc_id(); b.st = st;
    if (threadIdx.x == 0) (void)xb_add(&bar[XB_XCNT(b.x)], 1u);
    return b;
}
__device__ __forceinline__ void xcd_barrier_complete(unsigned* bar, unsigned x, unsigned& nloc, unsigned& nx) {
    const unsigned G = gridDim.x * gridDim.y * gridDim.z;
    unsigned sum, cnt, mine, sp = 0u;
    for (;;) {
        sum = 0u; cnt = 0u; mine = 0u;
#pragma unroll
        for (unsigned j = 0; j < 16; ++j) { const unsigned c = xb_ld(&bar[XB_XCNT(j)]); sum += c; cnt += (c > 0u) ? 1u : 0u; mine = (j == x) ? c : mine; }
        if (sum == G) break;
        __builtin_amdgcn_s_sleep(1);
        if ((++sp & 255u) == 0u) { if (xb_ld(&bar[XB_TMO])) break; if (sp > XB_SPIN_CAP) { atomicAdd(&bar[XB_TMO], 1u); break; } }
    }
    nloc = mine > 0u ? mine : 1u; nx = cnt > 0u ? cnt : 1u;
}
__device__ __forceinline__ void xcd_barrier(const XcdBarrier& b) {
    asm volatile("s_waitcnt vmcnt(0)" ::: "memory");
    __syncthreads();
    if (threadIdx.x == 0) {
        unsigned* bar = b.bar;
        __builtin_amdgcn_s_waitcnt(0);
        unsigned nloc = b.st[0], nx = b.st[1];
        if (nloc == 0u) { xcd_barrier_complete(bar, b.x, nloc, nx); b.st[0] = nloc; b.st[1] = nx; }
        const unsigned old = xb_add(&bar[XB_XSUB(b.x)], 1u);
        const unsigned gen = old / nloc;
        if (old + 1u == (gen + 1u) * nloc) {
            __builtin_amdgcn_fence(__ATOMIC_RELEASE, "agent");
            asm volatile("s_waitcnt vmcnt(0)" ::: "memory");
            const unsigned og = xb_add(&bar[XB_TOP], 1u);
            const unsigned tg = og / nx;
            if (og + 1u == (tg + 1u) * nx) xb_add(&bar[XB_TOPGEN], 1u);
            else XB_SPIN(xb_ld(&bar[XB_TOPGEN]) == tg, bar);
            __builtin_amdgcn_fence(__ATOMIC_ACQUIRE, "agent");
            xb_add(&bar[XB_XGEN(b.x)], 1u);
            asm volatile("s_waitcnt vmcnt(0)" ::: "memory");
        } else {
            XB_SPIN(xb_ld(&bar[XB_XGEN(b.x)]) == gen, bar);
            __builtin_amdgcn_fence(__ATOMIC_ACQUIRE, "agent");
            asm volatile("s_waitcnt vmcnt(0)" ::: "memory");
        }
    }
    __syncthreads();
}

constexpr int N_PHASES = 18;
#ifndef REP_MASK
#define REP_MASK 0
#endif
#define REP(k) (((REP_MASK) >> (k)) & 1)
#if REP_MASK == 0
#define REPFOR(k)
#else
#define REPFOR(k) for (int rep_ = 0; rep_ < 1 + REP(k); ++rep_)
#endif
#ifndef DRYLVL
#define DRYLVL 1
#endif
__device__ __forceinline__ const __attribute__((address_space(4))) Args* kargs() {
    const __attribute__((address_space(4))) Args* p = (const __attribute__((address_space(4))) Args*)__builtin_amdgcn_kernarg_segment_ptr();
    asm volatile("" : "+s"(p)); return p;
}
__global__ void __launch_bounds__(512, 2) fwd_megakernel(Args a_unused) {
    extern __shared__ __attribute__((aligned(16))) unsigned char lds_raw[];
    ldsp lds = (ldsp)lds_raw;
    cg::grid_group grid = cg::this_grid();
#define lo (kargs()->ph_lo)
#define hi (kargs()->ph_hi)
    if (threadIdx.x < 16) ((LAS unsigned*)(lds + MISC_OFF))[threadIdx.x] = 0u;
    __syncthreads();
    (void)xcd_barrier_post((unsigned*)(kargs()->ws + WS_CTL) + CW_BAR, (volatile LAS unsigned*)(lds + MISC_OFF));
#define a (*kargs())
#ifdef PHASE_ONLY
#define IN(k) ((k) == PHASE_ONLY && lo <= (k) && (k) < hi)
#elif defined(PHASE_MASK)
#define IN(k) ((((PHASE_MASK) >> (k)) & 1) && lo <= (k) && (k) < hi)
#else
#define IN(k) (lo <= (k) && (k) < hi)
#endif
#define SEAM(k) do { if (IN(k) && IN((k) + 1)) { XcdBarrier bar_; bar_.bar = (unsigned*)(kargs()->ws + WS_CTL) + CW_BAR; bar_.x = xb_xcc_id(); bar_.st = (volatile LAS unsigned*)(lds + MISC_OFF); TSEG_BEGIN(30); TSEG_BEGIN(100 + (k)); xcd_barrier(bar_); TSEG_END(100 + (k)); TSEG_END(30); } } while (0)
    if (lo < -12345) grid.sync();
    TSEG_BEGIN(50); if (IN(0)) { if (REP(0)) phase_p0(a, lds); phase_p0(a, lds); } TSEG_END(50);
    SEAM(0);
    if (IN(1)) REPFOR(1) {
        pg8::Gemm g{(const bf16_t*)(a.ws + WS_XB), (const bf16_t*)(a.ws + WS_WIN), T, NINP, DM, 0, nullptr};
        pg8::StaticOrder S; S.init(T, NINP, (int)gridDim.x, (int)blockIdx.x);
        pg8::EpiInProj E{(bf16_t*)(a.ws + WS_Q), (bf16_t*)(a.ws + WS_K), (bf16_t*)(a.ws + WS_V), (bf16_t*)(a.ws + WS_OZ), (bf16_t*)(a.ws + WS_XBC), (float*)(a.ws + WS_GATES)};
        pg8::gemm_phase<pg8::EpiInProj, pg8::StaticOrder, false>(lds, g, S, E);
    }
    SEAM(1);
    TSEG_BEGIN(52); if (IN(2)) { if (REP(2)) phase_ml_states(a, lds); phase_ml_states(a, lds); } TSEG_END(52);
    SEAM(2);
    TSEG_BEGIN(53); if (IN(3)) { if (REP(3)) phase_scan<true>(a, true); phase_scan<true>(a); } TSEG_END(53);
    SEAM(3);
    if (IN(4)) { if (REP(4)) phase_ml_out(a, lds, DRYLVL); phase_ml_out(a, lds); }
    SEAM(4);
    TSEG_BEGIN(55); if (IN(5)) { if (REP(5)) phase_ssd_states(a, lds); phase_ssd_states(a, lds); } TSEG_END(55);
    SEAM(5);
    TSEG_BEGIN(56); if (IN(6)) { if (REP(6)) phase_scan<false>(a, true); phase_scan<false>(a); } TSEG_END(56);
    SEAM(6);
    if (IN(7)) { if (REP(7)) phase_ssd_out(a, lds, DRYLVL); phase_ssd_out(a, lds); }
    SEAM(7);
    if (IN(8)) REPFOR(8) {
        pg8::Gemm g{(const bf16_t*)(a.ws + WS_OZ), (const bf16_t*)(a.ws + WS_WOUT), T, DM, 2048, 0, nullptr};
        pg8::StaticOrder S; S.init(T, DM, (int)gridDim.x, (int)blockIdx.x);
        pg8::EpiResBf16 E{a.in[I_X], (bf16_t*)a.out, DM, ALPHA};
        pg8::gemm_phase<pg8::EpiResBf16, pg8::StaticOrder, false>(lds, g, S, E);
    }
    SEAM(8);
    TSEG_BEGIN(59); if (IN(9)) { if (REP(9)) phase_ln1_router(a, lds); phase_ln1_router(a, lds); } TSEG_END(59);
    SEAM(9);
    TSEG_BEGIN(60); if (IN(10)) { if (REP(10)) phase_lists(a, lds); phase_lists(a, lds); } TSEG_END(60);
    SEAM(10);
    TSEG_BEGIN(61); if (IN(11)) REPFOR(11) moe_gemm1(a, lds, 0); TSEG_END(61);
    SEAM(11);
    TSEG_BEGIN(62); if (IN(12)) REPFOR(12) moe_gemm2(a, lds, 0); TSEG_END(62);
    SEAM(12);
    TSEG_BEGIN(63); if (IN(13)) REPFOR(13) { moe_combine(a, 0); moe_gemm1(a, lds, 1); } TSEG_END(63);
    SEAM(13);
    TSEG_BEGIN(64); if (IN(14)) REPFOR(14) moe_gemm2(a, lds, 1); TSEG_END(64);
    SEAM(14);
    TSEG_BEGIN(65); if (IN(15)) REPFOR(15) { moe_combine(a, 1); moe_gemm1(a, lds, 2); } TSEG_END(65);
    SEAM(15);
    TSEG_BEGIN(66); if (IN(16)) REPFOR(16) moe_gemm2(a, lds, 2); TSEG_END(66);
    SEAM(16);
    TSEG_BEGIN(67); if (IN(17)) { if (REP(17)) moe_combine(a, 2); moe_combine(a, 2); } TSEG_END(67);
    if (PROBE_SEG != 0 && blockIdx.x == 0 && threadIdx.x == 0) {
        const unsigned long long acc_ = *(volatile LAS unsigned long long*)(lds_probe_base + 16) * PROBE_SCALE; const unsigned long long t0_ = __builtin_amdgcn_s_memrealtime();
        while (__builtin_amdgcn_s_memrealtime() - t0_ < acc_) __builtin_amdgcn_s_sleep(10);
    }
#undef IN
#undef SEAM
#undef a
#undef lo
#undef hi
}

extern "C" void kernel_launch(void* const* d_in, const int* in_sizes, int n_in, void* d_out, int out_size, void* d_ws, size_t ws_size, hipStream_t stream) {
    static int grid = 0;
    if (grid == 0) {
        if (n_in != 24 || out_size != T * DM || ws_size < WS_END) { fprintf(stderr, "kernel_launch: unexpected problem (n_in %d, out %d, ws %zu); nothing launched\n", n_in, out_size, ws_size); grid = -1; return; }
        int dev = 0, cus = 0, per_cu = 0;
        hipGetDevice(&dev); hipDeviceGetAttribute(&cus, hipDeviceAttributeMultiprocessorCount, dev);
        hipFuncSetAttribute((const void*)fwd_megakernel, hipFuncAttributeMaxDynamicSharedMemorySize, LDS_BYTES);
        hipOccupancyMaxActiveBlocksPerMultiprocessor(&per_cu, (const void*)fwd_megakernel, 512, LDS_BYTES);
        if (per_cu < 1) { fprintf(stderr, "kernel_launch: occupancy query says %d blocks per CU\n", per_cu); per_cu = 1; }
        (void)hipGetLastError();
        grid = cus * per_cu; if (grid > 256) grid = 256;
    }
    if (grid < 0) return;
    hipMemsetAsync((char*)d_ws + WS_CTL, 0, 1 * MiB, stream);
    Args a{};
    for (int i = 0; i < 24; ++i) a.in[i] = (const float*)d_in[i];
    a.out = (float*)d_out; a.ws = (unsigned char*)d_ws; a.ph_lo = 0; a.ph_hi = N_PHASES;
    void* args[] = {&a};
    hipError_t e = hipLaunchCooperativeKernel((const void*)fwd_megakernel, dim3(grid), dim3(512), args, LDS_BYTES, stream);
    if (e != hipSuccess) fprintf(stderr, "cooperative launch failed: %s (grid %d)\n", hipGetErrorString(e), grid);
}
```

```cpp
#include <hip/hip_runtime.h>
#include <hip/hip_cooperative_groups.h>
#include <cstdio>
#include <cstdint>
namespace cg = cooperative_groups;

#define LAS __attribute__((address_space(3)))
typedef unsigned short bf16_t;
typedef short bf16x8 __attribute__((ext_vector_type(8)));
typedef short s16x4 __attribute__((ext_vector_type(4)));
typedef short v4i16_t __attribute__((ext_vector_type(4)));
typedef float f32x4 __attribute__((ext_vector_type(4)));
typedef float f32x2 __attribute__((ext_vector_type(2)));
typedef unsigned u32x4 __attribute__((ext_vector_type(4)));
typedef unsigned u32x2 __attribute__((ext_vector_type(2)));
typedef int i32x4 __attribute__((ext_vector_type(4)));
typedef int i32x8 __attribute__((ext_vector_type(8)));
typedef float f32x16 __attribute__((ext_vector_type(16)));
typedef LAS unsigned char* ldsp;
typedef LAS const unsigned char* ldscp;

constexpr int BATCH = 8, SEQ = 4096, DM = 1024, T = BATCH * SEQ;
constexpr int NC = 32, CH = 128;
constexpr int NIN = 6192, NINP = 6144;
constexpr int NE = 64, TOPK = 8, DE = 256;
constexpr float LN_EPS = 1e-5f, RMS_EPS = 1e-5f;
constexpr float ALPHA = 1.189207115002721f;
constexpr float NEG_BIG = -1e30f;
constexpr int NPASS = 1;
constexpr int PASS_VB0[NPASS + 1] = {0, 256};
constexpr int PASS_MAXROWS = 278528 + 32768;
constexpr int PASS_MAXTILES = PASS_MAXROWS / 256;
constexpr int YS_ROW0 = 262400;

constexpr size_t MiB = 1u << 20;
constexpr size_t WS_CTL = 0;
constexpr size_t WS_WIN = 1 * MiB;
constexpr size_t WS_WOUT = 14 * MiB;
constexpr size_t WS_GATES = 18 * MiB;
constexpr size_t WS_MSTAT = 24 * MiB;
constexpr size_t WS_Q = 26 * MiB;
constexpr size_t WS_K = 58 * MiB;
constexpr size_t WS_V = 90 * MiB;
constexpr size_t WS_OZ = 154 * MiB;
constexpr size_t WS_XBC = 282 * MiB;
constexpr size_t WS_XB = 410 * MiB;
constexpr size_t WS_H = 26 * MiB;
constexpr size_t WS_W1T = 461 * MiB;
constexpr size_t WS_H8 = 101 * MiB;
constexpr float H8_SCALE = 16.f, W1_SCALE = 512.f, ACT_SCALE = 8.f, W2_SCALE = 512.f;
constexpr size_t WS_W2T = 494 * MiB;
constexpr size_t WS_Y = 172 * MiB;
constexpr size_t WS_ACT = 429 * MiB;
constexpr size_t WS_SELE = 90 * MiB;
constexpr size_t WS_SELW = 91 * MiB;
constexpr size_t WS_TOKPOS = 92 * MiB;
constexpr size_t WS_ROWTOK = 93 * MiB;
constexpr size_t WS_ROWGATE = 95 * MiB;
constexpr size_t WS_ROWY = 97 * MiB;
constexpr size_t WS_TILEE = 99 * MiB;
constexpr size_t WS_END = 511 * MiB;
static_assert(T * 8 + 64 * 255 <= PASS_MAXROWS - 32768 && T * 8 < YS_ROW0 && (size_t)(YS_ROW0 + T) * DM <= (WS_W1T - WS_Y) && WS_W1T + (size_t)65 * 512 * 1024 <= WS_W2T && WS_W2T + (size_t)65 * 1024 * 256 <= WS_END && WS_H8 + (size_t)T * 1024 <= WS_Y && WS_TILEE + MiB <= WS_H8 && (size_t)PASS_MAXROWS * DE <= (size_t)T * DM * 4 && (size_t)NPASS * PASS_MAXROWS * 4 <= 2 * MiB, "MoE workspace map");
constexpr int MS_GM = 0;
constexpr int MS_MP = 4096;
constexpr int MS_U = 8192;
constexpr int MS_SD = 8192 + 262144;
constexpr int CW_BLOCKCNT = 1024;
constexpr int CW_NTILES = 512;
constexpr int CW_BAR = 32768;
constexpr int MISC_OFF = 159744 - 64;
#define lds_probe_base ((ldsp)(size_t)0 + MISC_OFF)

constexpr int LDS_BYTES = 159744;

typedef __bf16 bf16x2_t __attribute__((ext_vector_type(2)));
__device__ __forceinline__ unsigned pk2(float lo, float hi) { const f32x2 v = {lo, hi}; const bf16x2_t b = __builtin_convertvector(v, bf16x2_t); return __builtin_bit_cast(unsigned, b); }
__device__ __forceinline__ unsigned f2bf(float f) { return pk2(f, 0.f) & 0xffffu; }
__device__ __forceinline__ float bflo(unsigned u) { return __builtin_bit_cast(float, u << 16); }
__device__ __forceinline__ float bfhi(unsigned u) { return __builtin_bit_cast(float, u & 0xffff0000u); }
__device__ __forceinline__ float bf2f(short s) { return __builtin_bit_cast(float, ((unsigned)(unsigned short)s) << 16); }
template <int CTRL> __device__ __forceinline__ float dpp_f(float v) { return __builtin_bit_cast(float, __builtin_amdgcn_update_dpp(0, __builtin_bit_cast(int, v), CTRL, 0xF, 0xF, true)); }
__device__ __forceinline__ float rdlane_f(float v, int l) { return __builtin_bit_cast(float, __builtin_amdgcn_readlane(__builtin_bit_cast(int, v), l)); }
__device__ __forceinline__ float wave_sum(float v) {
    v += dpp_f<0x121>(v); v += dpp_f<0x122>(v); v += dpp_f<0x124>(v); v += dpp_f<0x128>(v);
    return (rdlane_f(v, 0) + rdlane_f(v, 16)) + (rdlane_f(v, 32) + rdlane_f(v, 48));
}
__device__ __forceinline__ float wave_max(float v) {
    v = fmaxf(v, dpp_f<0x121>(v)); v = fmaxf(v, dpp_f<0x122>(v)); v = fmaxf(v, dpp_f<0x124>(v)); v = fmaxf(v, dpp_f<0x128>(v));
    return fmaxf(fmaxf(rdlane_f(v, 0), rdlane_f(v, 16)), fmaxf(rdlane_f(v, 32), rdlane_f(v, 48)));
}
__device__ __forceinline__ float xor16_add(float v) { const unsigned u = __builtin_bit_cast(unsigned, v); const auto r = __builtin_amdgcn_permlane16_swap(u, u, false, false); return __builtin_bit_cast(float, r[0]) + __builtin_bit_cast(float, r[1]); }
__device__ __forceinline__ float xor32_add(float v) { const unsigned u = __builtin_bit_cast(unsigned, v); const auto r = __builtin_amdgcn_permlane32_swap(u, u, false, false); return __builtin_bit_cast(float, r[0]) + __builtin_bit_cast(float, r[1]); }
__device__ __forceinline__ float fq_sum(float v) { v += __shfl_xor(v, 16); v += __shfl_xor(v, 32); return v; }
__device__ __forceinline__ float group8_max(float v) {
    v = fmaxf(v, dpp_f<0xB1>(v)); v = fmaxf(v, dpp_f<0x4E>(v)); v = fmaxf(v, dpp_f<0x141>(v));
    return v;
}
template <int CTRL> __device__ __forceinline__ float dpp_keep_f(float v) { return __builtin_bit_cast(float, __builtin_amdgcn_update_dpp(__builtin_bit_cast(int, v), __builtin_bit_cast(int, v), CTRL, 0xF, 0xF, false)); }
__device__ __forceinline__ float wave_scan_add(float v, int lane) {
    v += dpp_f<0x111>(v); v += dpp_f<0x112>(v); v += dpp_f<0x114>(v); v += dpp_f<0x118>(v);
    const float t0 = rdlane_f(v, 15), t1 = rdlane_f(v, 31), t2 = rdlane_f(v, 47); const int row = lane >> 4;
    return v + (row == 0 ? 0.f : (row == 1 ? t0 : (row == 2 ? t0 + t1 : (t0 + t1) + t2)));
}
__device__ __forceinline__ float wave_scan_max(float v, int lane) {
    v = fmaxf(v, dpp_keep_f<0x111>(v)); v = fmaxf(v, dpp_keep_f<0x112>(v)); v = fmaxf(v, dpp_keep_f<0x114>(v)); v = fmaxf(v, dpp_keep_f<0x118>(v));
    const float t0 = rdlane_f(v, 15), t1 = rdlane_f(v, 31), t2 = rdlane_f(v, 47); const int row = lane >> 4;
    return row == 0 ? v : fmaxf(v, row == 1 ? t0 : (row == 2 ? fmaxf(t0, t1) : fmaxf(fmaxf(t0, t1), t2)));
}
__device__ __forceinline__ float sigmoidf_(float x) { return __builtin_amdgcn_rcpf(1.f + __expf(-x)); }
__device__ __forceinline__ float siluf_(float x) { return x * __builtin_amdgcn_rcpf(1.f + __expf(-x)); }
__device__ __forceinline__ float logsigmoidf_(float x) { return fminf(x, 0.f) - log1pf(__expf(-fabsf(x))); }
__device__ __forceinline__ float softplusf_(float x) { return fmaxf(x, 0.f) + log1pf(__expf(-fabsf(x))); }
__device__ __forceinline__ s16x4 vtr(ldscp p) { return __builtin_bit_cast(s16x4, __builtin_amdgcn_ds_read_tr16_b64_v4i16((LAS v4i16_t*)p)); }
__device__ __forceinline__ bf16x8 cat8(s16x4 lo, s16x4 hi) { return (bf16x8){lo[0], lo[1], lo[2], lo[3], hi[0], hi[1], hi[2], hi[3]}; }
#define BLOCK_SYNC() __syncthreads()
#ifndef PROBE_SEG
#define PROBE_SEG 0
#endif
#ifndef PROBE_SCALE
#define PROBE_SCALE 20
#endif
#define TSEG_BEGIN(id) do { if (PROBE_SEG == (id) && blockIdx.x == 0 && threadIdx.x == 0) { *(volatile LAS unsigned long long*)(lds_probe_base + 24) = __builtin_amdgcn_s_memrealtime(); } } while (0)
#define TSEG_END(id) do { if (PROBE_SEG == (id) && blockIdx.x == 0 && threadIdx.x == 0) { volatile LAS unsigned long long* p_ = (volatile LAS unsigned long long*)(lds_probe_base + 16); p_[0] = p_[0] + (__builtin_amdgcn_s_memrealtime() - p_[1]); } } while (0)
#define LDS_BARRIER() do { asm volatile("s_waitcnt lgkmcnt(0)" ::: "memory"); __builtin_amdgcn_s_barrier(); asm volatile("" ::: "memory"); } while (0)
__device__ __forceinline__ int wp_word(int i) { return __builtin_amdgcn_readfirstlane((int)((volatile LAS unsigned*)((ldsp)(size_t)0 + MISC_OFF))[i]); }
__device__ __forceinline__ int wp_i0(int per_batch) { return wp_word(9) ? wp_word(10) * per_batch + wp_word(11) : (int)blockIdx.x; }
__device__ __forceinline__ int wp_step() { return wp_word(9) ? wp_word(0) : (int)gridDim.x; }
__device__ __forceinline__ int wp_end(int per_batch, int nbatch) { return wp_word(9) ? (wp_word(10) + 1) * per_batch : nbatch * per_batch; }
__device__ __forceinline__ int launder(int v) { asm volatile("" : "+v"(v)); return v; }

__device__ __forceinline__ unsigned pk4_fp8(float a, float b, float c, float d) {
    int w = 0;
    w = __builtin_amdgcn_cvt_pk_fp8_f32(__builtin_amdgcn_fmed3f(a, -448.f, 448.f), __builtin_amdgcn_fmed3f(b, -448.f, 448.f), w, false);
    w = __builtin_amdgcn_cvt_pk_fp8_f32(__builtin_amdgcn_fmed3f(c, -448.f, 448.f), __builtin_amdgcn_fmed3f(d, -448.f, 448.f), w, true);
    return (unsigned)w;
}
namespace pg8 {
constexpr int BM = 256, BK = 64, HALF = 128, HTB = HALF * BK * 2, STAGE_BYTES = 8 * HTB, NXCD = 8, WGM = 8;
__host__ __device__ __forceinline__ int lds_byte(int r, int c) { const int st = (r >> 4) * 2 + (c >> 5), rr = r & 15, cc = c & 31, ob = rr * 64 + cc * 2; return st * 1024 + (ob ^ (((ob >> 9) & 1) << 5)); }
__host__ __device__ __forceinline__ void stage_rc(int b, int& R, int& C) { const int st = b / 1024, sb = b % 1024, swz = sb ^ (((sb >> 9) & 1) << 5); R = (st >> 1) * 16 + swz / 64; C = (st & 1) * 32 + (swz % 64) / 2; }
__host__ __device__ __forceinline__ int perm32(int rho) { const int n = rho >> 4, i = rho & 15; return 8 * (i >> 2) + 4 * n + (i & 3); }

struct Unit { int pm, pn, e; };
struct Gemm { const bf16_t* A; const bf16_t* Bt; int M, N, K; size_t bstride; const int* rowidx; };

struct StaticOrder {
    int nM, nN, nwg, G, c, loc, rev;
    __device__ void init(int M, int N, int G_, int c_) { nM = M / BM; nN = N / BM; nwg = nM * nN; G = G_; c = c_; loc = 0; rev = 0; }
    __device__ void init_local(int M, int N, int G_, int c_) { init(M, N, G_, c_); loc = (nM % (8 * WGM) == 0) ? 1 : 0; }
    __device__ bool next(int i, Unit& u) const {
        if (loc && wp_word(9)) { const int nMb = nM / 8; const int L = i * wp_word(0) + wp_word(11); if (L >= nMb * nN) return false;
            constexpr int WL = 2; const int grp = L / (WL * nN), w = L % (WL * nN); const int pl = grp * WL + w % WL; u.pm = wp_word(10) * nMb + (rev ? nMb - 1 - pl : pl); u.pn = (grp & 1) ? nN - 1 - w / WL : w / WL; u.e = 0; return true; }
        const long L = (long)i * G + c; if (L >= nwg) return false;
        int wgid = (int)L; { const int q = nwg / NXCD, r = nwg % NXCD, xcd = wgid % NXCD, off = wgid / NXCD; wgid = (xcd < r ? xcd * (q + 1) : r * (q + 1) + (xcd - r) * q) + off; }
        const int nig = WGM * nN, gid = wgid / nig, fm = gid * WGM, gsz = (nM - fm) < WGM ? (nM - fm) : WGM;
        u.pm = fm + ((wgid % nig) % gsz); u.pn = (wgid % nig) / gsz; u.e = 0; return true;
    }
};
template <int NN, bool DYN> struct MoeOrder {
    int ntile, G, c, efix; const int* tile_e;
    __device__ __forceinline__ bool next(int i, Unit& u) const {
        const int L = i * G + c; if (L >= ntile * NN) return false;
        u.pm = L / NN; u.pn = L % NN; u.e = DYN ? tile_e[u.pm] : efix; return true;
    }
};

__device__ __forceinline__ unsigned cvt_pk_bf16(float lo, float hi) { unsigned r; asm volatile("v_cvt_pk_bf16_f32 %0, %1, %2" : "=v"(r) : "v"(lo), "v"(hi)); return r; }

struct ArrAcc { const f32x4 (&a)[2][2][4][2]; __device__ __forceinline__ f32x4 operator()(int ai, int bj, int m, int n) const { return a[ai][bj][m][n]; } };
struct VecAcc { const f32x16 (&a)[2][2][2];    __device__ __forceinline__ f32x4 operator()(int ai, int bj, int m, int n) const { const f32x16 v = a[ai][bj][n]; return (f32x4){v[4 * m], v[4 * m + 1], v[4 * m + 2], v[4 * m + 3]}; } };
template <class Epi, class Sched, bool GATHER, bool FP8 = false>
__device__ __forceinline__ void gemm_phase(ldsp lds, const Gemm g, const Sched& S, const Epi& E) {
    const int tid = launder((int)threadIdx.x), wid = __builtin_amdgcn_readfirstlane(tid >> 6), lane = tid & 63, wr = wid >> 2, wc = wid & 3, fr = lane & 15, fq = lane >> 4;
    const int K = g.K, nt = K / BK;
    unsigned voffA[2], voffB[2]; int stR[2], stC[2];
#pragma unroll
    for (int i = 0; i < 2; ++i) { int R, C; stage_rc(tid * 16 + i * 8192, R, C); const int Rb = Epi::PERM ? ((R & ~31) + perm32(R & 31)) : R;
        stR[i] = R; stC[i] = C; voffA[i] = (unsigned)(R * K + C) * 2u; voffB[i] = (unsigned)(Rb * K + C) * 2u; }
    const size_t kstep = (size_t)(BK * 2);
    const size_t hstep = (size_t)HALF * K * 2;
    const size_t tstep = 2 * hstep;
    const unsigned ldsw = (unsigned)wid * 1024u;
    const int aoff = lds_byte(wr * 64 + fr, fq * 8), boff = lds_byte(wc * 32 + fr, fq * 8);
#define PG8_SA(b, h) (((b) * 2 + (h)) * HTB)
#define PG8_SB(b, h) ((4 + (b) * 2 + (h)) * HTB)
#define PG8_STAGE(bufoff, gbase, voff) do { _Pragma("unroll") for (int _i = 0; _i < 2; ++_i) \
        __builtin_amdgcn_global_load_lds((const unsigned*)((const char*)(gbase) + ((FP8 && !GATHER) ? (unsigned)launder((int)(voff)[_i]) : (voff)[_i])), (LAS unsigned*)(lds + (bufoff) + ldsw + _i * 8192), 16, 0, 0); } while (0)
#define PG8_LDA(dst, b, h) do { _Pragma("unroll") for (int m = 0; m < 4; ++m) _Pragma("unroll") for (int k = 0; k < 2; ++k) dst[m][k] = *(const LAS bf16x8*)(lds + PG8_SA(b, h) + aoff + m * 2048 + k * 1024); } while (0)
#define PG8_LDB(dst, b, h) do { _Pragma("unroll") for (int n = 0; n < 2; ++n) _Pragma("unroll") for (int k = 0; k < 2; ++k) dst[n][k] = *(const LAS bf16x8*)(lds + PG8_SB(b, h) + boff + n * 2048 + k * 1024); } while (0)
#define PG8_MMA(ai, bj, At, Bt) do { __builtin_amdgcn_s_setprio(1); _Pragma("unroll") for (int m = 0; m < 4; ++m) _Pragma("unroll") for (int n = 0; n < 2; ++n) { \
        if constexpr (FP8) {   \
            const i32x8 b8 = __builtin_shufflevector(__builtin_bit_cast(i32x4, Bt[n][0]), __builtin_bit_cast(i32x4, Bt[n][1]), 0, 1, 2, 3, 4, 5, 6, 7); \
            const i32x8 a8 = __builtin_shufflevector(__builtin_bit_cast(i32x4, At[m][0]), __builtin_bit_cast(i32x4, At[m][1]), 0, 1, 2, 3, 4, 5, 6, 7); \
            f32x16& av_ = accv[ai][bj][n]; f32x4 c_ = {av_[4 * m], av_[4 * m + 1], av_[4 * m + 2], av_[4 * m + 3]}; \
            c_ = __builtin_amdgcn_mfma_scale_f32_16x16x128_f8f6f4(b8, a8, c_, 0, 0, 0, 0, 0, 0);   \
            av_[4 * m] = c_[0]; av_[4 * m + 1] = c_[1]; av_[4 * m + 2] = c_[2]; av_[4 * m + 3] = c_[3]; \
        } else { _Pragma("unroll") for (int k = 0; k < 2; ++k) acc[ai][bj][m][n] = __builtin_amdgcn_mfma_f32_16x16x32_bf16(Bt[n][k], At[m][k], acc[ai][bj][m][n], 0, 0, 0); } } \
        __builtin_amdgcn_s_setprio(0); } while (0)
#define PG8_WAIT_V(n) asm volatile("s_waitcnt vmcnt(" #n ")" ::: "memory")
#define PG8_WAIT_L(n) asm volatile("s_waitcnt lgkmcnt(" #n ")" ::: "memory")
#define PG8_BAR __builtin_amdgcn_s_barrier()
#define PG8_SCHED __builtin_amdgcn_sched_barrier(0)
    Unit cur, nxt; int ui = 0;
    if (!S.next(0, cur)) return;
    f32x4 acc[2][2][4][2];
#pragma unroll
    for (int a = 0; a < 2; ++a)
#pragma unroll
        for (int b = 0; b < 2; ++b)
#pragma unroll
            for (int m = 0; m < 4; ++m)
#pragma unroll
                for (int n = 0; n < 2; ++n) acc[a][b][m][n] = (f32x4){0.f, 0.f, 0.f, 0.f};
    f32x16 accv[2][2][2];
    if constexpr (FP8) {
#pragma unroll
        for (int a = 0; a < 2; ++a)
#pragma unroll
            for (int b = 0; b < 2; ++b)
#pragma unroll
                for (int n = 0; n < 2; ++n) accv[a][b][n] = (f32x16)(0.f);
    }
    bf16x8 At[4][2], B0[2][2], B1[2][2];
    unsigned gc[2][2], gn[2][2];
    auto load_g = [&](unsigned (&dst)[2][2], const Unit& u) {
#pragma unroll
        for (int h = 0; h < 2; ++h)
#pragma unroll
            for (int i = 0; i < 2; ++i) { const int src = g.rowidx[u.pm * BM + h * HALF + stR[i]]; dst[h][i] = (unsigned)(src * K + stC[i]) * 2u; }
    };
    const char* cA = GATHER ? (const char*)g.A : (const char*)g.A + (size_t)cur.pm * tstep;
    const char* cB = (const char*)g.Bt + (size_t)cur.e * g.bstride + (size_t)cur.pn * tstep;
#define PG8_STA(bufoff, h, ptr, garr) do { if constexpr (GATHER) { PG8_STAGE(bufoff, ptr, garr[h]); } else { PG8_STAGE(bufoff, (ptr) + (h) * hstep, voffA); } } while (0)
    if constexpr (GATHER) { load_g(gc, cur); }
    PG8_STAGE(PG8_SB(0, 0), cB, voffB); PG8_STAGE(PG8_SB(0, 1), cB + hstep, voffB); PG8_STA(PG8_SA(0, 0), 0, cA, gc); PG8_STA(PG8_SA(0, 1), 1, cA, gc);
    if (wr == 1) PG8_BAR;
    PG8_WAIT_V(2); PG8_BAR;
    PG8_STAGE(PG8_SB(1, 0), cB + kstep, voffB); PG8_STA(PG8_SA(1, 0), 0, cA + kstep, gc); PG8_STAGE(PG8_SB(1, 1), cB + hstep + kstep, voffB);
    PG8_WAIT_V(6); PG8_BAR;
    for (;;) {
        const bool has_next = S.next(ui + 1, nxt);
        const char* nA = GATHER ? (const char*)g.A : (has_next ? (const char*)g.A + (size_t)nxt.pm * tstep : cA);
        const char* nB = has_next ? (const char*)g.Bt + (size_t)nxt.e * g.bstride + (size_t)nxt.pn * tstep : cB;
        if constexpr (GATHER) { if (has_next) load_g(gn, nxt); else {
#pragma unroll
            for (int h = 0; h < 2; ++h)
#pragma unroll
                for (int i = 0; i < 2; ++i) gn[h][i] = gc[h][i]; } }
        for (int t = 0; t < nt; t += 2) {
            const bool last = (t == nt - 2);
            const char* a1 = cA + (size_t)(t + 1) * kstep;
            const char* a2 = last ? nA : cA + (size_t)(t + 2) * kstep; const char* b2 = last ? nB : cB + (size_t)(t + 2) * kstep;
            const char* a3 = a2 + kstep; const char* b3 = b2 + kstep;
#define PG8_STA2(bufoff, h, ptr) do { if constexpr (GATHER) { if (last) { PG8_STAGE(bufoff, ptr, gn[h]); } else { PG8_STAGE(bufoff, ptr, gc[h]); } } else { PG8_STAGE(bufoff, (ptr) + (h) * hstep, voffA); } } while (0)
            PG8_LDB(B0, 0, 0); PG8_LDB(B1, 0, 1); PG8_SCHED; PG8_LDA(At, 0, 0); PG8_STA(PG8_SA(1, 1), 1, a1, gc);
            PG8_WAIT_V(8); PG8_WAIT_L(0); PG8_BAR; PG8_MMA(0, 0, At, B0); PG8_MMA(0, 1, At, B1); PG8_BAR; PG8_SCHED;
            PG8_LDA(At, 0, 1); PG8_STAGE(PG8_SB(0, 0), b2, voffB); PG8_STAGE(PG8_SB(0, 1), b2 + hstep, voffB); PG8_STA2(PG8_SA(0, 0), 0, a2);
            PG8_WAIT_V(8); PG8_WAIT_L(0); PG8_BAR; PG8_MMA(1, 0, At, B0); PG8_MMA(1, 1, At, B1); PG8_BAR; PG8_SCHED;
            PG8_LDB(B0, 1, 0); PG8_LDB(B1, 1, 1); PG8_SCHED; PG8_LDA(At, 1, 0); PG8_STA2(PG8_SA(0, 1), 1, a2);
            PG8_WAIT_V(8); PG8_WAIT_L(0); PG8_BAR; PG8_MMA(0, 0, At, B0); PG8_MMA(0, 1, At, B1); PG8_BAR; PG8_SCHED;
            PG8_LDA(At, 1, 1); PG8_STAGE(PG8_SB(1, 0), b3, voffB); PG8_STAGE(PG8_SB(1, 1), b3 + hstep, voffB); PG8_STA2(PG8_SA(1, 0), 0, a3);
            PG8_WAIT_V(8); PG8_WAIT_L(0); PG8_BAR; PG8_MMA(1, 0, At, B0); PG8_MMA(1, 1, At, B1); PG8_BAR; PG8_SCHED;
        }
        TSEG_BEGIN(70);
        if (wr == 0) PG8_BAR;
        if constexpr (FP8) E(VecAcc{accv}, cur, wr, wc, launder(fr), launder(fq)); else E(ArrAcc{acc}, cur, wr, wc, launder(fr), launder(fq));
        TSEG_END(70);
        if (!has_next) break;
#pragma unroll
        for (int a = 0; a < 2; ++a)
#pragma unroll
            for (int b = 0; b < 2; ++b)
#pragma unroll
                for (int m = 0; m < 4; ++m)
#pragma unroll
                    for (int n = 0; n < 2; ++n) acc[a][b][m][n] = (f32x4){0.f, 0.f, 0.f, 0.f};
        if constexpr (FP8) {
#pragma unroll
            for (int a = 0; a < 2; ++a)
#pragma unroll
                for (int b = 0; b < 2; ++b)
#pragma unroll
                    for (int n = 0; n < 2; ++n) accv[a][b][n] = (f32x16)(0.f);
        }
        cur = nxt; cA = nA; cB = nB; ++ui;
        if constexpr (GATHER) {
#pragma unroll
            for (int h = 0; h < 2; ++h)
#pragma unroll
                for (int i = 0; i < 2; ++i) gc[h][i] = gn[h][i];
        }
        if (wr == 1) PG8_BAR;
    }
    PG8_WAIT_V(0);
    PG8_BAR;
#undef PG8_SA
#undef PG8_SB
#undef PG8_STAGE
#undef PG8_STA
#undef PG8_STA2
#undef PG8_LDA
#undef PG8_LDB
#undef PG8_MMA
#undef PG8_WAIT_V
#undef PG8_WAIT_L
#undef PG8_BAR
#undef PG8_SCHED
}

struct EpiInProj {
    static constexpr bool PERM = true;
    bf16_t *q, *k, *v, *oz, *xbc; float* gates;
    template <class ACC> __device__ __forceinline__ void operator()(const ACC& acc, const Unit& u, int wr, int wc, int fr, int fq) const {
        const int row0 = u.pm * BM + wr * 64 + fr, pn = u.pn;
        bf16_t* base; int ld, colt;
        if (pn < 2) { base = q; ld = 512; colt = pn * 256; }
        else if (pn < 4) { base = k; ld = 512; colt = (pn - 2) * 256; }
        else if (pn < 8) { base = v; ld = 1024; colt = (pn - 4) * 256; }
        else if (pn < 16) { base = oz; ld = 2048; colt = (pn - 8) * 256; }
        else { base = xbc; ld = 2048; colt = (pn - 16) * 256; }
        const int col0 = colt + wc * 32 + 8 * fq;
#pragma unroll
        for (int ai = 0; ai < 2; ++ai)
#pragma unroll
            for (int m = 0; m < 4; ++m) { bf16_t* rowp = base + (size_t)(row0 + ai * HALF + m * 16) * ld + col0;
#pragma unroll
                for (int bj = 0; bj < 2; ++bj) { const f32x4 v0 = acc(ai, bj, m, 0), v1 = acc(ai, bj, m, 1);
                    u32x4 w; w.x = cvt_pk_bf16(v0[0], v0[1]); w.y = cvt_pk_bf16(v0[2], v0[3]); w.z = cvt_pk_bf16(v1[0], v1[1]); w.w = cvt_pk_bf16(v1[2], v1[3]);
                    *(u32x4*)(rowp + bj * HALF) = w; } }
    }
};
struct EpiResF32 {
    static constexpr bool PERM = false;
    const float* res; float* out; int ldc; float alpha;
    template <class ACC> __device__ __forceinline__ void operator()(const ACC& acc, const Unit& u, int wr, int wc, int fr, int fq) const {
        const int col0 = u.pn * BM + wc * 32 + 4 * fq;
#pragma unroll
        for (int ai = 0; ai < 2; ++ai)
#pragma unroll
            for (int m = 0; m < 4; ++m) { const size_t off = (size_t)(u.pm * BM + ai * HALF + wr * 64 + m * 16 + fr) * ldc + col0;
                f32x4 r[2][2];
#pragma unroll
                for (int bj = 0; bj < 2; ++bj)
#pragma unroll
                    for (int n = 0; n < 2; ++n) r[bj][n] = *(const f32x4*)(res + off + bj * HALF + n * 16);
#pragma unroll
                for (int bj = 0; bj < 2; ++bj)
#pragma unroll
                    for (int n = 0; n < 2; ++n) *(f32x4*)(out + off + bj * HALF + n * 16) = acc(ai, bj, m, n) + r[bj][n] * alpha;
                asm volatile("" ::: "memory"); }
    }
};
struct EpiResBf16 {
    static constexpr bool PERM = true;
    const float* res; bf16_t* out; int ldc; float alpha;
    template <class ACC> __device__ __forceinline__ void operator()(const ACC& acc, const Unit& u, int wr, int wc, int fr, int fq) const {
        const int col0 = u.pn * BM + wc * 32 + 8 * fq;
#pragma unroll
        for (int ai = 0; ai < 2; ++ai)
#pragma unroll
            for (int m = 0; m < 4; ++m) { const size_t off = (size_t)(u.pm * BM + ai * HALF + wr * 64 + m * 16 + fr) * ldc + col0;
                f32x4 r[2][2];
#pragma unroll
                for (int bj = 0; bj < 2; ++bj)
#pragma unroll
                    for (int n = 0; n < 2; ++n) r[bj][n] = *(const f32x4*)(res + off + bj * HALF + n * 4);
#pragma unroll
                for (int bj = 0; bj < 2; ++bj) { const f32x4 v0 = acc(ai, bj, m, 0) + r[bj][0] * alpha, v1 = acc(ai, bj, m, 1) + r[bj][1] * alpha;
                    u32x4 w; w.x = cvt_pk_bf16(v0[0], v0[1]); w.y = cvt_pk_bf16(v0[2], v0[3]); w.z = cvt_pk_bf16(v1[0], v1[1]); w.w = cvt_pk_bf16(v1[2], v1[3]);
                    *(u32x4*)(out + off + bj * HALF) = w; }
                asm volatile("" ::: "memory"); }
    }
};
struct EpiF32 {
    static constexpr bool PERM = false;
    float* out; int ldc;
    template <class ACC> __device__ __forceinline__ void operator()(const ACC& acc, const Unit& u, int wr, int wc, int fr, int fq) const {
        const int col0 = u.pn * BM + wc * 32 + 4 * fq;
#pragma unroll
        for (int ai = 0; ai < 2; ++ai)
#pragma unroll
            for (int m = 0; m < 4; ++m) { float* rowp = out + (size_t)(u.pm * BM + ai * HALF + wr * 64 + m * 16 + fr) * ldc + col0;
#pragma unroll
                for (int bj = 0; bj < 2; ++bj)
#pragma unroll
                    for (int n = 0; n < 2; ++n) *(f32x4*)(rowp + bj * HALF + n * 16) = acc(ai, bj, m, n);
                asm volatile("" ::: "memory"); }
    }
};
struct EpiSwiGLU {
    static constexpr bool PERM = true;
    unsigned char* act; float sc;
    template <class ACC> __device__ __forceinline__ void operator()(const ACC& acc, const Unit& u, int wr, int wc, int fr, int fq) const {
        const int row0 = u.pm * BM + wr * 64 + fr, col0 = u.pn * 128 + wc * 32 + 8 * fq;
#pragma unroll
        for (int ai = 0; ai < 2; ++ai)
#pragma unroll
            for (int m = 0; m < 4; ++m) { unsigned char* rowp = act + (size_t)(row0 + ai * HALF + m * 16) * DE + col0;
                float r[8];
#pragma unroll
                for (int n = 0; n < 2; ++n)
#pragma unroll
                    for (int j = 0; j < 4; ++j) { const float gt = acc(ai, 0, m, n)[j] * sc, up = acc(ai, 1, m, n)[j] * sc; r[n * 4 + j] = gt * __builtin_amdgcn_rcpf(1.f + __expf(-gt)) * (up * ACT_SCALE); }
                u32x2 w; w.x = pk4_fp8(r[0], r[1], r[2], r[3]); w.y = pk4_fp8(r[4], r[5], r[6], r[7]);
                *(u32x2*)rowp = w; asm volatile("" ::: "memory"); }
    }
};
struct EpiDownY {
    static constexpr bool PERM = true;
    unsigned char* Y; const int* rowy; const float* rowgate;
    template <class ACC> __device__ __forceinline__ void operator()(const ACC& acc, const Unit& u, int wr, int wc, int fr, int fq) const {
        const int row0 = u.pm * BM + wr * 64 + fr, colb = u.pn * BM + wc * 32;
#pragma unroll
        for (int ai = 0; ai < 2; ++ai) {
            float gtv[4]; int yrs[2];
#pragma unroll
            for (int m = 0; m < 4; ++m) gtv[m] = rowgate[row0 + ai * HALF + m * 16];
#pragma unroll
            for (int mp = 0; mp < 2; ++mp) yrs[mp] = rowy[row0 + ai * HALF + (2 * mp + (fq & 1)) * 16];
#pragma unroll
            for (int mp = 0; mp < 2; ++mp) {
                const int yr = yrs[mp];
                unsigned char* rowp = Y + (size_t)yr * DM + colb + 16 * (fq >> 1);
#pragma unroll
                for (int bj = 0; bj < 2; ++bj) {
                    auto pack8 = [&](const f32x4& a0, const f32x4& a1, float gt, unsigned& lo, unsigned& hi) {
                        const f32x4 v0 = a0 * gt, v1 = a1 * gt; int w0 = 0, w1 = 0;
                        w0 = __builtin_amdgcn_cvt_pk_fp8_f32(__builtin_amdgcn_fmed3f(v0[0], -448.f, 448.f), __builtin_amdgcn_fmed3f(v0[1], -448.f, 448.f), w0, false);
                        w0 = __builtin_amdgcn_cvt_pk_fp8_f32(__builtin_amdgcn_fmed3f(v0[2], -448.f, 448.f), __builtin_amdgcn_fmed3f(v0[3], -448.f, 448.f), w0, true);
                        w1 = __builtin_amdgcn_cvt_pk_fp8_f32(__builtin_amdgcn_fmed3f(v1[0], -448.f, 448.f), __builtin_amdgcn_fmed3f(v1[1], -448.f, 448.f), w1, false);
                        w1 = __builtin_amdgcn_cvt_pk_fp8_f32(__builtin_amdgcn_fmed3f(v1[2], -448.f, 448.f), __builtin_amdgcn_fmed3f(v1[3], -448.f, 448.f), w1, true);
                        lo = (unsigned)w0; hi = (unsigned)w1; };
                    unsigned alo, ahi, blo, bhi;
                    pack8(acc(ai, bj, 2 * mp, 0), acc(ai, bj, 2 * mp, 1), gtv[2 * mp] * (64.f / (ACT_SCALE * W2_SCALE)), alo, ahi);
                    pack8(acc(ai, bj, 2 * mp + 1, 0), acc(ai, bj, 2 * mp + 1, 1), gtv[2 * mp + 1] * (64.f / (ACT_SCALE * W2_SCALE)), blo, bhi);
                    { const auto r = __builtin_amdgcn_permlane16_swap(alo, blo, false, false); alo = r[0]; blo = r[1]; }
                    { const auto r = __builtin_amdgcn_permlane16_swap(ahi, bhi, false, false); ahi = r[0]; bhi = r[1]; }
                    u32x4 o; o.x = alo; o.y = ahi; o.z = blo; o.w = bhi;
                    *(u32x4*)(rowp + bj * HALF) = o; asm volatile("" ::: "memory"); }
            }
        }
    }
};
}

struct Args { const float* in[24]; float* out; unsigned char* ws; int ph_lo, ph_hi; };
typedef const __attribute__((address_space(4))) Args& ArgsRef;
enum { I_X = 0, I_WIN, I_MLIB, I_MLFB, I_MLNW, I_CONVW, I_CONVB, I_DTB, I_ALOG, I_DSKIP, I_SSMNW, I_WOUT, I_LN1G, I_LN1B, I_WR, I_RB, I_WEG, I_WEU, I_WED, I_WSG, I_WSU, I_WSD, I_LN2G, I_LN2B };

__device__ __forceinline__ void transpose_item(const float* W, int ldw, int k0, int c0, bf16_t* WT, int ldk, int r0, float scale, LAS float* scr, int lane) {
    f32x4 tv[8];
#pragma unroll
    for (int i = 0; i < 8; ++i) tv[i] = *(const f32x4*)(W + (size_t)(k0 + 8 * i + (lane >> 3)) * ldw + c0 + (lane & 7) * 4);
#pragma unroll
    for (int i = 0; i < 8; ++i) { LAS float* d = scr + (8 * i + (lane >> 3)) * 33 + (lane & 7) * 4; d[0] = tv[i][0]; d[1] = tv[i][1]; d[2] = tv[i][2]; d[3] = tv[i][3]; }
    asm volatile("s_waitcnt lgkmcnt(0)" ::: "memory");
    const int c = lane & 7;
#pragma unroll
    for (int j = 0; j < 4; ++j) { const int n = (lane >> 3) + 8 * j; const LAS float* s = scr + (8 * c) * 33 + n;
        u32x4 o; o.x = pk2(s[0 * 33] * scale, s[1 * 33] * scale); o.y = pk2(s[2 * 33] * scale, s[3 * 33] * scale); o.z = pk2(s[4 * 33] * scale, s[5 * 33] * scale); o.w = pk2(s[6 * 33] * scale, s[7 * 33] * scale);
        *(u32x4*)(WT + (size_t)(r0 + n) * ldk + k0 + 8 * c) = o; }
    asm volatile("s_waitcnt lgkmcnt(0)" ::: "memory");
}
__device__ __forceinline__ void transpose_load(const float* W, int ldw, int k0, int c0, int lane, f32x4 (&tv)[8]) {
#pragma unroll
    for (int i = 0; i < 8; ++i) tv[i] = *(const f32x4*)(W + (size_t)(k0 + 8 * i + (lane >> 3)) * ldw + c0 + (lane & 7) * 4);
}
__device__ __forceinline__ void transpose_finish(const f32x4 (&tv)[8], int k0, bf16_t* WT, int ldk, int r0, float scale, LAS float* scr, int lane) {
#pragma unroll
    for (int i = 0; i < 8; ++i) { LAS float* d = scr + (8 * i + (lane >> 3)) * 33 + (lane & 7) * 4; d[0] = tv[i][0]; d[1] = tv[i][1]; d[2] = tv[i][2]; d[3] = tv[i][3]; }
    asm volatile("s_waitcnt lgkmcnt(0)" ::: "memory");
    const int c = lane & 7;
#pragma unroll
    for (int j = 0; j < 4; ++j) { const int n = (lane >> 3) + 8 * j; const LAS float* s = scr + (8 * c) * 33 + n;
        u32x4 o; o.x = pk2(s[0 * 33] * scale, s[1 * 33] * scale); o.y = pk2(s[2 * 33] * scale, s[3 * 33] * scale); o.z = pk2(s[4 * 33] * scale, s[5 * 33] * scale); o.w = pk2(s[6 * 33] * scale, s[7 * 33] * scale);
        *(u32x4*)(WT + (size_t)(r0 + n) * ldk + k0 + 8 * c) = o; }
    asm volatile("s_waitcnt lgkmcnt(0)" ::: "memory");
}
__device__ __forceinline__ void transpose_item_f8(const float* W, int ldw, int k0, int c0, unsigned char* WT, int ldk, int r0, float scale, LAS float* scr, int lane) {
    f32x4 tv[8];
#pragma unroll
    for (int i = 0; i < 8; ++i) tv[i] = *(const f32x4*)(W + (size_t)(k0 + 8 * i + (lane >> 3)) * ldw + c0 + (lane & 7) * 4);
#pragma unroll
    for (int i = 0; i < 8; ++i) { LAS float* d = scr + (8 * i + (lane >> 3)) * 33 + (lane & 7) * 4; d[0] = tv[i][0]; d[1] = tv[i][1]; d[2] = tv[i][2]; d[3] = tv[i][3]; }
    asm volatile("s_waitcnt lgkmcnt(0)" ::: "memory");
    const int c = lane & 7;
#pragma unroll
    for (int j = 0; j < 4; ++j) { const int n = (lane >> 3) + 8 * j; const LAS float* s = scr + (8 * c) * 33 + n;
        u32x2 o; o.x = pk4_fp8(s[0 * 33] * scale, s[1 * 33] * scale, s[2 * 33] * scale, s[3 * 33] * scale); o.y = pk4_fp8(s[4 * 33] * scale, s[5 * 33] * scale, s[6 * 33] * scale, s[7 * 33] * scale);
        *(u32x2*)(WT + (size_t)(r0 + n) * ldk + k0 + 8 * c) = o; }
    asm volatile("s_waitcnt lgkmcnt(0)" ::: "memory");
}

__device__ __forceinline__ void phase_p0(ArgsRef a, ldsp lds) {
    const int tid = launder((int)threadIdx.x), lane = tid & 63, wave = tid >> 6, G = gridDim.x;
    const int gw = blockIdx.x * 8 + wave, NGW = G * 8;
    LAS float* scr = (LAS float*)(lds + wave * 8448);
    const float* x = a.in[I_X]; bf16_t* xb = (bf16_t*)(a.ws + WS_XB);
    bf16_t* wint = (bf16_t*)(a.ws + WS_WIN); bf16_t* woutt = (bf16_t*)(a.ws + WS_WOUT);
    constexpr int NI_WIN = 192 * 16, NI_WOUT = 32 * 32;
    TSEG_BEGIN(51);
    auto win_item = [&](int it, int& k0, int& sc, int& dr, float& scale) {
        const int cb = it % 192, kb = it / 192; dr = cb * 32; k0 = kb * 64; scale = 1.f;
        if (dr < 512) sc = dr; else if (dr < 1024) { sc = dr; scale = 0.08838834764831845f; } else if (dr < 3072) sc = dr; else sc = dr + 16;
    };
    for (int it = gw; it < NI_WIN; it += 2 * NGW) {
        const int it1 = it + NGW; const bool two = it1 < NI_WIN;
        int k0a, sca, dra, k0b, scb, drb; float sa, sb;
        win_item(it, k0a, sca, dra, sa); win_item(two ? it1 : it, k0b, scb, drb, sb);
        f32x4 ta[8], tb[8];
        transpose_load(a.in[I_WIN], NIN, k0a, sca, lane, ta);
        if (two) transpose_load(a.in[I_WIN], NIN, k0b, scb, lane, tb);
        transpose_finish(ta, k0a, wint, DM, dra, sa, scr, lane);
        if (two) transpose_finish(tb, k0b, wint, DM, drb, sb, scr, lane);
    }
    for (int it = NI_WIN + gw; it < NI_WIN + NI_WOUT; it += NGW) {
        if (it - NI_WIN < G * 7) continue;
        const int r = it - NI_WIN; const int cb = r % 32, kb = r / 32;
        transpose_item(a.in[I_WOUT], DM, kb * 64, cb * 32, woutt, 2048, cb * 32, 1.f, scr, lane);
    }
    LDS_BARRIER();
    TSEG_END(51); TSEG_BEGIN(54);
    constexpr int WP = 2064;
#pragma unroll 1
    for (int e0 = tid; e0 < 12 * DM; e0 += 512 * 8) {
        f32x4 wv[8];
#pragma unroll
        for (int u = 0; u < 8; ++u) { const int e = e0 + 512 * u, k = e / 12, pc = e % 12; const int col = pc < 4 ? 3072 + 4 * pc : 6160 + 4 * (pc - 4);
            wv[u] = *(const f32x4*)(a.in[I_WIN] + (size_t)k * NIN + col); }
#pragma unroll
        for (int u = 0; u < 8; ++u) { const int e = e0 + 512 * u, k = e / 12, pc = e % 12; const int n0 = 4 * pc;
#pragma unroll
            for (int j = 0; j < 4; ++j) *(LAS unsigned short*)(lds + (n0 + j) * WP + k * 2) = (unsigned short)f2bf(wv[u][j]); }
    }
    LDS_BARRIER();
    float* gates = (float*)(a.ws + WS_GATES);
    const int fr = lane & 15, fq = lane >> 4;
    TSEG_END(54); TSEG_BEGIN(57);
    for (int grp = gw; grp < T / 16; grp += NGW) {
        const float* xr = x + (size_t)(grp * 16 + fr) * DM + 8 * fq; bf16_t* xo = xb + (size_t)(grp * 16 + fr) * DM + 8 * fq;
        f32x4 acc[3];
#pragma unroll
        for (int nt = 0; nt < 3; ++nt) acc[nt] = (f32x4){0.f, 0.f, 0.f, 0.f};
#pragma unroll 1
        for (int kc = 0; kc < 4; ++kc) {
            f32x4 v[8][2];
#pragma unroll
            for (int ks = 0; ks < 8; ++ks) { v[ks][0] = *(const f32x4*)(xr + 256 * kc + 32 * ks); v[ks][1] = *(const f32x4*)(xr + 256 * kc + 32 * ks + 4); }
#pragma unroll
            for (int ks = 0; ks < 8; ++ks) {
                u32x4 pk; pk.x = pk2(v[ks][0][0], v[ks][0][1]); pk.y = pk2(v[ks][0][2], v[ks][0][3]); pk.z = pk2(v[ks][1][0], v[ks][1][1]); pk.w = pk2(v[ks][1][2], v[ks][1][3]);
                *(u32x4*)(xo + 256 * kc + 32 * ks) = pk;
                const bf16x8 af = __builtin_bit_cast(bf16x8, pk);
#pragma unroll
                for (int nt = 0; nt < 3; ++nt) { const bf16x8 wf = *(const LAS bf16x8*)(lds + (16 * nt + fr) * WP + (256 * kc + 32 * ks + 8 * fq) * 2);
                    acc[nt] = __builtin_amdgcn_mfma_f32_16x16x32_bf16(wf, af, acc[nt], 0, 0, 0); }
            }
        }
#pragma unroll
        for (int nt = 0; nt < 3; ++nt) *(f32x4*)(gates + (size_t)(grp * 16 + fr) * 48 + 16 * nt + 4 * fq) = acc[nt];
    }
    LDS_BARRIER();
    TSEG_END(57);
}

__device__ __forceinline__ void chunk_state_gemm(ldscp P, int pitchP, ldscp Q, int pitchQ, const LAS float* w, bf16_t* out, int lane) {
    const int g = lane >> 4, q = (lane & 15) >> 2, p = lane & 3, fr = lane & 15;
#pragma unroll 1
    for (int ih = 0; ih < 2; ++ih) {
        f32x4 acc[4][4];
#pragma unroll
        for (int i = 0; i < 4; ++i)
#pragma unroll
            for (int j = 0; j < 4; ++j) acc[i][j] = (f32x4){0.f, 0.f, 0.f, 0.f};
#pragma unroll 1
        for (int ks = 0; ks < 4; ++ks) {
            const int srow = 32 * ks + 8 * g;
            const f32x4 w0 = *(const LAS f32x4*)(w + srow), w1 = *(const LAS f32x4*)(w + srow + 4);
            bf16x8 qf[4];
#pragma unroll
            for (int jt = 0; jt < 4; ++jt) {
                ldscp ad = Q + (srow + q) * pitchQ + (16 * jt + 4 * p) * 2;
                const s16x4 lo = vtr(ad), hi = vtr(ad + 4 * pitchQ);
                u32x4 pk; pk.x = pk2(bf2f(lo[0]) * w0[0], bf2f(lo[1]) * w0[1]); pk.y = pk2(bf2f(lo[2]) * w0[2], bf2f(lo[3]) * w0[3]);
                pk.z = pk2(bf2f(hi[0]) * w1[0], bf2f(hi[1]) * w1[1]); pk.w = pk2(bf2f(hi[2]) * w1[2], bf2f(hi[3]) * w1[3]);
                qf[jt] = __builtin_bit_cast(bf16x8, pk);
            }
#pragma unroll
            for (int it = 0; it < 4; ++it) {
                ldscp ad = P + (srow + q) * pitchP + (16 * (4 * ih + it) + 4 * p) * 2;
                const bf16x8 pf = cat8(vtr(ad), vtr(ad + 4 * pitchP));
#pragma unroll
                for (int jt = 0; jt < 4; ++jt) acc[it][jt] = __builtin_amdgcn_mfma_f32_16x16x32_bf16(pf, qf[jt], acc[it][jt], 0, 0, 0);
            }
        }
        TSEG_BEGIN(85);
#pragma unroll
        for (int ip = 0; ip < 2; ++ip)
#pragma unroll
            for (int jt = 0; jt < 4; ++jt) {
                unsigned alo = pk2(acc[2 * ip][jt][0], acc[2 * ip][jt][1]), ahi = pk2(acc[2 * ip][jt][2], acc[2 * ip][jt][3]);
                unsigned blo = pk2(acc[2 * ip + 1][jt][0], acc[2 * ip + 1][jt][1]), bhi = pk2(acc[2 * ip + 1][jt][2], acc[2 * ip + 1][jt][3]);
                { const auto r = __builtin_amdgcn_permlane16_swap(alo, blo, false, false); alo = r[0]; blo = r[1]; }
                { const auto r = __builtin_amdgcn_permlane16_swap(ahi, bhi, false, false); ahi = r[0]; bhi = r[1]; }
                const int itsel = 2 * ip + (g & 1);
                u32x4 o; o.x = alo; o.y = ahi; o.z = blo; o.w = bhi;
                *(u32x4*)(out + (size_t)(16 * jt + fr) * 128 + 16 * (4 * ih + itsel) + 8 * (g >> 1)) = o; }
        TSEG_END(85);
    }
}

constexpr int P128 = 288, P256 = 544;
constexpr int P128R = 272;

struct MlVec { float ig[2], bb[2], colw[2]; float g; };
__device__ __forceinline__ MlVec ml_chunk_vec_raw(const float (&graw)[4], float ib, float fb, int lane) {
    MlVec r; float lf[2];
#pragma unroll
    for (int j = 0; j < 2; ++j) { r.ig[j] = graw[j] + ib; lf[j] = logsigmoidf_(graw[2 + j] + fb); }
    const float loc1 = lf[0] + lf[1]; const float s = wave_scan_add(loc1, lane); const float ex = s - loc1;
    r.bb[0] = ex + lf[0]; r.bb[1] = s; r.g = rdlane_f(s, 63);
    r.colw[0] = r.ig[0] - r.bb[0]; r.colw[1] = r.ig[1] - r.bb[1];
    return r;
}
__device__ __forceinline__ MlVec ml_chunk_vec(const float* gates, int row0, int d, int h, float ib, float fb, int lane) {
    MlVec r; float lf[2];
#pragma unroll
    for (int j = 0; j < 2; ++j) { const int u = 2 * lane + j, t = d ? 127 - u : u; const float* gr = gates + (size_t)(row0 + t) * 48;
        r.ig[j] = gr[d * 4 + h] + ib; lf[j] = logsigmoidf_(gr[8 + d * 4 + h] + fb); }
    const float loc1 = lf[0] + lf[1]; const float s = wave_scan_add(loc1, lane); const float ex = s - loc1;
    r.bb[0] = ex + lf[0]; r.bb[1] = s; r.g = rdlane_f(s, 63);
    r.colw[0] = r.ig[0] - r.bb[0]; r.colw[1] = r.ig[1] - r.bb[1];
    return r;
}

__device__ __forceinline__ void phase_ml_states(ArgsRef a, ldsp lds) {
    const int tid = launder((int)threadIdx.x), lane = tid & 63, wave = __builtin_amdgcn_readfirstlane(tid >> 6), G = gridDim.x;
    const bf16_t* Kb = (const bf16_t*)(a.ws + WS_K); const bf16_t* Vb = (const bf16_t*)(a.ws + WS_V);
    const float* gates = (const float*)(a.ws + WS_GATES); float* ms = (float*)(a.ws + WS_MSTAT);
    bf16_t* ST = (bf16_t*)a.out;
    ldsp Kt = lds, Vt = lds + 36864; LAS float* wv = (LAS float*)(lds + 106496);
    u32x4 kreg[4], vreg[8];
    auto issue_tiles = [&](int item) {
        const int c = item % NC, h = (item / NC) % 4, b = item / (NC * 4); const int row0 = b * SEQ + c * CH;
#pragma unroll
        for (int i = 0; i < 4; ++i) { const int id = tid + 512 * i, r = id >> 4, ch = id & 15; kreg[i] = *(const u32x4*)(Kb + (size_t)(row0 + r) * 512 + h * 128 + ch * 8); }
#pragma unroll
        for (int i = 0; i < 8; ++i) { const int id = tid + 512 * i, r = id >> 5, ch = id & 31; vreg[i] = *(const u32x4*)(Vb + (size_t)(row0 + r) * 1024 + h * 256 + ch * 8); }
    };
    if (wp_i0(4 * NC) < wp_end(4 * NC, BATCH)) issue_tiles(wp_i0(4 * NC));
    for (int item = wp_i0(4 * NC); item < wp_end(4 * NC, BATCH); item += wp_step()) {
        const int c = item % NC, h = (item / NC) % 4, b = item / (NC * 4); const int row0 = b * SEQ + c * CH;
        TSEG_BEGIN(35);
#pragma unroll
        for (int i = 0; i < 4; ++i) { const int id = tid + 512 * i, r = id >> 4, ch = id & 15; *(LAS u32x4*)(Kt + r * P128 + ch * 16) = kreg[i]; }
#pragma unroll
        for (int i = 0; i < 8; ++i) { const int id = tid + 512 * i, r = id >> 5, ch = id & 31; *(LAS u32x4*)(Vt + r * P256 + ch * 16) = vreg[i]; }
        if (wave < 2) {
            const int d = wave; const MlVec v = ml_chunk_vec(gates, row0, d, h, a.in[I_MLIB][d * 4 + h], a.in[I_MLFB][d * 4 + h], lane);
            const float a0 = v.g + v.colw[0], a1 = v.g + v.colw[1]; const float ml = wave_max(fmaxf(a0, a1));
#pragma unroll
            for (int j = 0; j < 2; ++j) { const int u = 2 * lane + j, t = d ? 127 - u : u; wv[d * 128 + t] = __expf((j ? a1 : a0) - ml); }
            if (lane == 0) { const int chain = (b * 4 + h) * 2 + d; ms[MS_GM + (chain * 32 + c) * 2] = v.g; ms[MS_GM + (chain * 32 + c) * 2 + 1] = ml; }
        }
        LDS_BARRIER();
        if (item + wp_step() < wp_end(4 * NC, BATCH)) issue_tiles(item + wp_step());
        TSEG_END(35); TSEG_BEGIN(36);
        if (tid < 256) { const int d = tid >> 7, dk = tid & 127; float s = 0.f;
            for (int r = 0; r < 128; ++r) s += wv[d * 128 + r] * bf2f(*(const LAS short*)(Kt + r * P128 + dk * 2));
            ms[MS_U + (size_t)(((b * 4 + h) * 2 + d) * 32 + c) * 128 + dk] = s; }
        TSEG_END(36); TSEG_BEGIN(37);
        { const int d = wave >> 2, qd = wave & 3;
          bf16_t* out = ST + ((size_t)(((b * 4 + h) * 2 + d) * 32 + c) * 256 + 64 * qd) * 128;
          chunk_state_gemm(Kt, P128, Vt + 64 * qd * 2, P256, wv + d * 128, out, lane); }
        LDS_BARRIER();
        TSEG_END(37);
    }
}

template <bool ML, bool REV>
__device__ __forceinline__ void scan_chain(const float* ms, const bf16_t* base, bf16_t* wbase, int chain, float (&st)[8], float& m) {
    constexpr int E = ML ? 32768 : 8192;
#pragma unroll 1
    for (int half = 0; half < 2; ++half) {
        const int cb0 = (REV ? 1 - half : half) * 16;
        u32x4 buf[16]; float dcy[16], scl[16];
#pragma unroll
        for (int j = 0; j < 16; ++j) buf[j] = *(const u32x4*)(base + (size_t)(cb0 + j) * E);
#pragma unroll
        for (int j = 0; j < 16; ++j) { const int c = cb0 + j;
            if (ML) { dcy[j] = ms[MS_GM + (chain * 32 + c) * 2]; scl[j] = ms[MS_GM + (chain * 32 + c) * 2 + 1]; }
            else { dcy[j] = ms[MS_SD + chain * 32 + c]; scl[j] = 1.f; } }
#pragma unroll
        for (int step = 0; step < 16; ++step) {
            const int j = REV ? 15 - step : step; const int c = cb0 + j;
            const u32x4 cur = buf[j];
            float decay = dcy[j], scale = scl[j];
            if (ML) { const float g = decay, ml = scale; const float mn = fmaxf(g + m, ml); decay = __expf(g + m - mn); scale = __expf(ml - mn); m = mn; }
            u32x4 o; o.x = pk2(st[0], st[1]); o.y = pk2(st[2], st[3]); o.z = pk2(st[4], st[5]); o.w = pk2(st[6], st[7]);
            *(u32x4*)(wbase + (size_t)c * E) = o;
            st[0] = decay * st[0] + scale * bflo(cur.x); st[1] = decay * st[1] + scale * bfhi(cur.x);
            st[2] = decay * st[2] + scale * bflo(cur.y); st[3] = decay * st[3] + scale * bfhi(cur.y);
            st[4] = decay * st[4] + scale * bflo(cur.z); st[5] = decay * st[5] + scale * bfhi(cur.z);
            st[6] = decay * st[6] + scale * bflo(cur.w); st[7] = decay * st[7] + scale * bfhi(cur.w);
        }
    }
}

template <bool ML>
__device__ __forceinline__ void phase_scan(ArgsRef a, ldsp lds, bool dry = false) {
    const int tid = launder((int)threadIdx.x), G = gridDim.x;
    float* ms = (float*)(a.ws + WS_MSTAT); bf16_t* ST = (bf16_t*)a.out;
    constexpr int E = ML ? 32768 : 8192, VPC = E / 8, NCHAIN = ML ? 64 : 256, NV = NCHAIN * VPC, NX = ML ? 64 * 128 : 0;
    volatile LAS unsigned* mw = (volatile LAS unsigned*)(lds + MISC_OFF);
    const bool uni = !dry && mw[9] != 0u;
    const int xq = uni ? (int)mw[10] : 0, rk = uni ? (int)mw[11] : (int)blockIdx.x, stp = uni ? (int)mw[0] : G;
    constexpr int PV = NV / BATCH, PX = NX / BATCH;
    const int lim = uni ? PV + PX : (dry ? NV / 2 : NV + NX);
    for (int li = rk * 512 + tid; li < lim; li += stp * 512) {
        const int it = uni ? (li < PV ? xq * PV + (ML ? PV - 1 - li : li) : NV + xq * PX + (li - PV)) : li;
        if (it < NV) {
            const int chain = it / VPC, vi = it % VPC, d = chain & 1;
            float st[8];
#pragma unroll
            for (int j = 0; j < 8; ++j) st[j] = 0.f;
            float m = NEG_BIG;
            bf16_t* base = ST + (size_t)chain * 32 * E + vi * 8;
            bf16_t* wbase = dry ? (bf16_t*)(a.ws + WS_XB) + (base - ST) : base;
            if (d == 0) scan_chain<ML, false>(ms, base, wbase, chain, st, m);
            else scan_chain<ML, true>(ms, base, wbase, chain, st, m);
        } else if (ML) {
            const int idx = it - NV, chain = idx >> 7, dk = idx & 127, d = chain & 1;
            float gv[32], mlv[32], uv[32], nv[32], mv[32];
#pragma unroll
            for (int step = 0; step < 32; ++step) { const int c = d ? 31 - step : step;
                gv[step] = ms[MS_GM + (chain * 32 + c) * 2]; mlv[step] = ms[MS_GM + (chain * 32 + c) * 2 + 1]; uv[step] = ms[MS_U + (size_t)(chain * 32 + c) * 128 + dk]; }
            float n = 0.f, m = NEG_BIG;
#pragma unroll
            for (int step = 0; step < 32; ++step) {
                const float mn = fmaxf(gv[step] + m, mlv[step]);
                const float decay = __expf(gv[step] + m - mn), scale = __expf(mlv[step] - mn);
                nv[step] = n; mv[step] = m;
                n = decay * n + scale * uv[step]; m = mn;
            }
#pragma unroll
            for (int step = 0; step < 32; ++step) { const int c = d ? 31 - step : step;
                ms[MS_U + (size_t)(chain * 32 + c) * 128 + dk] = nv[step];
                if (dk == 0) ms[MS_MP + chain * 32 + c] = mv[step]; }
        }
    }
}

__device__ __forceinline__ void phase_ml_out(ArgsRef a, ldsp lds, int dry = 0) {
    const int tid_ = launder((int)threadIdx.x), lane = tid_ & 63, wave = __builtin_amdgcn_readfirstlane(tid_ >> 6), G = gridDim.x;
    const int fr_ = lane & 15, fq_ = lane >> 4;
    const bf16_t* Qb = (const bf16_t*)(a.ws + WS_Q); const bf16_t* Kb = (const bf16_t*)(a.ws + WS_K); const bf16_t* Vb = (const bf16_t*)(a.ws + WS_V);
    bf16_t* OZ = (bf16_t*)(a.ws + WS_OZ);
    const float* gates = (const float*)(a.ws + WS_GATES); const float* ms = (const float*)(a.ws + WS_MSTAT);
    const bf16_t* ST = (const bf16_t*)a.out;
    ldsp Qt = lds, Kt = lds + 36864, Xt = lds + 73728;
    LAS float* vec = (LAS float*)(lds + 147456);
    LAS float* npv = vec + 1280;
    LAS float* nwl = npv + 256;
    for (int i = tid_; i < 1024; i += 512) nwl[i] = a.in[I_MLNW][i];
    u32x4 pre[8];
    float graw[4], mpn;
    auto issue_qk = [&](int item) {
        const int c = item % NC, h = (item / NC) % 4, b = item / (NC * 4); const int row0 = b * SEQ + c * CH; const int tl = launder(tid_);
#pragma unroll
        for (int i = 0; i < 4; ++i) { const int id = tl + 512 * i, r = id >> 4, ch = id & 15;
            pre[i] = *(const u32x4*)(Qb + (size_t)(row0 + r) * 512 + h * 128 + ch * 8); pre[4 + i] = *(const u32x4*)(Kb + (size_t)(row0 + r) * 512 + h * 128 + ch * 8); }
        const int chain0n = (b * 4 + h) * 2;
        if (wave < 2) { const int d = wave;
#pragma unroll
            for (int j = 0; j < 2; ++j) { const int u = 2 * lane + j, t = d ? 127 - u : u; const float* gr = gates + (size_t)(row0 + t) * 48; graw[j] = gr[d * 4 + h]; graw[2 + j] = gr[8 + d * 4 + h]; }
            mpn = ms[MS_MP + (chain0n + d) * 32 + c]; }
        else if (wave < 6) { const int i2 = tl - 128; const int d = i2 >> 7, dk = i2 & 127; mpn = ms[MS_U + (size_t)((chain0n + d) * 32 + c) * 128 + dk]; }
    };
    if (wp_i0(4 * NC) < wp_end(4 * NC, BATCH)) issue_qk(wp_i0(4 * NC));
    for (int item = wp_i0(4 * NC); item < wp_end(4 * NC, BATCH); item += wp_step()) {
        const int c = item % NC, h = (item / NC) % 4, b = item / (NC * 4); const int row0 = b * SEQ + c * CH;
        const int chain0 = (b * 4 + h) * 2;
        const int fr = launder(fr_), fq = launder(fq_), g4 = fq, q4 = fr >> 2, p4 = fr & 3;
        const int tid = launder(tid_);
        TSEG_BEGIN(1); TSEG_BEGIN(9);
#pragma unroll
        for (int i = 0; i < 4; ++i) { const int id = tid + 512 * i, r = id >> 4, ch = id & 15;
            *(LAS u32x4*)(Qt + r * P128R + ch * 16) = pre[i]; *(LAS u32x4*)(Kt + r * P128R + ch * 16) = pre[4 + i]; }
#pragma unroll
        for (int i = 0; i < 8; ++i) { const int id = tid + 512 * i, r = id >> 5, ch = id & 31; pre[i] = *(const u32x4*)(Vb + (size_t)(row0 + r) * 1024 + h * 256 + ch * 8); }
        { const bf16_t* cp = ST + (size_t)((chain0 + 0) * 32 + c) * 32768;
#pragma unroll
          for (int i = 0; i < 8; ++i) { const int id = tid + 512 * i, r = id >> 4, ch = id & 15;
              *(LAS u32x4*)(Xt + r * P128R + ch * 16) = *(const u32x4*)(cp + (size_t)r * 128 + ch * 8); } }
        if (wave < 2) {
            const int d = wave; const MlVec v = ml_chunk_vec_raw(graw, a.in[I_MLIB][d * 4 + h], a.in[I_MLFB][d * 4 + h], lane);
            const float mp = mpn;
            const float cm1 = fmaxf(v.colw[0], v.colw[1]); const float sc = wave_scan_max(cm1, lane); float ex = dpp_f<0x138>(sc); if (lane == 0) ex = NEG_BIG;
            const float cmax[2] = {fmaxf(ex, v.colw[0]), sc};
#pragma unroll
            for (int j = 0; j < 2; ++j) { const int u = 2 * lane + j, t = d ? 127 - u : u; const float ro = fmaxf(mp, cmax[j]);
                LAS float* vd = vec + d * 640;
                vd[t] = v.colw[j]; vd[128 + t] = ro; vd[256 + t] = __expf(mp - ro); vd[384 + t] = __expf(-(v.bb[j] + ro)); }
        } else if (wave < 6) {
            const int i2 = tid - 128; const int d = i2 >> 7, dk = i2 & 127; npv[d * 128 + dk] = mpn;
        }
        LDS_BARRIER();
        TSEG_END(1); TSEG_BEGIN(2);
        if (dry == 2) { LDS_BARRIER(); continue; }

        { const int pr = tid >> 1, part = tid & 1, d = pr >> 7, t = pr & 127; float s = 0.f;
          for (int k = 0; k < 64; ++k) { const int dk = part * 64 + k; s += bf2f(*(const LAS short*)(Qt + t * P128R + dk * 2)) * npv[d * 128 + dk]; }
          s += dpp_f<0xB1>(s); if (part == 0) vec[d * 640 + 512 + t] = s; }
        f32x4 sacc[8];
#pragma unroll
        for (int i = 0; i < 8; ++i) sacc[i] = (f32x4){0.f, 0.f, 0.f, 0.f};
        bf16x8 qf[4];
#pragma unroll
        for (int ks = 0; ks < 4; ++ks) qf[ks] = *(const LAS bf16x8*)(Qt + (16 * wave + fr) * P128R + (32 * ks + 8 * fq) * 2);
#pragma unroll
        for (int ks = 0; ks < 4; ++ks)
#pragma unroll
            for (int i = 0; i < 8; ++i) { const bf16x8 kf = *(const LAS bf16x8*)(Kt + (16 * i + fr) * P128R + (32 * ks + 8 * fq) * 2);
                sacc[i] = __builtin_amdgcn_mfma_f32_16x16x32_bf16(kf, qf[ks], sacc[i], 0, 0, 0); }
        LDS_BARRIER();
        TSEG_END(2); TSEG_BEGIN(3);
        if (dry == 3) { asm volatile("" :: "v"(sacc[0]), "v"(sacc[1]), "v"(sacc[2]), "v"(sacc[3]), "v"(sacc[4]), "v"(sacc[5]), "v"(sacc[6]), "v"(sacc[7])); LDS_BARRIER(); continue; }
        const int t = 16 * wave + fr;
        const float rof = vec[128 + t], rob = vec[640 + 128 + t];
        float rsf = 0.f, rsb = 0.f;
#pragma unroll
        for (int i = 0; i < 8; ++i) {
            if (i < wave) { const f32x4 cwf = *(const LAS f32x4*)(vec + 16 * i + 4 * fq);
#pragma unroll
                for (int r = 0; r < 4; ++r) rsf += sacc[i][r] * __expf(cwf[r] - rof); }
            else if (i > wave) { const f32x4 cwb = *(const LAS f32x4*)(vec + 640 + 16 * i + 4 * fq);
#pragma unroll
                for (int r = 0; r < 4; ++r) rsb += sacc[i][r] * __expf(cwb[r] - rob); }
            else { const f32x4 cwf = *(const LAS f32x4*)(vec + 16 * i + 4 * fq), cwb = *(const LAS f32x4*)(vec + 640 + 16 * i + 4 * fq);
#pragma unroll
                for (int r = 0; r < 4; ++r) { const int s = 16 * i + 4 * fq + r; const float sv = sacc[i][r];
                    float ef = __expf(fminf(cwf[r] - rof, 0.f)), eb = __expf(fminf(cwb[r] - rob, 0.f));
                    ef = (s <= t) ? ef : 0.f; eb = (s >= t) ? eb : 0.f;
                    rsf += sv * ef; rsb += sv * eb; } }
        }
        rsf = fq_sum(rsf); rsb = fq_sum(rsb);
        const float iwf = vec[256 + t], iwb = vec[640 + 256 + t];
        const float denf = rsf + iwf * vec[512 + t], denb = rsb + iwb * vec[640 + 512 + t];
        const float rinvf = 1.f / fmaxf(fabsf(denf), vec[384 + t]), rinvb = 1.f / fmaxf(fabsf(denb), vec[640 + 384 + t]);
        const float cf = iwf * rinvf, cb = iwb * rinvb;
        asm volatile("" ::: "memory");
        { const int fq2 = launder(fq), t2 = launder(t);
#pragma unroll
        for (int i = 0; i < 8; ++i) { float pv[4];
            if (i < wave) { const f32x4 cwf = *(const LAS f32x4*)(vec + 16 * i + 4 * fq2);
#pragma unroll
                for (int r = 0; r < 4; ++r) pv[r] = sacc[i][r] * (__expf(cwf[r] - rof) * rinvf); }
            else if (i > wave) { const f32x4 cwb = *(const LAS f32x4*)(vec + 640 + 16 * i + 4 * fq2);
#pragma unroll
                for (int r = 0; r < 4; ++r) pv[r] = sacc[i][r] * (__expf(cwb[r] - rob) * rinvb); }
            else { const f32x4 cwf = *(const LAS f32x4*)(vec + 16 * i + 4 * fq2), cwb = *(const LAS f32x4*)(vec + 640 + 16 * i + 4 * fq2);
#pragma unroll
                for (int r = 0; r < 4; ++r) { const int s = 16 * i + 4 * fq2 + r;
                    float ef = __expf(fminf(cwf[r] - rof, 0.f)), eb = __expf(fminf(cwb[r] - rob, 0.f));
                    ef = (s <= t2) ? ef : 0.f; eb = (s >= t2) ? eb : 0.f;
                    pv[r] = sacc[i][r] * (ef * rinvf + eb * rinvb); } }
            u32x2 o; o.x = pk2(pv[0], pv[1]); o.y = pk2(pv[2], pv[3]);
            *(LAS u32x2*)(Kt + t2 * P128R + (16 * i + 4 * fq2) * 2) = o; } }
        asm volatile("" ::: "memory");
        f32x4 hacc[16];
#pragma unroll
        for (int n = 0; n < 16; ++n) hacc[n] = (f32x4){0.f, 0.f, 0.f, 0.f};
#pragma unroll
        for (int nh = 0; nh < 2; ++nh) {
#pragma unroll
            for (int ks = 0; ks < 4; ++ks)
#pragma unroll
                for (int n = 8 * nh; n < 8 * nh + 8; ++n) { const bf16x8 cfr = *(const LAS bf16x8*)(Xt + (16 * n + fr) * P128R + (32 * ks + 8 * fq) * 2);
                    hacc[n] = __builtin_amdgcn_mfma_f32_16x16x32_bf16(cfr, qf[ks], hacc[n], 0, 0, 0); }
            asm volatile("" ::: "memory");
        }
#pragma unroll
        for (int n = 0; n < 16; ++n) hacc[n] = hacc[n] * cf;
        LDS_BARRIER();
        TSEG_END(3); TSEG_BEGIN(4);
        if (dry == 4) {
#pragma unroll
            for (int n = 0; n < 16; ++n) asm volatile("" :: "v"(hacc[n]));
            continue; }
        { const bf16_t* cp = ST + (size_t)((chain0 + 1) * 32 + c) * 32768;
#pragma unroll
          for (int i = 0; i < 8; ++i) { const int id = tid + 512 * i, r = id >> 4, ch = id & 15;
              *(LAS u32x4*)(Xt + r * P128R + ch * 16) = *(const u32x4*)(cp + (size_t)r * 128 + ch * 8); } }
        LDS_BARRIER();
        TSEG_END(4); TSEG_BEGIN(5);
#pragma unroll
        for (int nh = 0; nh < 4; ++nh) {
            f32x4 tacc[4];
#pragma unroll
            for (int n = 0; n < 4; ++n) tacc[n] = (f32x4){0.f, 0.f, 0.f, 0.f};
#pragma unroll
            for (int ks = 0; ks < 4; ++ks)
#pragma unroll
                for (int n = 0; n < 4; ++n) { const bf16x8 cfr = *(const LAS bf16x8*)(Xt + (16 * (4 * nh + n) + fr) * P128R + (32 * ks + 8 * fq) * 2);
                    tacc[n] = __builtin_amdgcn_mfma_f32_16x16x32_bf16(cfr, qf[ks], tacc[n], 0, 0, 0); }
#pragma unroll
            for (int n = 0; n < 4; ++n) hacc[4 * nh + n] = hacc[4 * nh + n] + tacc[n] * cb;
            asm volatile("" ::: "memory");
        }
        LDS_BARRIER();
        TSEG_END(5); TSEG_BEGIN(6);
        if (dry == 5) {
#pragma unroll
            for (int n = 0; n < 16; ++n) asm volatile("" :: "v"(hacc[n]));
            continue; }
#pragma unroll
        for (int i = 0; i < 8; ++i) { const int id = tid + 512 * i, r = id >> 5, ch = id & 31; *(LAS u32x4*)(Xt + r * P256 + ch * 16) = pre[i]; }
        if (item + wp_step() < wp_end(4 * NC, BATCH)) issue_qk(item + wp_step());
        bf16_t* orow = OZ + (size_t)(row0 + t) * 2048 + h * 256;
        u32x4 ovv[8];
#pragma unroll
        for (int m = 0; m < 8; ++m) ovv[m] = *(const u32x4*)(orow + 16 * (2 * m + (fq & 1)) + 8 * (fq >> 1));
        LDS_BARRIER();
        TSEG_END(6); TSEG_BEGIN(7);
#pragma unroll
        for (int ks = 0; ks < 4; ++ks) {
            const bf16x8 pf = *(const LAS bf16x8*)(Kt + t * P128R + (32 * ks + 8 * fq) * 2);
#pragma unroll
            for (int n = 0; n < 16; ++n) { ldscp ad = Xt + (32 * ks + 8 * g4 + q4) * P256 + (16 * n + 4 * p4) * 2;
                const bf16x8 vf = cat8(vtr(ad), vtr(ad + 4 * P256));
                hacc[n] = __builtin_amdgcn_mfma_f32_16x16x32_bf16(vf, pf, hacc[n], 0, 0, 0); }
        }
        TSEG_END(7); TSEG_BEGIN(8);
        if (dry == 6) {
#pragma unroll
            for (int n = 0; n < 16; ++n) asm volatile("" :: "v"(hacc[n]));
            LDS_BARRIER(); continue; }
        float s1 = 0.f;
#pragma unroll
        for (int n = 0; n < 16; ++n) s1 += (hacc[n][0] + hacc[n][1]) + (hacc[n][2] + hacc[n][3]);
        s1 = fq_sum(s1);
        const float mu = s1 * (1.f / 256.f); float s2 = 0.f;
#pragma unroll
        for (int n = 0; n < 16; ++n) { const f32x4 dd = hacc[n] - mu; s2 += (dd[0] * dd[0] + dd[1] * dd[1]) + (dd[2] * dd[2] + dd[3] * dd[3]); }
        s2 = fq_sum(s2);
        const float rstd = 1.f / sqrtf(s2 * (1.f / 256.f) + LN_EPS);
        bf16_t* owr = dry ? (bf16_t*)(a.ws + WS_XB) + (size_t)(row0 + t) * 1024 + h * 256 : orow;
        const LAS float* nw = nwl + h * 256;
#pragma unroll
        for (int m = 0; m < 8; ++m) {
            unsigned ua0 = __builtin_bit_cast(unsigned, (hacc[2 * m][0] - mu) * rstd), ua1 = __builtin_bit_cast(unsigned, (hacc[2 * m][1] - mu) * rstd);
            unsigned ua2 = __builtin_bit_cast(unsigned, (hacc[2 * m][2] - mu) * rstd), ua3 = __builtin_bit_cast(unsigned, (hacc[2 * m][3] - mu) * rstd);
            unsigned ub0 = __builtin_bit_cast(unsigned, (hacc[2 * m + 1][0] - mu) * rstd), ub1 = __builtin_bit_cast(unsigned, (hacc[2 * m + 1][1] - mu) * rstd);
            unsigned ub2 = __builtin_bit_cast(unsigned, (hacc[2 * m + 1][2] - mu) * rstd), ub3 = __builtin_bit_cast(unsigned, (hacc[2 * m + 1][3] - mu) * rstd);
            { const auto sw = __builtin_amdgcn_permlane16_swap(ua0, ub0, false, false); ua0 = sw[0]; ub0 = sw[1]; }
            { const auto sw = __builtin_amdgcn_permlane16_swap(ua1, ub1, false, false); ua1 = sw[0]; ub1 = sw[1]; }
            { const auto sw = __builtin_amdgcn_permlane16_swap(ua2, ub2, false, false); ua2 = sw[0]; ub2 = sw[1]; }
            { const auto sw = __builtin_amdgcn_permlane16_swap(ua3, ub3, false, false); ua3 = sw[0]; ub3 = sw[1]; }
            const float a0 = __builtin_bit_cast(float, ua0), a1 = __builtin_bit_cast(float, ua1), a2 = __builtin_bit_cast(float, ua2), a3 = __builtin_bit_cast(float, ua3);
            const float b0 = __builtin_bit_cast(float, ub0), b1 = __builtin_bit_cast(float, ub1), b2 = __builtin_bit_cast(float, ub2), b3 = __builtin_bit_cast(float, ub3);
            const int dv = 16 * (2 * m + (fq & 1)) + 8 * (fq >> 1); const u32x4 ov = ovv[m];
            const f32x4 wa = *(const LAS f32x4*)(nw + dv), wb = *(const LAS f32x4*)(nw + dv + 4);
            u32x4 o;
            o.x = pk2(a0 * wa[0] * sigmoidf_(bflo(ov.x)), a1 * wa[1] * sigmoidf_(bfhi(ov.x))); o.y = pk2(a2 * wa[2] * sigmoidf_(bflo(ov.y)), a3 * wa[3] * sigmoidf_(bfhi(ov.y)));
            o.z = pk2(b0 * wb[0] * sigmoidf_(bflo(ov.z)), b1 * wb[1] * sigmoidf_(bfhi(ov.z))); o.w = pk2(b2 * wb[2] * sigmoidf_(bflo(ov.w)), b3 * wb[3] * sigmoidf_(bfhi(ov.w)));
            if (dry == 7) asm volatile("" :: "v"(o)); else *(u32x4*)(owr + dv) = o; }
        LDS_BARRIER();
        TSEG_END(8); TSEG_END(9);
    }
}

__device__ __forceinline__ void ssd_conv_issue(ArgsRef a, int b, int c, int g, int want, u32x4 (&rows)[20]) {
    const int tid = launder((int)threadIdx.x), ch64 = tid & 63, strip = tid >> 6;
    int col; bool on;
    if (ch64 < 32) { col = 256 * g + 8 * ch64; on = want & 1; }
    else if (ch64 < 48) { col = 1024 + 128 * g + 8 * (ch64 - 32); on = want & 2; }
    else { col = 1536 + 128 * g + 8 * (ch64 - 48); on = want & 4; }
    if (!on) return;
    const bf16_t* X = (const bf16_t*)(a.ws + WS_XBC) + (size_t)b * SEQ * 2048 + col;
    const int t0 = c * CH + strip * 16;
#pragma unroll
    for (int j = 0; j < 20; ++j) { const int tt = t0 - 2 + j; const int tc = tt < 0 ? 0 : (tt >= SEQ ? SEQ - 1 : tt);
        const u32x4 v = *(const u32x4*)(X + (size_t)tc * 2048); rows[j] = (tt >= 0 && tt < SEQ) ? v : (u32x4){0u, 0u, 0u, 0u}; }
}
__device__ __forceinline__ void ssd_conv_weights(ArgsRef a, int g, LAS float* cwl) {
    const int tid = launder((int)threadIdx.x);
    for (int e = tid; e < 6 * 512; e += 512) { const int j = e >> 9, ch = e & 511; const int col = ch < 256 ? 256 * g + ch : (ch < 384 ? 1024 + 128 * g + (ch - 256) : 1536 + 128 * g + (ch - 384));
        cwl[e] = j < 5 ? a.in[I_CONVW][j * 2048 + col] : a.in[I_CONVB][col]; }
}
template <bool LDSW>
__device__ __forceinline__ void ssd_conv_finish(ArgsRef a, int g, const LAS float* cwl, ldsp Xt, ldsp Bt, ldsp Ct, int want, int pitchBC, const u32x4 (&rows)[20]) {
    const int tid = launder((int)threadIdx.x), ch64 = tid & 63, strip = tid >> 6;
    int col, pitch; ldsp dst; bool on;
    if (ch64 < 32) { col = 256 * g + 8 * ch64; dst = Xt + ch64 * 16; pitch = P256; on = want & 1; }
    else if (ch64 < 48) { col = 1024 + 128 * g + 8 * (ch64 - 32); dst = Bt + (ch64 - 32) * 16; pitch = pitchBC; on = want & 2; }
    else { col = 1536 + 128 * g + 8 * (ch64 - 48); dst = Ct + (ch64 - 48) * 16; pitch = pitchBC; on = want & 4; }
    if (!on) return;
    f32x2 w2[5][4], bias2[4];
    if constexpr (LDSW) {
        const LAS float* cw = cwl + 8 * ch64;
#pragma unroll
        for (int j = 0; j < 5; ++j) { const f32x4 w0 = *(const LAS f32x4*)(cw + j * 512), w1 = *(const LAS f32x4*)(cw + j * 512 + 4);
            w2[j][0] = (f32x2){w0[0], w0[1]}; w2[j][1] = (f32x2){w0[2], w0[3]}; w2[j][2] = (f32x2){w1[0], w1[1]}; w2[j][3] = (f32x2){w1[2], w1[3]}; }
        { const f32x4 b0 = *(const LAS f32x4*)(cw + 5 * 512), b1 = *(const LAS f32x4*)(cw + 5 * 512 + 4); bias2[0] = (f32x2){b0[0], b0[1]}; bias2[1] = (f32x2){b0[2], b0[3]}; bias2[2] = (f32x2){b1[0], b1[1]}; bias2[3] = (f32x2){b1[2], b1[3]}; }
    } else {
        const float* cw = a.in[I_CONVW] + col; const float* cbp = a.in[I_CONVB] + col;
#pragma unroll
        for (int j = 0; j < 5; ++j) { const f32x4 w0 = *(const f32x4*)(cw + j * 2048), w1 = *(const f32x4*)(cw + j * 2048 + 4);
            w2[j][0] = (f32x2){w0[0], w0[1]}; w2[j][1] = (f32x2){w0[2], w0[3]}; w2[j][2] = (f32x2){w1[0], w1[1]}; w2[j][3] = (f32x2){w1[2], w1[3]}; }
        { const f32x4 b0 = *(const f32x4*)cbp, b1 = *(const f32x4*)(cbp + 4); bias2[0] = (f32x2){b0[0], b0[1]}; bias2[1] = (f32x2){b0[2], b0[3]}; bias2[2] = (f32x2){b1[0], b1[1]}; bias2[3] = (f32x2){b1[2], b1[3]}; }
    }
#pragma unroll
    for (int r = 0; r < 16; ++r) {
        f32x2 o2[4];
#pragma unroll
        for (int e = 0; e < 4; ++e) o2[e] = bias2[e];
#pragma unroll
        for (int j = 0; j < 5; ++j) { const u32x4 v = rows[r + j];
            o2[0] += w2[j][0] * (f32x2){bflo(v.x), bfhi(v.x)}; o2[1] += w2[j][1] * (f32x2){bflo(v.y), bfhi(v.y)};
            o2[2] += w2[j][2] * (f32x2){bflo(v.z), bfhi(v.z)}; o2[3] += w2[j][3] * (f32x2){bflo(v.w), bfhi(v.w)}; }
        u32x4 pk;
#pragma unroll
        for (int e = 0; e < 4; ++e) { const f32x2 ng = o2[e] * -1.4426950408889634f; f32x2 ex; ex.x = __builtin_amdgcn_exp2f(ng.x); ex.y = __builtin_amdgcn_exp2f(ng.y);
            const f32x2 dn = ex + 1.0f; f32x2 rc; rc.x = __builtin_amdgcn_rcpf(dn.x); rc.y = __builtin_amdgcn_rcpf(dn.y); const f32x2 sv = o2[e] * rc;
            pk[e] = pk2(sv.x, sv.y); }
        *(LAS u32x4*)(dst + (strip * 16 + r) * pitch) = pk;
    }
}
__device__ __forceinline__ void ssd_conv_tiles(ArgsRef a, int b, int c, int g, ldsp Xt, ldsp Bt, ldsp Ct, int want, int pitchBC) {
    u32x4 rows[20];
    ssd_conv_issue(a, b, c, g, want, rows);
    ssd_conv_finish<false>(a, g, nullptr, Xt, Bt, Ct, want, pitchBC, rows);
}

struct SsVec { float dt[2], ac[2]; float tot; };
__device__ __forceinline__ SsVec ss_chunk_vec(const float (&graw)[2], float dtb, float A, int lane) {
    SsVec r; float da[2];
#pragma unroll
    for (int j = 0; j < 2; ++j) { r.dt[j] = softplusf_(graw[j] + dtb); da[j] = r.dt[j] * A; }
    const float loc1 = da[0] + da[1]; const float s = wave_scan_add(loc1, lane); const float ex = s - loc1;
    r.ac[0] = ex + da[0]; r.ac[1] = s; r.tot = rdlane_f(s, 63);
    return r;
}

__device__ __forceinline__ void phase_ssd_states(ArgsRef a, ldsp lds) {
    const int tid = launder((int)threadIdx.x), lane = tid & 63, wave = __builtin_amdgcn_readfirstlane(tid >> 6), G = gridDim.x;
    const float* gates = (const float*)(a.ws + WS_GATES); float* ms = (float*)(a.ws + WS_MSTAT);
    bf16_t* ST = (bf16_t*)a.out;
    ldsp Bt = lds, Xt = lds + 36864; LAS float* wv = (LAS float*)(lds + 106496);
    LAS float* cwl = (LAS float*)(lds + 110592); int cw_g = -1;
    u32x4 rows[20]; float graw[2], dtb_n, alog_n;
    auto issue_item = [&](int item) {
        const int g = item % 4, c = (item / 4) % NC, b = item / (4 * NC); const int row0 = b * SEQ + c * CH; const int d = wave & 1, h16 = 4 * g + (wave >> 1);
        dtb_n = a.in[I_DTB][d * 16 + h16]; alog_n = a.in[I_ALOG][d * 16 + h16];
#pragma unroll
        for (int j = 0; j < 2; ++j) { const int u = 2 * lane + j, t = d ? 127 - u : u; graw[j] = gates[(size_t)(row0 + t) * 48 + 16 + d * 16 + h16]; }
        ssd_conv_issue(a, b, c, g, 3, rows);
    };
    if (wp_i0(NC * 4) < wp_end(NC * 4, BATCH)) issue_item(wp_i0(NC * 4));
    for (int item = wp_i0(NC * 4); item < wp_end(NC * 4, BATCH); item += wp_step()) {
        const int g = item % 4, c = (item / 4) % NC, b = item / (4 * NC);
        const int hh = wave >> 1, d = wave & 1, h16 = 4 * g + hh;
        TSEG_BEGIN(38);
        if (g != cw_g) { ssd_conv_weights(a, g, cwl); cw_g = g; LDS_BARRIER(); }
        TSEG_BEGIN(81);
        ssd_conv_finish<true>(a, g, cwl, Xt, Bt, Bt, 3, P128, rows);
        TSEG_END(81); TSEG_BEGIN(82);
        { const SsVec v = ss_chunk_vec(graw, dtb_n, -__expf(alog_n), lane);
#pragma unroll
          for (int j = 0; j < 2; ++j) { const int u = 2 * lane + j, t = d ? 127 - u : u; wv[wave * 128 + t] = v.dt[j] * __expf(v.tot - v.ac[j]); }
          if (lane == 0) ms[MS_SD + ((b * 16 + h16) * 2 + d) * 32 + c] = __expf(v.tot); }
        TSEG_END(82); TSEG_BEGIN(83);
        LDS_BARRIER();
        TSEG_END(83);
        TSEG_BEGIN(84);
        if (item + wp_step() < wp_end(NC * 4, BATCH)) issue_item(item + wp_step());
        TSEG_END(84);
        TSEG_END(38); TSEG_BEGIN(39);
        { bf16_t* out = ST + (size_t)(((b * 16 + h16) * 2 + d) * 32 + c) * 8192;
          chunk_state_gemm(Bt, P128, Xt + 64 * hh * 2, P256, wv + wave * 128, out, lane); }
        LDS_BARRIER();
        TSEG_END(39);
    }
}

__device__ __forceinline__ void phase_ssd_out(ArgsRef a, ldsp lds, int dry = 0) {
    const int tid = launder((int)threadIdx.x), lane = tid & 63, wave = __builtin_amdgcn_readfirstlane(tid >> 6), G = gridDim.x;
    const int fr_ = lane & 15, fq_ = lane >> 4;
    const float* gates = (const float*)(a.ws + WS_GATES);
    bf16_t* OZ = (bf16_t*)(a.ws + WS_OZ); const bf16_t* ST = (const bf16_t*)a.out;
    ldsp Ct = lds, Bt = lds + 36864, Xt = lds + 73728;
    LAS float* vec = (LAS float*)(lds + 73728 + 69632);
    static_assert(73728 + 69632 + 8192 + 4096 <= MISC_OFF, "layout");
    LAS float* nwl = vec + 2048;
    for (int i = tid; i < 1024; i += 512) nwl[i] = a.in[I_SSMNW][i];
    for (int item = wp_i0(NC * 4); item < wp_end(NC * 4, BATCH); item += wp_step()) {
        const int g = item % 4, c = (item / 4) % NC, b = item / (4 * NC); const int row0 = b * SEQ + c * CH;
        const int fr = launder(fr_), fq = launder(fq_), g4 = fq, q4 = fr >> 2, p4 = fr & 3;
        TSEG_BEGIN(11); TSEG_BEGIN(20);
        float graw[2];
        { const int hh = wave >> 1, d = wave & 1, h16 = 4 * g + hh;
#pragma unroll
          for (int j = 0; j < 2; ++j) { const int u = 2 * lane + j, t = d ? 127 - u : u; graw[j] = gates[(size_t)(row0 + t) * 48 + 16 + d * 16 + h16]; } }
        ssd_conv_tiles(a, b, c, g, Xt, Bt, Ct, 7, P128R);
        { const int hh = wave >> 1, d = wave & 1, h16 = 4 * g + hh;
          const SsVec v = ss_chunk_vec(graw, a.in[I_DTB][d * 16 + h16], -__expf(a.in[I_ALOG][d * 16 + h16]), lane);
#pragma unroll
          for (int j = 0; j < 2; ++j) { const int u = 2 * lane + j, t = d ? 127 - u : u; vec[wave * 256 + t] = v.ac[j]; vec[wave * 256 + 128 + t] = v.dt[j]; } }
        LDS_BARRIER();
        TSEG_END(11); TSEG_BEGIN(12);
        if (dry == 2) { LDS_BARRIER(); continue; }
        f32x4 cbv[8];
#pragma unroll
        for (int i = 0; i < 8; ++i) cbv[i] = (f32x4){0.f, 0.f, 0.f, 0.f};
        bf16x8 cf[4];
#pragma unroll
        for (int ks = 0; ks < 4; ++ks) cf[ks] = *(const LAS bf16x8*)(Ct + (16 * wave + fr) * P128R + (32 * ks + 8 * fq) * 2);
#pragma unroll
        for (int ks = 0; ks < 4; ++ks)
#pragma unroll
            for (int i = 0; i < 8; ++i) { const bf16x8 bfr = *(const LAS bf16x8*)(Bt + (16 * i + fr) * P128R + (32 * ks + 8 * fq) * 2);
                cbv[i] = __builtin_amdgcn_mfma_f32_16x16x32_bf16(bfr, cf[ks], cbv[i], 0, 0, 0); }
        LDS_BARRIER();
        TSEG_END(12); TSEG_BEGIN(13);
        if (dry == 3) { asm volatile("" :: "v"(cbv[0]), "v"(cbv[1]), "v"(cbv[2]), "v"(cbv[3]), "v"(cbv[4]), "v"(cbv[5]), "v"(cbv[6]), "v"(cbv[7])); continue; }
        const int t = 16 * wave + fr;
        ldsp Ht = Ct;
        u32x4 pre[4];
#pragma unroll
        for (int i = 0; i < 4; ++i) { const int id = tid + 512 * i, d = id >> 10, r = (id >> 4) & 63, ch = id & 15;
            pre[i] = *(const u32x4*)(ST + (size_t)(((b * 16 + 4 * g) * 2 + d) * 32 + c) * 8192 + r * 128 + ch * 8); }
        float s2 = 0.f;
        u32x2 ypk[4][4];
        bf16_t* yrow = dry ? (bf16_t*)(a.ws + WS_XB) + (size_t)(row0 + t) * 1024 + 256 * g : OZ + (size_t)(row0 + t) * 2048 + 1024 + 256 * g;
#pragma unroll
        for (int hh = 0; hh < 4; ++hh) {
            const int h16 = 4 * g + hh;
            TSEG_BEGIN(15);
#pragma unroll
            for (int i = 0; i < 4; ++i) { const int id = tid + 512 * i, d = id >> 10, r = (id >> 4) & 63, ch = id & 15;
                *(LAS u32x4*)(Ht + d * 18432 + r * P128R + ch * 16) = pre[i]; }
            LDS_BARRIER();
            TSEG_END(15); TSEG_BEGIN(16);
            if (hh < 3) {
#pragma unroll
                for (int i = 0; i < 4; ++i) { const int id = tid + 512 * i, d = id >> 10, r = (id >> 4) & 63, ch = id & 15;
                    pre[i] = *(const u32x4*)(ST + (size_t)(((b * 16 + h16 + 1) * 2 + d) * 32 + c) * 8192 + r * 128 + ch * 8); }
            }
            const bf16_t* zrow = OZ + (size_t)(row0 + t) * 2048 + 1024 + 256 * g + 64 * hh;
            u32x2 zpre[4];
#pragma unroll
            for (int n = 0; n < 4; ++n) zpre[n] = *(const u32x2*)(zrow + 16 * n + 4 * fq);
            f32x4 y[4];
            if (dry == 5) {
#pragma unroll
                for (int n = 0; n < 4; ++n) y[n] = (f32x4){0.f, 0.f, 0.f, 0.f};
            } else {
                f32x4 yf[4], yb[4];
#pragma unroll
                for (int n = 0; n < 4; ++n) { yf[n] = (f32x4){0.f, 0.f, 0.f, 0.f}; yb[n] = (f32x4){0.f, 0.f, 0.f, 0.f}; }
#pragma unroll
                for (int ks = 0; ks < 4; ++ks)
#pragma unroll
                    for (int n = 0; n < 4; ++n) {
                        const bf16x8 h0 = *(const LAS bf16x8*)(Ht + (16 * n + fr) * P128R + (32 * ks + 8 * fq) * 2);
                        const bf16x8 h1 = *(const LAS bf16x8*)(Ht + 18432 + (16 * n + fr) * P128R + (32 * ks + 8 * fq) * 2);
                        yf[n] = __builtin_amdgcn_mfma_f32_16x16x32_bf16(h0, cf[ks], yf[n], 0, 0, 0);
                        yb[n] = __builtin_amdgcn_mfma_f32_16x16x32_bf16(h1, cf[ks], yb[n], 0, 0, 0); }
                const float ef = __expf(vec[(hh * 2 + 0) * 256 + t]), eb = __expf(vec[(hh * 2 + 1) * 256 + t]);
#pragma unroll
                for (int n = 0; n < 4; ++n) y[n] = yf[n] * ef + yb[n] * eb;
            }
            TSEG_END(16); TSEG_BEGIN(17);
            if (dry != 4) {
            { const int fq2 = launder(fq), t2 = launder(t);
              const float af = vec[(hh * 2 + 0) * 256 + t2], ab = vec[(hh * 2 + 1) * 256 + t2];
#pragma unroll
              for (int i = 0; i < 8; ++i) { float pv[4]; const LAS float* vb = vec + hh * 512 + 16 * i + 4 * fq2;
                  if (i < wave) { const f32x4 acf = *(const LAS f32x4*)(vb), dtf = *(const LAS f32x4*)(vb + 128);
#pragma unroll
                      for (int r = 0; r < 4; ++r) pv[r] = cbv[i][r] * (__expf(af - acf[r]) * dtf[r]); }
                  else if (i > wave) { const f32x4 acb = *(const LAS f32x4*)(vb + 256), dtb = *(const LAS f32x4*)(vb + 384);
#pragma unroll
                      for (int r = 0; r < 4; ++r) pv[r] = cbv[i][r] * (__expf(ab - acb[r]) * dtb[r]); }
                  else { const f32x4 acf = *(const LAS f32x4*)(vb), dtf = *(const LAS f32x4*)(vb + 128), acb = *(const LAS f32x4*)(vb + 256), dtb = *(const LAS f32x4*)(vb + 384);
#pragma unroll
                      for (int r = 0; r < 4; ++r) { const int s = 16 * i + 4 * fq2 + r;
                          float lf = __expf(fminf(af - acf[r], 0.f)) * dtf[r], lb = __expf(fminf(ab - acb[r], 0.f)) * dtb[r];
                          lf = (s <= t2) ? lf : 0.f; lb = (s >= t2) ? lb : 0.f;
                          pv[r] = cbv[i][r] * (lf + lb); } }
                  u32x2 o; o.x = pk2(pv[0], pv[1]); o.y = pk2(pv[2], pv[3]);
                  *(LAS u32x2*)(Bt + t2 * P128R + (16 * i + 4 * fq2) * 2) = o; } }
            asm volatile("s_waitcnt lgkmcnt(0)" ::: "memory");
            TSEG_END(17); TSEG_BEGIN(18);
#pragma unroll
            for (int ks = 0; ks < 4; ++ks) {
                const bf16x8 pf = *(const LAS bf16x8*)(Bt + t * P128R + (32 * ks + 8 * fq) * 2);
#pragma unroll
                for (int n = 0; n < 4; ++n) { ldscp ad = Xt + (32 * ks + 8 * g4 + q4) * P256 + (64 * hh + 16 * n + 4 * p4) * 2;
                    const bf16x8 xf = cat8(vtr(ad), vtr(ad + 4 * P256));
                    y[n] = __builtin_amdgcn_mfma_f32_16x16x32_bf16(xf, pf, y[n], 0, 0, 0); }
            }
            }
            TSEG_END(18); TSEG_BEGIN(19);
            { const float dsk = a.in[I_DSKIP][h16];
#pragma unroll
              for (int n = 0; n < 4; ++n) { const int p = 16 * n + 4 * fq;
                  const u32x2 xv = *(const LAS u32x2*)(Xt + t * P256 + (64 * hh + p) * 2); const u32x2 zv = zpre[n];
                  f32x4 o;
                  o[0] = (y[n][0] + dsk * bflo(xv.x)) * siluf_(bflo(zv.x)); o[1] = (y[n][1] + dsk * bfhi(xv.x)) * siluf_(bfhi(zv.x));
                  o[2] = (y[n][2] + dsk * bflo(xv.y)) * siluf_(bflo(zv.y)); o[3] = (y[n][3] + dsk * bfhi(xv.y)) * siluf_(bfhi(zv.y));
                  s2 += (o[0] * o[0] + o[1] * o[1]) + (o[2] * o[2] + o[3] * o[3]);
                  u32x2 ow; ow.x = pk2(o[0], o[1]); ow.y = pk2(o[2], o[3]); ypk[hh][n] = ow; } }
            LDS_BARRIER();
            TSEG_END(19);
        }
        TSEG_END(13); TSEG_BEGIN(14);
        s2 = fq_sum(s2);
        const float rs = 1.f / sqrtf(s2 * (1.f / 256.f) + RMS_EPS);
        const LAS float* nw = nwl + 256 * g;
#pragma unroll
        for (int hn = 0; hn < 16; ++hn) { const int ch = 16 * hn + 4 * fq; const f32x4 w4 = *(const LAS f32x4*)(nw + ch); const u32x2 yv = ypk[hn >> 2][hn & 3];
            u32x2 o; o.x = pk2(bflo(yv.x) * rs * w4[0], bfhi(yv.x) * rs * w4[1]); o.y = pk2(bflo(yv.y) * rs * w4[2], bfhi(yv.y) * rs * w4[3]); *(u32x2*)(yrow + ch) = o; }
        LDS_BARRIER();
        TSEG_END(14); TSEG_END(20);
    }
}

constexpr int CONV_ITEMS = 65 * 384, CONV_SEAMS = 7, CONV_SEAM0 = 2, CONV_PER = 2;
struct ConvDesc { const float* W; int ldw, k0, c0; unsigned char* WT; int ldk, r0; float scale; };
__device__ __forceinline__ ConvDesc conv_desc(ArgsRef a, int it) {
    const int e = it / 384, r = it % 384; ConvDesc d;
    if (r < 256) { const int up = r >> 7, q = r & 127, cb = q & 7, kb = q >> 3;
        d.W = up ? (e < 64 ? a.in[I_WEU] + (size_t)e * DM * DE : a.in[I_WSU]) : (e < 64 ? a.in[I_WEG] + (size_t)e * DM * DE : a.in[I_WSG]);
        d.ldw = DE; d.k0 = kb * 64; d.c0 = cb * 32; d.WT = a.ws + WS_W1T + (size_t)e * 512 * DM; d.ldk = DM; d.r0 = 256 * (cb >> 2) + 32 * (cb & 3) + 128 * up; d.scale = W1_SCALE; }
    else { const int q = r - 256, cb = q & 31, kb = q >> 5;
        d.W = e < 64 ? a.in[I_WED] + (size_t)e * DE * DM : a.in[I_WSD];
        d.ldw = DM; d.k0 = kb * 64; d.c0 = cb * 32; d.WT = a.ws + WS_W2T + (size_t)e * DM * DE; d.ldk = DE; d.r0 = cb * 32; d.scale = W2_SCALE; }
    return d;
}
__device__ __forceinline__ void conv_load(const ConvDesc& d, int lane, f32x4 (&tv)[8]) {
#pragma unroll
    for (int i = 0; i < 8; ++i) tv[i] = *(const f32x4*)(d.W + (size_t)(d.k0 + 8 * i + (lane >> 3)) * d.ldw + d.c0 + (lane & 7) * 4);
}
__device__ __forceinline__ void conv_finish(const ConvDesc& d, const f32x4 (&tv)[8], LAS float* scr, int lane) {
#pragma unroll
    for (int i = 0; i < 8; ++i) { LAS float* p = scr + (8 * i + (lane >> 3)) * 33 + (lane & 7) * 4; p[0] = tv[i][0]; p[1] = tv[i][1]; p[2] = tv[i][2]; p[3] = tv[i][3]; }
    asm volatile("s_waitcnt lgkmcnt(0)" ::: "memory");
    const int c = lane & 7; const float scale = d.scale;
#pragma unroll
    for (int j = 0; j < 4; ++j) { const int n = (lane >> 3) + 8 * j; const LAS float* s_ = scr + (8 * c) * 33 + n;
        u32x2 o; o.x = pk4_fp8(s_[0 * 33] * scale, s_[1 * 33] * scale, s_[2 * 33] * scale, s_[3 * 33] * scale); o.y = pk4_fp8(s_[4 * 33] * scale, s_[5 * 33] * scale, s_[6 * 33] * scale, s_[7 * 33] * scale);
        *(u32x2*)(d.WT + (size_t)(d.r0 + n) * d.ldk + d.k0 + 8 * c) = o; }
    asm volatile("s_waitcnt lgkmcnt(0)" ::: "memory");
}
__device__ __forceinline__ void conv_item(ArgsRef a, int it, LAS float* scr, int lane) { const ConvDesc d = conv_desc(a, it); f32x4 tv[8]; conv_load(d, lane, tv); conv_finish(d, tv, scr, lane); }
__device__ __forceinline__ void wout_slice(ArgsRef a, ldsp lds, int wave, int lane) {
    const int r = (int)blockIdx.x * 7 + (wave - 1); if (r >= 32 * 32) return;
    transpose_item(a.in[I_WOUT], DM, (r / 32) * 64, (r % 32) * 32, (bf16_t*)(a.ws + WS_WOUT), 2048, (r % 32) * 32, 1.f, (LAS float*)(lds + wave * 8448), lane);
}
__device__ __forceinline__ void conv_slice(ArgsRef a, ldsp lds, int sl, int wave, int lane) {
    static_assert(CONV_PER == 2, "two items per wave and seam");
    LAS float* scr = (LAS float*)(lds + wave * 8448);
    const int it0 = ((sl * (int)gridDim.x + (int)blockIdx.x) * 7 + (wave - 1)) * CONV_PER, it1 = it0 + 1;
    if (it0 >= CONV_ITEMS) return;
    const ConvDesc d0 = conv_desc(a, it0), d1 = conv_desc(a, it1 < CONV_ITEMS ? it1 : it0);
    f32x4 t0[8], t1[8];
    conv_load(d0, lane, t0); conv_load(d1, lane, t1);
    conv_finish(d0, t0, scr, lane);
    if (it1 < CONV_ITEMS) conv_finish(d1, t1, scr, lane);
}

__device__ __forceinline__ void phase_ln1_router(ArgsRef a, ldsp lds) {
    const int tid = launder((int)threadIdx.x), lane = tid & 63, wave = __builtin_amdgcn_readfirstlane(tid >> 6), G = gridDim.x;
    const int gw = blockIdx.x * 8 + wave, NGW = G * 8;
    TSEG_BEGIN(31);
    {
        LAS float* scr = (LAS float*)(lds + 81920 + wave * 8448);
        for (int it = CONV_SEAMS * G * 7 * CONV_PER + gw; it < CONV_ITEMS; it += NGW) conv_item(a, it, scr, lane);
    }
    LDS_BARRIER();
    TSEG_END(31);
    const bf16_t* r1 = (const bf16_t*)a.out; bf16_t* H = (bf16_t*)(a.ws + WS_H);
    int* sele = (int*)(a.ws + WS_SELE); float* selw = (float*)(a.ws + WS_SELW);
    unsigned* ctl = (unsigned*)(a.ws + WS_CTL);
    constexpr int WPT = 160;
    ldsp Whi = lds, Wlo = lds + 40960;
    LAS float* lg = (LAS float*)(lds + 81920);
    LAS unsigned* cnt = (LAS unsigned*)(lds + 81920 + 33280);
    const float* g1 = a.in[I_LN1G]; const float* b1 = a.in[I_LN1B]; const float* wr = a.in[I_WR];
    const int fr = lane & 15, fq = lane >> 4, q4 = fr >> 2, p4 = fr & 3;
    for (int vb = wp_i0(256 / BATCH); vb < wp_end(256 / BATCH, BATCH); vb += wp_step()) {
        const int tok0 = vb * 128;
        if (tid < 64) cnt[tid] = 0u;
        TSEG_BEGIN(32);
        f32x4 ggv[4], bbv[4];
#pragma unroll
        for (int j = 0; j < 4; ++j) { ggv[j] = *((const f32x4*)g1 + lane + 64 * j); bbv[j] = *((const f32x4*)b1 + lane + 64 * j); }
        for (int rr = 0; rr < 16; rr += 4) {
            f32x4 v[4][4];
#pragma unroll
            for (int q = 0; q < 4; ++q) { const u32x2* xr = (const u32x2*)(r1 + (size_t)(tok0 + 16 * wave + rr + q) * DM) + lane;
#pragma unroll
                for (int j = 0; j < 4; ++j) { const u32x2 w = xr[64 * j]; v[q][j] = (f32x4){bflo(w.x), bfhi(w.x), bflo(w.y), bfhi(w.y)}; } }
#pragma unroll
            for (int q = 0; q < 4; ++q) {
                const int t = tok0 + 16 * wave + rr + q; float s = 0.f;
#pragma unroll
                for (int j = 0; j < 4; ++j) s += (v[q][j].x + v[q][j].y) + (v[q][j].z + v[q][j].w);
                const float mean = wave_sum(s) * (1.f / DM); float s2 = 0.f;
#pragma unroll
                for (int j = 0; j < 4; ++j) { v[q][j] = v[q][j] - mean; s2 += (v[q][j].x * v[q][j].x + v[q][j].y * v[q][j].y) + (v[q][j].z * v[q][j].z + v[q][j].w * v[q][j].w); }
                const float rstd = __builtin_amdgcn_rsqf(wave_sum(s2) * (1.f / DM) + LN_EPS);
                unsigned long long* o8 = (unsigned long long*)(H + (size_t)t * DM) + lane; unsigned* o4 = (unsigned*)(a.ws + WS_H8 + (size_t)t * DM) + lane;
#pragma unroll
                for (int j = 0; j < 4; ++j) { const f32x4 hv = v[q][j] * rstd * ggv[j] + bbv[j];
                    o8[64 * j] = (unsigned long long)pk2(hv.x, hv.y) | ((unsigned long long)pk2(hv.z, hv.w) << 32);
                    const f32x4 h8 = hv * H8_SCALE; o4[64 * j] = pk4_fp8(h8.x, h8.y, h8.z, h8.w); }
            }
        }
        asm volatile("s_waitcnt vmcnt(0)" ::: "memory");
        TSEG_END(32); TSEG_BEGIN(33);
        f32x4 lacc[4];
#pragma unroll
        for (int nt = 0; nt < 4; ++nt) lacc[nt] = (f32x4){0.f, 0.f, 0.f, 0.f};
        f32x4 pw[8];
#pragma unroll
        for (int i = 0; i < 8; ++i) pw[i] = *(const f32x4*)(wr + (size_t)(tid + 512 * i) * 4);
        const bf16_t* hrow = H + (size_t)(tok0 + 16 * wave + fr) * DM + 8 * fq;
#pragma unroll 1
        for (int kc = 0; kc < 4; ++kc) {
#pragma unroll
            for (int i = 0; i < 8; ++i) { const int id = tid + 512 * i, k = id >> 4, e4 = (id & 15) * 4; const f32x4 w = pw[i];
                u32x2 hi; hi.x = pk2(w[0], w[1]); hi.y = pk2(w[2], w[3]);
                u32x2 lo; lo.x = pk2(w[0] - bflo(hi.x), w[1] - bfhi(hi.x)); lo.y = pk2(w[2] - bflo(hi.y), w[3] - bfhi(hi.y));
                *(LAS u32x2*)(Whi + k * WPT + e4 * 2) = hi; *(LAS u32x2*)(Wlo + k * WPT + e4 * 2) = lo; }
            if (kc < 3) {
#pragma unroll
                for (int i = 0; i < 8; ++i) pw[i] = *(const f32x4*)(wr + (size_t)(kc + 1) * 256 * NE + (size_t)(tid + 512 * i) * 4);
            }
            bf16x8 af[8];
#pragma unroll
            for (int ks = 0; ks < 8; ++ks) af[ks] = *(const bf16x8*)(hrow + 256 * kc + 32 * ks);
            LDS_BARRIER();
#pragma unroll
            for (int ks = 0; ks < 8; ++ks)
#pragma unroll
                for (int nt = 0; nt < 4; ++nt) { const int off = (32 * ks + 8 * fq + q4) * WPT + (16 * nt + 4 * p4) * 2;
                    const bf16x8 wh = cat8(vtr(Whi + off), vtr(Whi + off + 4 * WPT)), wl = cat8(vtr(Wlo + off), vtr(Wlo + off + 4 * WPT));
                    lacc[nt] = __builtin_amdgcn_mfma_f32_16x16x32_bf16(af[ks], wh, lacc[nt], 0, 0, 0);
                    lacc[nt] = __builtin_amdgcn_mfma_f32_16x16x32_bf16(af[ks], wl, lacc[nt], 0, 0, 0); }
            LDS_BARRIER();
        }
#pragma unroll
        for (int nt = 0; nt < 4; ++nt)
#pragma unroll
            for (int r = 0; r < 4; ++r) lg[(16 * wave + 4 * fq + r) * 65 + 16 * nt + fr] = lacc[nt][r];
        asm volatile("s_waitcnt lgkmcnt(0)" ::: "memory");
        TSEG_END(33); TSEG_BEGIN(34);
        const float rb = a.in[I_RB][lane]; unsigned mycnt = 0u;
        for (int rr = 0; rr < 16; ++rr) {
            const int row = 16 * wave + rr; const int t = tok0 + row;
            const float score = sigmoidf_(lg[row * 65 + lane]); const float choice = score + rb;
            const float m1 = group8_max(choice);
            const unsigned long long eq = __ballot(choice == m1); const int gbase = lane & ~7;
            const unsigned gm = (unsigned)(eq >> gbase) & 0xffu; const int first = gbase + __builtin_ctz(gm);
            const float m2 = group8_max((lane == first) ? -INFINITY : choice);
            const float gs = m1 + m2; const int grp = lane >> 3;
            int grank = 0;
#pragma unroll
            for (int g2 = 0; g2 < 8; ++g2) { const float og = rdlane_f(gs, 8 * g2); grank += (og > gs || (og == gs && g2 < grp)) ? 1 : 0; }
            float curv = (grank < 4) ? choice : -INFINITY; int rank = -1;
#pragma unroll
            for (int r = 0; r < TOPK; ++r) { const float mx = wave_max(curv); const unsigned long long bal = __ballot(curv == mx);
                const int win = __builtin_ctzll(bal); if (lane == win) { rank = r; curv = -INFINITY; } }
            const bool sel = rank >= 0;
            const float wsum = wave_sum(sel ? score : 0.f);
            if (sel) { sele[t * 8 + rank] = lane; selw[t * 8 + rank] = score / wsum * 2.5f; mycnt++; }
        }
        TSEG_END(34);
        if (mycnt) atomicAdd((unsigned*)&cnt[lane], mycnt);
        LDS_BARRIER();
        if (tid < 64) ctl[CW_BLOCKCNT + vb * 64 + tid] = cnt[tid];
        LDS_BARRIER();
    }
}

__device__ __forceinline__ void phase_lists(ArgsRef a, ldsp lds) {
    const int tid = launder((int)threadIdx.x), lane = tid & 63, wave = __builtin_amdgcn_readfirstlane(tid >> 6), G = gridDim.x;
    const unsigned* ctl = (const unsigned*)(a.ws + WS_CTL); unsigned* ctlw = (unsigned*)(a.ws + WS_CTL);
    const int* sele = (const int*)(a.ws + WS_SELE); const float* selw = (const float*)(a.ws + WS_SELW);
    int* tokpos = (int*)(a.ws + WS_TOKPOS);
    LAS unsigned* part = (LAS unsigned*)lds;
    LAS unsigned* pre = part + 1024;
    LAS unsigned* cntp = pre + 64;
    LAS unsigned* pstart = cntp + 64;
    LAS unsigned* cstart = pstart + 64;
    LAS unsigned* lcnt = cstart + 64;
    for (int vb = blockIdx.x; vb < 256; vb += G) {
        int p = 0;
#pragma unroll
        for (int q = 1; q < NPASS; ++q) p += (vb >= PASS_VB0[q]) ? 1 : 0;
        const int vb0 = PASS_VB0[p], vb1 = PASS_VB0[p + 1];
        int* rowtok = (int*)(a.ws + WS_ROWTOK) + p * PASS_MAXROWS; float* rowgate = (float*)(a.ws + WS_ROWGATE) + p * PASS_MAXROWS;
        int* rowy = (int*)(a.ws + WS_ROWY) + p * PASS_MAXROWS; int* tilee = (int*)(a.ws + WS_TILEE) + p * PASS_MAXTILES;
        { const int e = tid & 63, pt = tid >> 6; unsigned tot = 0u, bel = 0u;
          for (int v2 = vb0 + pt; v2 < vb1; v2 += 8) { const unsigned cv = ctl[CW_BLOCKCNT + v2 * 64 + e]; tot += cv; if (v2 < vb) bel += cv; }
          part[(pt * 64 + e) * 2] = tot; part[(pt * 64 + e) * 2 + 1] = bel; }
        BLOCK_SYNC();
        if (tid < 64) { unsigned tot = 0u, bel = 0u;
#pragma unroll
            for (int pt = 0; pt < 8; ++pt) { tot += part[(pt * 64 + tid) * 2]; bel += part[(pt * 64 + tid) * 2 + 1]; }
            const unsigned pad = (tot + 255u) & ~255u;
            unsigned ps = pad, cs = tot;
#pragma unroll
            for (int o = 1; o < 64; o <<= 1) { const unsigned t1 = __shfl_up(ps, o), t2 = __shfl_up(cs, o); if (lane >= o) { ps += t1; cs += t2; } }
            const unsigned sh = (p == 0) ? (unsigned)T : 0u;
            pre[tid] = bel; cntp[tid] = tot; pstart[tid] = sh + ps - pad; cstart[tid] = cs - tot; lcnt[tid] = 0u;
            if (vb == vb0 && tid == 63) ctlw[CW_NTILES + p] = (sh + ps) >> 8; }
        BLOCK_SYNC();
#pragma unroll
        for (int i = 0; i < 2; ++i) { const int sidx = tid + 512 * i, tl = sidx >> 3, k = sidx & 7; const int t = vb * 128 + tl;
            const int e = sele[t * 8 + k]; const float w = selw[t * 8 + k];
            const unsigned rank = pre[e] + atomicAdd((unsigned*)&lcnt[e], 1u);
            const unsigned prow = pstart[e] + rank, yrow = cstart[e] + rank + 1u;
            rowtok[prow] = t; rowgate[prow] = w; rowy[prow] = (int)yrow; tokpos[t * 8 + k] = (int)yrow; }
        { const int e = vb - vb0;
            if (e < 64) { const unsigned c0 = cntp[e], ps = pstart[e], pad = (c0 + 255u) & ~255u;
                for (unsigned r = c0 + tid; r < pad; r += 512) { rowtok[ps + r] = vb0 * 128; rowgate[ps + r] = 0.f; rowy[ps + r] = T * 8 + 1 + (int)((ps + r) % 255u); }
                for (unsigned tl = tid; tl < (pad >> 8); tl += 512) tilee[(ps >> 8) + tl] = e; }
            if (e == 64 && p == 0) for (int tl = tid; tl < T / 256; tl += 512) tilee[tl] = 64;
        }
        if (tid < 128) { const int t = vb * 128 + tid; int* rt0 = (int*)(a.ws + WS_ROWTOK); float* rg0 = (float*)(a.ws + WS_ROWGATE); int* ry0 = (int*)(a.ws + WS_ROWY);
            rt0[t] = t; rg0[t] = 1.f; ry0[t] = YS_ROW0 + t; }
        BLOCK_SYNC();
    }
}

__device__ __forceinline__ void moe_gemm1(ArgsRef a, ldsp lds, int p) {
    const unsigned* ctl = (const unsigned*)(a.ws + WS_CTL);
    const int ntile = (int)ctl[CW_NTILES + p];
    pg8::Gemm g{(const bf16_t*)(a.ws + WS_H8), (const bf16_t*)(a.ws + WS_W1T), 0, 512, DM / 2, (size_t)512 * DM, (const int*)(a.ws + WS_ROWTOK) + p * PASS_MAXROWS};
    pg8::MoeOrder<2, true> S{ntile, (int)gridDim.x, (int)blockIdx.x, 0, (const int*)(a.ws + WS_TILEE) + p * PASS_MAXTILES};
    pg8::EpiSwiGLU E{(unsigned char*)a.out, 1.f / (H8_SCALE * W1_SCALE)};
    pg8::gemm_phase<pg8::EpiSwiGLU, pg8::MoeOrder<2, true>, true, true>(lds, g, S, E);
}
__device__ __forceinline__ void moe_gemm2(ArgsRef a, ldsp lds, int p) {
    const unsigned* ctl = (const unsigned*)(a.ws + WS_CTL);
    const int ntile = (int)ctl[CW_NTILES + p];
    pg8::Gemm g{(const bf16_t*)a.out, (const bf16_t*)(a.ws + WS_W2T), 0, DM, DE / 2, (size_t)DM * DE, nullptr};
    pg8::MoeOrder<4, true> S{ntile, (int)gridDim.x, (int)blockIdx.x, 0, (const int*)(a.ws + WS_TILEE) + p * PASS_MAXTILES};
    pg8::EpiDownY E{(unsigned char*)(a.ws + WS_Y), (const int*)(a.ws + WS_ROWY) + p * PASS_MAXROWS, (const float*)(a.ws + WS_ROWGATE) + p * PASS_MAXROWS};
    pg8::gemm_phase<pg8::EpiDownY, pg8::MoeOrder<4, true>, false, true>(lds, g, S, E);
}
__device__ __forceinline__ void moe_combine(ArgsRef a, int p) {
    const int tid = launder((int)threadIdx.x), lane_ = tid & 63, wave = tid >> 6, G = gridDim.x;
    const bf16_t* H = (const bf16_t*)(a.ws + WS_H); const unsigned char* Y = (const unsigned char*)(a.ws + WS_Y); const int* tokpos = (const int*)(a.ws + WS_TOKPOS);
    const float* g2 = a.in[I_LN2G]; const float* b2 = a.in[I_LN2B];
    const int t0 = PASS_VB0[p] * 128, t1 = PASS_VB0[p + 1] * 128;
    for (int tb = t0 + (blockIdx.x * 8 + wave) * 2; tb < t1; tb += G * 16) {
        const int lane = launder(lane_);
        int yr[2][8]; u32x4 hv[2][2]; u32x2 sv[2][2];
#pragma unroll
        for (int u = 0; u < 2; ++u) { const int t = tb + u;
#pragma unroll
            for (int k = 0; k < 8; ++k) yr[u][k] = tokpos[t * 8 + k];
#pragma unroll
            for (int j = 0; j < 2; ++j) { const int c = 8 * lane + 512 * j; hv[u][j] = *(const u32x4*)(H + (size_t)t * DM + c); sv[u][j] = *(const u32x2*)(Y + (size_t)(YS_ROW0 + t) * DM + c); } }
        f32x4 gav[2], gbv[2], bav[2], bbv[2];
#pragma unroll
        for (int j = 0; j < 2; ++j) { const int c = 8 * lane + 512 * j; gav[j] = *(const f32x4*)(g2 + c); gbv[j] = *(const f32x4*)(g2 + c + 4); bav[j] = *(const f32x4*)(b2 + c); bbv[j] = *(const f32x4*)(b2 + c + 4); }
        u32x2 yv[2][8][2];
#pragma unroll
        for (int u = 0; u < 2; ++u)
#pragma unroll
            for (int k = 0; k < 8; ++k)
#pragma unroll
                for (int j = 0; j < 2; ++j) yv[u][k][j] = *(const u32x2*)(Y + (size_t)yr[u][k] * DM + 8 * lane + 512 * j);
#pragma unroll
        for (int u = 0; u < 2; ++u) { const int t = tb + u;
            float v[2][8];
#pragma unroll
            for (int j = 0; j < 2; ++j) { f32x2 q[4];
                { const u32x2 s4 = sv[u][j]; q[0] = __builtin_amdgcn_cvt_pk_f32_fp8((int)s4.x, false); q[1] = __builtin_amdgcn_cvt_pk_f32_fp8((int)s4.x, true);
                  q[2] = __builtin_amdgcn_cvt_pk_f32_fp8((int)s4.y, false); q[3] = __builtin_amdgcn_cvt_pk_f32_fp8((int)s4.y, true); }
#pragma unroll
                for (int k = 0; k < 8; ++k) { const u32x2 y4 = yv[u][k][j];
                    q[0] += __builtin_amdgcn_cvt_pk_f32_fp8((int)y4.x, false); q[1] += __builtin_amdgcn_cvt_pk_f32_fp8((int)y4.x, true);
                    q[2] += __builtin_amdgcn_cvt_pk_f32_fp8((int)y4.y, false); q[3] += __builtin_amdgcn_cvt_pk_f32_fp8((int)y4.y, true); }
                const u32x4 h4 = hv[u][j]; constexpr float IS = 1.f / 64.f;
                v[j][0] = q[0].x * IS + ALPHA * bflo(h4.x); v[j][1] = q[0].y * IS + ALPHA * bfhi(h4.x); v[j][2] = q[1].x * IS + ALPHA * bflo(h4.y); v[j][3] = q[1].y * IS + ALPHA * bfhi(h4.y);
                v[j][4] = q[2].x * IS + ALPHA * bflo(h4.z); v[j][5] = q[2].y * IS + ALPHA * bfhi(h4.z); v[j][6] = q[3].x * IS + ALPHA * bflo(h4.w); v[j][7] = q[3].y * IS + ALPHA * bfhi(h4.w); }
            float s = 0.f;
#pragma unroll
            for (int j = 0; j < 2; ++j)
#pragma unroll
                for (int e = 0; e < 8; ++e) s += v[j][e];
            const float mean = wave_sum(s) * (1.f / DM); float s2 = 0.f;
#pragma unroll
            for (int j = 0; j < 2; ++j)
#pragma unroll
                for (int e = 0; e < 8; ++e) { v[j][e] -= mean; s2 += v[j][e] * v[j][e]; }
            const float rstd = __builtin_amdgcn_rsqf(wave_sum(s2) * (1.f / DM) + LN_EPS);
#pragma unroll
            for (int j = 0; j < 2; ++j) { const int c = 8 * lane + 512 * j;
                const f32x4 ga = gav[j], gb = gbv[j], ba = bav[j], bb = bbv[j];
                f32x4 o0, o1;
                o0[0] = v[j][0] * rstd * ga[0] + ba[0]; o0[1] = v[j][1] * rstd * ga[1] + ba[1]; o0[2] = v[j][2] * rstd * ga[2] + ba[2]; o0[3] = v[j][3] * rstd * ga[3] + ba[3];
                o1[0] = v[j][4] * rstd * gb[0] + bb[0]; o1[1] = v[j][5] * rstd * gb[1] + bb[1]; o1[2] = v[j][6] * rstd * gb[2] + bb[2]; o1[3] = v[j][7] * rstd * gb[3] + bb[3];
                *(f32x4*)(a.out + (size_t)t * DM + c) = o0; *(f32x4*)(a.out + (size_t)t * DM + c + 4) = o1; }
        }
    }
}

#define XB_TMO      128
#define XB_XCNT(j)  (256  + 64 * (j))
#define XB_XSUB(j)  (1280 + 64 * (j))
#define XB_XGEN(j)  (2304 + 64 * (j))
#define XB_TOP      3328
#define XB_TOPGEN   3392
#define XB_LSUB(j)  (3456 + 64 * (j))
#define XB_LGEN(j)  (4480 + 64 * (j))
#define XCD_BAR_WORDS 3456
#define XB_SPIN_CAP (1u << 18)
__device__ __forceinline__ unsigned xb_ld(unsigned* p)              { return __hip_atomic_load(p, __ATOMIC_RELAXED, __HIP_MEMORY_SCOPE_AGENT); }
__device__ __forceinline__ unsigned xb_add(unsigned* p, unsigned v) { return __hip_atomic_fetch_add(p, v, __ATOMIC_RELAXED, __HIP_MEMORY_SCOPE_AGENT); }
__device__ __forceinline__ unsigned xb_xcc_id() { return (unsigned)__builtin_amdgcn_s_getreg((3 << 11) | 20) & 0xFu; }
#define XB_SPIN(cond, bar) do { unsigned _sp = 0; while (cond) { __builtin_amdgcn_s_sleep(1); \
    if ((++_sp & 255u) == 0u) { if (xb_ld(&(bar)[XB_TMO])) break; if (_sp > XB_SPIN_CAP) { atomicAdd(&(bar)[XB_TMO], 1u); break; } } } } while (0)
struct XcdBarrier { unsigned* bar; unsigned x; volatile LAS unsigned* st; };
__device__ __forceinline__ XcdBarrier xcd_barrier_post(unsigned* bar, volatile LAS unsigned* st) {
    XcdBarrier b; b.bar = bar; b.x = xb_xcc_id(); b.st = st;
    if (threadIdx.x == 0) { const unsigned rk = xb_add(&bar[XB_XCNT(b.x)], 1u); st[10] = b.x; st[11] = rk; }
    return b;
}
__device__ __forceinline__ void xcd_barrier_complete(unsigned* bar, unsigned x, unsigned& nloc, unsigned& nx, unsigned& even) {
    const unsigned G = gridDim.x * gridDim.y * gridDim.z;
    unsigned sum, cnt, mine, sp = 0u; even = 0u;
    for (;;) {
        sum = 0u; cnt = 0u; mine = 0u;
#pragma unroll
        for (unsigned j = 0; j < 16; ++j) { const unsigned c = xb_ld(&bar[XB_XCNT(j)]); sum += c; cnt += (c > 0u) ? 1u : 0u; mine = (j == x) ? c : mine; }
        if (sum == G) { even = (cnt == 8u && (G & 7u) == 0u) ? 1u : 0u;
#pragma unroll
            for (unsigned j = 0; j < 16; ++j) { const unsigned c = xb_ld(&bar[XB_XCNT(j)]); if (j < 8u ? c != G / 8u : c != 0u) even = 0u; }
            break; }
        __builtin_amdgcn_s_sleep(1);
        if ((++sp & 255u) == 0u) { if (xb_ld(&bar[XB_TMO])) break; if (sp > XB_SPIN_CAP) { atomicAdd(&bar[XB_TMO], 1u); break; } }
    }
    nloc = mine > 0u ? mine : 1u; nx = cnt > 0u ? cnt : 1u;
}
__device__ __forceinline__ void xcd_barrier_t0(const XcdBarrier& b) {
    unsigned* bar = b.bar;
    __builtin_amdgcn_s_waitcnt(0);
    unsigned nloc = b.st[0], nx = b.st[1];
    if (nloc == 0u) { unsigned even; xcd_barrier_complete(bar, b.x, nloc, nx, even); b.st[0] = nloc; b.st[1] = nx; b.st[9] = (even != 0u && BATCH == 8) ? 1u : 0u; }
    const unsigned old = xb_add(&bar[XB_XSUB(b.x)], 1u);
    const unsigned gen = old / nloc;
    if (old + 1u == (gen + 1u) * nloc) {
        __builtin_amdgcn_fence(__ATOMIC_RELEASE, "agent");
        asm volatile("s_waitcnt vmcnt(0)" ::: "memory");
        const unsigned og = xb_add(&bar[XB_TOP], 1u);
        const unsigned tg = og / nx;
        if (og + 1u == (tg + 1u) * nx) xb_add(&bar[XB_TOPGEN], 1u);
        else XB_SPIN(xb_ld(&bar[XB_TOPGEN]) == tg, bar);
        __builtin_amdgcn_fence(__ATOMIC_ACQUIRE, "agent");
        xb_add(&bar[XB_XGEN(b.x)], 1u);
        asm volatile("s_waitcnt vmcnt(0)" ::: "memory");
    } else {
        XB_SPIN(xb_ld(&bar[XB_XGEN(b.x)]) == gen, bar);
        __builtin_amdgcn_fence(__ATOMIC_ACQUIRE, "agent");
        asm volatile("s_waitcnt vmcnt(0)" ::: "memory");
    }
}
__device__ __forceinline__ void xcd_barrier(const XcdBarrier& b) {
    asm volatile("s_waitcnt vmcnt(0)" ::: "memory");
    __syncthreads();
    if (threadIdx.x == 0) xcd_barrier_t0(b);
    __syncthreads();
}
__device__ __forceinline__ void xcd_local_t0(const XcdBarrier& b) {
    unsigned* bar = b.bar;
    __builtin_amdgcn_s_waitcnt(0);
    const unsigned nloc = b.st[0];
    const unsigned old = xb_add(&bar[XB_LSUB(b.x)], 1u);
    const unsigned gen = old / nloc;
    if (old + 1u == (gen + 1u) * nloc) xb_add(&bar[XB_LGEN(b.x)], 1u);
    else XB_SPIN(xb_ld(&bar[XB_LGEN(b.x)]) == gen, bar);
    __builtin_amdgcn_fence(__ATOMIC_ACQUIRE, "agent");
    asm volatile("s_waitcnt vmcnt(0)" ::: "memory");
}
template <class F> __device__ __forceinline__ void xcd_seam_work(const XcdBarrier& b, F&& work) {
    asm volatile("s_waitcnt vmcnt(0)" ::: "memory");
    __syncthreads();
    if (threadIdx.x == 0) { if (b.st[9] != 0u) xcd_local_t0(b); else xcd_barrier_t0(b); }
    else if (threadIdx.x >= 64) work();
    asm volatile("s_waitcnt vmcnt(0) lgkmcnt(0)" ::: "memory");
    __syncthreads();
}
template <class F> __device__ __forceinline__ void xcd_barrier_work(const XcdBarrier& b, F&& work) {
    asm volatile("s_waitcnt vmcnt(0)" ::: "memory");
    __syncthreads();
    if (threadIdx.x == 0) xcd_barrier_t0(b);
    else if (threadIdx.x >= 64) work();
    asm volatile("s_waitcnt vmcnt(0) lgkmcnt(0)" ::: "memory");
    __syncthreads();
}

constexpr int N_PHASES = 14;
#ifndef REP_MASK
#define REP_MASK 0
#endif
#define REP(k) (((REP_MASK) >> (k)) & 1)
#if REP_MASK == 0
#define REPFOR(k)
#else
#define REPFOR(k) for (int rep_ = 0; rep_ < 1 + REP(k); ++rep_)
#endif
#ifndef DRYLVL
#define DRYLVL 1
#endif
__device__ __forceinline__ const __attribute__((address_space(4))) Args* kargs() {
    const __attribute__((address_space(4))) Args* p = (const __attribute__((address_space(4))) Args*)__builtin_amdgcn_kernarg_segment_ptr();
    asm volatile("" : "+s"(p)); return p;
}
__global__ void __launch_bounds__(512, 2) fwd_megakernel(Args a_unused) {
    extern __shared__ __attribute__((aligned(16))) unsigned char lds_raw[];
    ldsp lds = (ldsp)lds_raw;
    cg::grid_group grid = cg::this_grid();
#define lo (kargs()->ph_lo)
#define hi (kargs()->ph_hi)
    if (threadIdx.x < 16) ((LAS unsigned*)(lds + MISC_OFF))[threadIdx.x] = 0u;
    __syncthreads();
    (void)xcd_barrier_post((unsigned*)(kargs()->ws + WS_CTL) + CW_BAR, (volatile LAS unsigned*)(lds + MISC_OFF));
#define a (*kargs())
#ifdef PHASE_ONLY
#define IN(k) ((k) == PHASE_ONLY && lo <= (k) && (k) < hi)
#elif defined(PHASE_MASK)
#define IN(k) ((((PHASE_MASK) >> (k)) & 1) && lo <= (k) && (k) < hi)
#else
#define IN(k) (lo <= (k) && (k) < hi)
#endif
#define SEAM(k) do { if (IN(k) && IN((k) + 1)) { XcdBarrier bar_; bar_.bar = (unsigned*)(kargs()->ws + WS_CTL) + CW_BAR; bar_.x = xb_xcc_id(); bar_.st = (volatile LAS unsigned*)(lds + MISC_OFF); TSEG_BEGIN(30); TSEG_BEGIN(100 + (k)); \
    if ((k) == 1) xcd_barrier_work(bar_, [&] { const int t_ = (int)threadIdx.x; wout_slice(a, lds, __builtin_amdgcn_readfirstlane(t_ >> 6), t_ & 63); }); \
    else if ((k) == 7) xcd_barrier_work(bar_, [&] { const int t_ = (int)threadIdx.x; conv_slice(a, lds, (k) - CONV_SEAM0, __builtin_amdgcn_readfirstlane(t_ >> 6), t_ & 63); }); \
    else if ((k) >= CONV_SEAM0 && (k) < CONV_SEAM0 + CONV_SEAMS) xcd_seam_work(bar_, [&] { const int t_ = (int)threadIdx.x; conv_slice(a, lds, (k) - CONV_SEAM0, __builtin_amdgcn_readfirstlane(t_ >> 6), t_ & 63); }); \
    else xcd_barrier(bar_); \
    TSEG_END(100 + (k)); TSEG_END(30); } } while (0)
    if (lo < -12345) grid.sync();
    TSEG_BEGIN(50); if (IN(0)) { if (REP(0)) phase_p0(a, lds); phase_p0(a, lds); } TSEG_END(50);
    SEAM(0);
    if (IN(1)) REPFOR(1) {
        pg8::Gemm g{(const bf16_t*)(a.ws + WS_XB), (const bf16_t*)(a.ws + WS_WIN), T, NINP, DM, 0, nullptr};
        pg8::StaticOrder S; S.init_local(T, NINP, (int)gridDim.x, (int)blockIdx.x);
        pg8::EpiInProj E{(bf16_t*)(a.ws + WS_Q), (bf16_t*)(a.ws + WS_K), (bf16_t*)(a.ws + WS_V), (bf16_t*)(a.ws + WS_OZ), (bf16_t*)(a.ws + WS_XBC), (float*)(a.ws + WS_GATES)};
        pg8::gemm_phase<pg8::EpiInProj, pg8::StaticOrder, false>(lds, g, S, E);
    }
    SEAM(1);
    TSEG_BEGIN(52); if (IN(2)) { if (REP(2)) phase_ml_states(a, lds); phase_ml_states(a, lds); } TSEG_END(52);
    SEAM(2);
    TSEG_BEGIN(53); if (IN(3)) { if (REP(3)) phase_scan<true>(a, lds, true); phase_scan<true>(a, lds); } TSEG_END(53);
    SEAM(3);
    if (IN(4)) { if (REP(4)) phase_ml_out(a, lds, DRYLVL); phase_ml_out(a, lds); }
    SEAM(4);
    TSEG_BEGIN(55); if (IN(5)) { if (REP(5)) phase_ssd_states(a, lds); phase_ssd_states(a, lds); } TSEG_END(55);
    SEAM(5);
    TSEG_BEGIN(56); if (IN(6)) { if (REP(6)) phase_scan<false>(a, lds, true); phase_scan<false>(a, lds); } TSEG_END(56);
    SEAM(6);
    if (IN(7)) { if (REP(7)) phase_ssd_out(a, lds, DRYLVL); phase_ssd_out(a, lds); }
    SEAM(7);
    if (IN(8)) REPFOR(8) {
        pg8::Gemm g{(const bf16_t*)(a.ws + WS_OZ), (const bf16_t*)(a.ws + WS_WOUT), T, DM, 2048, 0, nullptr};
        pg8::StaticOrder S; S.init_local(T, DM, (int)gridDim.x, (int)blockIdx.x); S.rev = 1;
        pg8::EpiResBf16 E{a.in[I_X], (bf16_t*)a.out, DM, ALPHA};
        pg8::gemm_phase<pg8::EpiResBf16, pg8::StaticOrder, false>(lds, g, S, E);
    }
    SEAM(8);
    TSEG_BEGIN(59); if (IN(9)) { if (REP(9)) phase_ln1_router(a, lds); phase_ln1_router(a, lds); } TSEG_END(59);
    SEAM(9);
    TSEG_BEGIN(60); if (IN(10)) { if (REP(10)) phase_lists(a, lds); phase_lists(a, lds); } TSEG_END(60);
    SEAM(10);
    TSEG_BEGIN(61); if (IN(11)) REPFOR(11) moe_gemm1(a, lds, 0); TSEG_END(61);
    SEAM(11);
    TSEG_BEGIN(62); if (IN(12)) REPFOR(12) moe_gemm2(a, lds, 0); TSEG_END(62);
    SEAM(12);
    TSEG_BEGIN(67); if (IN(13)) { if (REP(13)) moe_combine(a, 0); moe_combine(a, 0); } TSEG_END(67);
    if (PROBE_SEG != 0 && blockIdx.x == 0 && threadIdx.x == 0) {
        const unsigned long long acc_ = *(volatile LAS unsigned long long*)(lds_probe_base + 16) * PROBE_SCALE; const unsigned long long t0_ = __builtin_amdgcn_s_memrealtime();
        while (__builtin_amdgcn_s_memrealtime() - t0_ < acc_) __builtin_amdgcn_s_sleep(10);
    }
#undef IN
#undef SEAM
#undef a
#undef lo
#undef hi
}

extern "C" void kernel_launch(void* const* d_in, const int* in_sizes, int n_in, void* d_out, int out_size, void* d_ws, size_t ws_size, hipStream_t stream) {
    static int grid = 0;
    if (grid == 0) {
        if (n_in != 24 || out_size != T * DM || ws_size < WS_END) { fprintf(stderr, "kernel_launch: unexpected problem (n_in %d, out %d, ws %zu); nothing launched\n", n_in, out_size, ws_size); grid = -1; return; }
        int dev = 0, cus = 0, per_cu = 0;
        hipGetDevice(&dev); hipDeviceGetAttribute(&cus, hipDeviceAttributeMultiprocessorCount, dev);
        hipFuncSetAttribute((const void*)fwd_megakernel, hipFuncAttributeMaxDynamicSharedMemorySize, LDS_BYTES);
        hipOccupancyMaxActiveBlocksPerMultiprocessor(&per_cu, (const void*)fwd_megakernel, 512, LDS_BYTES);
        if (per_cu < 1) { fprintf(stderr, "kernel_launch: occupancy query says %d blocks per CU\n", per_cu); per_cu = 1; }
        (void)hipGetLastError();
        grid = cus * per_cu; if (grid > 256) grid = 256;
    }
    if (grid < 0) return;
    hipMemsetAsync((char*)d_ws + WS_CTL, 0, 1 * MiB, stream);
    Args a{};
    for (int i = 0; i < 24; ++i) a.in[i] = (const float*)d_in[i];
    a.out = (float*)d_out; a.ws = (unsigned char*)d_ws; a.ph_lo = 0; a.ph_hi = N_PHASES;
    void* args[] = {&a};
    hipError_t e = hipLaunchCooperativeKernel((const void*)fwd_megakernel, dim3(grid), dim3(512), args, LDS_BYTES, stream);
    if (e != hipSuccess) fprintf(stderr, "cooperative launch failed: %s (grid %d)\n", hipGetErrorString(e), grid);
}
```
